# Optimizing an MI355X kernel written in HIP

```python
import math
import jax
import jax.numpy as jnp
from jax import lax
import numpy as np

D_MODEL = 1024
BATCH = 2
SEQ = 8192
DEPTH = 1

N_MEM = 256
HEAD_DIM = 64
NSA_HEADS = 8
NSA_KV_HEADS = 2
NSA_GROUP = NSA_HEADS // NSA_KV_HEADS
NSA_WIDTH = NSA_HEADS * HEAD_DIM
KV_WIDTH = NSA_KV_HEADS * HEAD_DIM
RWKV_HEADS = 8
RWKV_WIDTH = RWKV_HEADS * HEAD_DIM
MIX_WIDTH = NSA_WIDTH + RWKV_WIDTH
CMP_LEN = 32
CMP_STRIDE = 16
CMP_HIDDEN = 256
SEL_BLOCK = 64
SEL_TOP = 16
WINDOW = 512
Q_BLOCK = 128
DECAY_LORA = 64
AAA_LORA = 64
GATE_LORA = 128
N_BUCKETS = 32
MAX_DISTANCE = 2048
XATTN_HEADS = 4
XATTN_HEAD = D_MODEL // XATTN_HEADS
D_FF = -(-(8 * D_MODEL) // (3 * 256)) * 256
RMS_EPS = 1e-6
LNX_EPS = 64e-5
FORCE_SCORE = 1e4
NEG_SCORE = -1e9
NSA_SIZES = (NSA_WIDTH,) + (KV_WIDTH,) * 6 + (NSA_HEADS * 3,)
RWKV_SIZES = (RWKV_WIDTH,) * 3 + (DECAY_LORA, AAA_LORA, GATE_LORA)
NSA_COLS = sum(NSA_SIZES)
RWKV_COLS = sum(RWKV_SIZES)
IN_COLS = NSA_COLS + RWKV_COLS

kernel_name = 'hybrid_nsa_rwkv7_block'


def _split(z, sizes):
    return jnp.split(z, np.cumsum(sizes)[:-1].tolist(), axis=-1)


def rms_norm(x, g):
    x32 = x.astype(jnp.float32)
    y = x32 * lax.rsqrt(jnp.mean(x32 * x32, axis=-1, keepdims=True) + RMS_EPS)
    return (y * g.astype(jnp.float32)).astype(x.dtype)


def masked_softmax(s, mask):
    s = jnp.where(mask, s.astype(jnp.float32), -1e30)
    m = jnp.max(s, axis=-1, keepdims=True)
    e = jnp.where(mask, jnp.exp(s - m), 0.0)
    return e / jnp.maximum(jnp.sum(e, axis=-1, keepdims=True), 1e-30)


def t5_bucket(dist):
    n = jnp.maximum(dist, 0)
    max_exact = N_BUCKETS // 2
    nf = jnp.maximum(n, 1).astype(jnp.float32)
    large = max_exact + (jnp.log(nf / max_exact) / math.log(MAX_DISTANCE / max_exact)
                         * (N_BUCKETS - max_exact)).astype(jnp.int32)
    return jnp.where(n < max_exact, n, jnp.minimum(large, N_BUCKETS - 1))


def nsa_compress(kv, pe, w1, b1, w2):
    B, T = kv.shape[:2]
    n_cmp = (T - CMP_LEN) // CMP_STRIDE + 1
    idx = np.arange(n_cmp)[:, None] * CMP_STRIDE + np.arange(CMP_LEN)[None, :]
    blk = kv[:, idx] + pe[None, None, :, None, :]
    blk = jnp.transpose(blk, (0, 3, 1, 2, 4)).reshape(B, NSA_KV_HEADS, n_cmp, CMP_LEN * HEAD_DIM)
    return jax.nn.gelu(blk @ w1 + b1) @ w2


def nsa_attention(q, k_cmp, v_cmp, k_sel, v_sel, k_win, v_win, gate_logits, rel_bias,
                  pe_k, pe_v, ck_w1, ck_b1, ck_w2, cv_w1, cv_b1, cv_w2):
    B, T = q.shape[:2]
    Hkv, G, dh = NSA_KV_HEADS, NSA_GROUP, HEAD_DIM
    qh = (q.reshape(B, T, Hkv, G, dh) * (dh ** -0.5)).transpose(0, 2, 3, 1, 4)
    kvh = lambda a: a.reshape(B, T, Hkv, dh)
    Kc = nsa_compress(kvh(k_cmp), pe_k, ck_w1, ck_b1, ck_w2)
    Vc = nsa_compress(kvh(v_cmp), pe_v, cv_w1, cv_b1, cv_w2)
    n_cmp = Kc.shape[2]
    cmp_start = np.arange(n_cmp) * CMP_STRIDE
    cmp_end = cmp_start + CMP_LEN - 1
    n_sel = T // SEL_BLOCK
    n_top = min(SEL_TOP, n_sel)
    sel_start = np.arange(n_sel) * SEL_BLOCK
    overlap = jnp.asarray(((cmp_start[:, None] <= sel_start[None, :] + SEL_BLOCK - 1)
                           & (cmp_end[:, None] >= sel_start[None, :])).astype(np.float32))
    Ks = kvh(k_sel).reshape(B, n_sel, SEL_BLOCK, Hkv, dh).transpose(0, 3, 1, 2, 4)
    Vs = kvh(v_sel).reshape(B, n_sel, SEL_BLOCK, Hkv, dh).transpose(0, 3, 1, 2, 4)
    pad = ((0, 0), (0, 0), (WINDOW, 0), (0, 0))
    Kw = jnp.pad(kvh(k_win).transpose(0, 2, 1, 3), pad)
    Vw = jnp.pad(kvh(v_win).transpose(0, 2, 1, 3), pad)
    gates = jax.nn.sigmoid(gate_logits).reshape(B, T, Hkv, G, 3).transpose(0, 2, 3, 1, 4)
    table = rel_bias.T.reshape(Hkv, G, N_BUCKETS)
    bi = jnp.arange(B)[:, None, None, None]
    hi = jnp.arange(Hkv)[None, :, None, None]
    h6 = jnp.arange(Hkv)[None, :, None, None, None, None]
    g6 = jnp.arange(G)[None, None, :, None, None, None]
    blk_id = jnp.arange(n_sel)

    def query_block(qb):
        q0 = qb * Q_BLOCK
        qblk = lax.dynamic_slice_in_dim(qh, q0, Q_BLOCK, axis=3)
        t = q0 + jnp.arange(Q_BLOCK)
        dist_c = t[:, None] - cmp_end[None, :]
        s = jnp.einsum('bhgqd,bhcd->bhgqc', qblk, Kc).astype(jnp.float32) + table[:, :, t5_bucket(dist_c)]
        p_c = masked_softmax(s, dist_c >= 0)
        o_c = jnp.einsum('bhgqc,bhcd->bhgqd', p_c.astype(Vc.dtype), Vc)
        imp = jnp.einsum('bhgqc,cj->bhqj', p_c, overlap)
        cur = t // SEL_BLOCK
        forced = (blk_id[None] == 0) | (blk_id[None] == cur[:, None]) | (blk_id[None] == cur[:, None] - 1)
        valid = blk_id[None] * SEL_BLOCK <= t[:, None]
        score = jnp.where(valid, jnp.where(forced, FORCE_SCORE, imp), NEG_SCORE)
        _, idx = lax.top_k(score, n_top)
        kg = Ks[bi, hi, idx]
        vg = Vs[bi, hi, idx]
        kpos = idx[..., None] * SEL_BLOCK + jnp.arange(SEL_BLOCK)
        dist_s = t[None, None, :, None, None] - kpos
        bias_s = table[h6, g6, t5_bucket(dist_s)[:, :, None]]
        s = jnp.einsum('bhgqd,bhqnkd->bhgqnk', qblk, kg).astype(jnp.float32) + bias_s
        s = s.reshape(B, Hkv, G, Q_BLOCK, -1)
        mask_s = (dist_s >= 0)[:, :, None].reshape(B, Hkv, 1, Q_BLOCK, -1)
        p_s = masked_softmax(s, mask_s)
        o_s = jnp.einsum('bhgqm,bhqmd->bhgqd', p_s.astype(vg.dtype), vg.reshape(B, Hkv, Q_BLOCK, -1, dh))
        kw = lax.dynamic_slice_in_dim(Kw, q0, Q_BLOCK + WINDOW, axis=2)
        vw = lax.dynamic_slice_in_dim(Vw, q0, Q_BLOCK + WINDOW, axis=2)
        spos = q0 - WINDOW + jnp.arange(Q_BLOCK + WINDOW)
        dist_w = t[:, None] - spos[None, :]
        mask_w = (dist_w >= 0) & (dist_w < WINDOW) & (spos[None, :] >= 0)
        s = jnp.einsum('bhgqd,bhkd->bhgqk', qblk, kw).astype(jnp.float32) + table[:, :, t5_bucket(dist_w)]
        p_w = masked_softmax(s, mask_w)
        o_w = jnp.einsum('bhgqk,bhkd->bhgqd', p_w.astype(vw.dtype), vw)
        g = lax.dynamic_slice_in_dim(gates, q0, Q_BLOCK, axis=3)
        return g[..., 0:1] * o_c + g[..., 1:2] * o_s + g[..., 2:3] * o_w

    out = lax.map(query_block, jnp.arange(T // Q_BLOCK))
    return out.transpose(1, 0, 4, 2, 3, 5).reshape(B, T, NSA_WIDTH)


def rwkv7_time_mix(r, k, v, wd, ad, gd, w0, w_up, a0, a_up, g_up, k_k, k_a, r_k, lnx_w, lnx_b):
    B, T, _ = r.shape
    f32 = jnp.float32
    heads = lambda z: z.reshape(B, T, RWKV_HEADS, HEAD_DIM)
    w_log = -jax.nn.softplus(-(w0 + jnp.tanh(wd) @ w_up)) - 0.5
    decay = jnp.exp(-jnp.exp(w_log.astype(f32)))
    a = jax.nn.sigmoid(a0 + ad @ a_up)
    g = jax.nn.sigmoid(gd) @ g_up
    kk = heads(k * k_k).astype(f32)
    kk = kk * lax.rsqrt(jnp.maximum(jnp.sum(kk * kk, axis=-1, keepdims=True), 1e-24))
    k = k * (1 + (a - 1) * k_a)
    tm = lambda z: jnp.swapaxes(heads(z).astype(f32), 0, 1)
    xs = (tm(r), tm(decay), tm(k), tm(v), jnp.swapaxes(-kk, 0, 1),
          jnp.swapaxes(kk * heads(a).astype(f32), 0, 1))

    def step(S, inp):
        r_t, w_t, k_t, v_t, a_t, b_t = inp
        sa = jnp.einsum('bhvk,bhk->bhv', S, a_t)
        S = S * w_t[:, :, None, :] + sa[..., None] * b_t[:, :, None, :] + v_t[..., None] * k_t[:, :, None, :]
        return S, jnp.einsum('bhvk,bhk->bhv', S, r_t)

    S0 = jnp.zeros((B, RWKV_HEADS, HEAD_DIM, HEAD_DIM), f32)
    _, y = lax.scan(step, S0, xs)
    y = jnp.swapaxes(y, 0, 1)
    mean = jnp.mean(y, axis=-1, keepdims=True)
    var = jnp.mean(jnp.square(y - mean), axis=-1, keepdims=True)
    y = ((y - mean) * lax.rsqrt(var + LNX_EPS)).reshape(B, T, RWKV_WIDTH) * lnx_w + lnx_b
    bonus = jnp.sum(heads(r) * heads(k) * r_k, axis=-1, keepdims=True) * heads(v)
    y = (y + bonus.reshape(B, T, RWKV_WIDTH).astype(f32)) * g.astype(f32)
    return y.astype(r.dtype)


def memory_cross_attention(h, mem, w_q, w_kv, w_o):
    B, T, _ = h.shape
    M = mem.shape[1]
    q = (h @ w_q).reshape(B, T, XATTN_HEADS, XATTN_HEAD)
    kv = mem @ w_kv
    k = kv[..., :D_MODEL].reshape(B, M, XATTN_HEADS, XATTN_HEAD)
    v = kv[..., D_MODEL:].reshape(B, M, XATTN_HEADS, XATTN_HEAD)
    s = jnp.einsum('bthd,bmhd->bhtm', q, k).astype(jnp.float32) * (XATTN_HEAD ** -0.5)
    p = jax.nn.softmax(s, axis=-1)
    o = jnp.einsum('bhtm,bmhd->bthd', p.astype(v.dtype), v).reshape(B, T, D_MODEL)
    return o @ w_o


def hybrid_layer(x, mem, rel_bias, norm_mix_g, w_in, nsa_gate_b, cmp_pe_k, cmp_pe_v,
                 cmp_k_w1, cmp_k_b1, cmp_k_w2, cmp_v_w1, cmp_v_b1, cmp_v_w2,
                 rwkv_mu, rwkv_w0, rwkv_w_up, rwkv_a0, rwkv_a_up, rwkv_g_up,
                 rwkv_k_k, rwkv_k_a, rwkv_r_k, rwkv_lnx_w, rwkv_lnx_b, w_out,
                 norm_x_g, norm_mem_g, w_q_x, w_kv_x, w_o_x,
                 norm_ffn_g, w_gate, w_up, w_down):
    proj = rms_norm(x, norm_mix_g) @ w_in
    nsa_part = proj[..., :NSA_COLS]
    rw = proj[..., NSA_COLS:]
    rw_prev = jnp.pad(rw[:, :-1], ((0, 0), (1, 0), (0, 0)))
    rw = rw + (rw_prev - rw) * rwkv_mu
    q, kc, vc, ks, vs, kw, vw, gl = _split(nsa_part, NSA_SIZES)
    r, k, v, wd, ad, gd = _split(rw, RWKV_SIZES)
    o_nsa = nsa_attention(q, kc, vc, ks, vs, kw, vw, gl + nsa_gate_b, rel_bias,
                          cmp_pe_k, cmp_pe_v, cmp_k_w1, cmp_k_b1, cmp_k_w2, cmp_v_w1, cmp_v_b1, cmp_v_w2)
    o_rwkv = rwkv7_time_mix(r, k, v, wd, ad, gd, rwkv_w0, rwkv_w_up, rwkv_a0, rwkv_a_up, rwkv_g_up,
                            rwkv_k_k, rwkv_k_a, rwkv_r_k, rwkv_lnx_w, rwkv_lnx_b)
    x = x + jnp.concatenate([o_nsa, o_rwkv], axis=-1) @ w_out
    x = x + memory_cross_attention(rms_norm(x, norm_x_g), rms_norm(mem, norm_mem_g), w_q_x, w_kv_x, w_o_x)
    h = rms_norm(x, norm_ffn_g)
    return x + (jax.nn.silu(h @ w_gate) * (h @ w_up)) @ w_down


def setup_inputs(seed: int = 0) -> dict:
    key = jax.random.key(seed)
    keys = iter(jax.random.split(key, 48))
    f32 = jnp.float32

    def nrm(shape, scale, stacked=True):
        shp = ((DEPTH,) + shape) if stacked else shape
        return scale * jax.random.normal(next(keys), shp, f32)

    def gain(n):
        return 1.0 + nrm((n,), 0.01)

    flat = CMP_LEN * HEAD_DIM
    return {
        'x': nrm((BATCH, SEQ, D_MODEL), 1.0, stacked=False),
        'mem': nrm((BATCH, N_MEM, D_MODEL), 1.0, stacked=False),
        'rel_bias': nrm((N_BUCKETS, NSA_HEADS), 0.2, stacked=False),
        'norm_f_g': 1.0 + nrm((D_MODEL,), 0.01, stacked=False),
        'norm_mix_g': gain(D_MODEL),
        'w_in': nrm((D_MODEL, IN_COLS), D_MODEL ** -0.5),
        'nsa_gate_b': nrm((NSA_HEADS * 3,), 0.01),
        'cmp_pe_k': nrm((CMP_LEN, HEAD_DIM), 0.02),
        'cmp_pe_v': nrm((CMP_LEN, HEAD_DIM), 0.02),
        'cmp_k_w1': nrm((flat, CMP_HIDDEN), flat ** -0.5),
        'cmp_k_b1': nrm((CMP_HIDDEN,), 0.01),
        'cmp_k_w2': nrm((CMP_HIDDEN, HEAD_DIM), CMP_HIDDEN ** -0.5),
        'cmp_v_w1': nrm((flat, CMP_HIDDEN), flat ** -0.5),
        'cmp_v_b1': nrm((CMP_HIDDEN,), 0.01),
        'cmp_v_w2': nrm((CMP_HIDDEN, HEAD_DIM), CMP_HIDDEN ** -0.5),
        'rwkv_mu': jax.random.uniform(next(keys), (DEPTH, RWKV_COLS), f32, 0.0, 1.0),
        'rwkv_w0': jax.random.uniform(next(keys), (DEPTH, RWKV_WIDTH), f32, -6.0, 0.0),
        'rwkv_w_up': nrm((DECAY_LORA, RWKV_WIDTH), 0.5 * DECAY_LORA ** -0.5),
        'rwkv_a0': nrm((RWKV_WIDTH,), 0.5),
        'rwkv_a_up': nrm((AAA_LORA, RWKV_WIDTH), 0.5 * AAA_LORA ** -0.5),
        'rwkv_g_up': nrm((GATE_LORA, RWKV_WIDTH), GATE_LORA ** -0.5),
        'rwkv_k_k': 0.85 + nrm((RWKV_WIDTH,), 0.05),
        'rwkv_k_a': 1.0 + nrm((RWKV_WIDTH,), 0.05),
        'rwkv_r_k': nrm((RWKV_HEADS, HEAD_DIM), 0.1),
        'rwkv_lnx_w': gain(RWKV_WIDTH),
        'rwkv_lnx_b': nrm((RWKV_WIDTH,), 0.01),
        'w_out': nrm((MIX_WIDTH, D_MODEL), MIX_WIDTH ** -0.5),
        'norm_x_g': gain(D_MODEL),
        'norm_mem_g': gain(D_MODEL),
        'w_q_x': nrm((D_MODEL, D_MODEL), D_MODEL ** -0.5),
        'w_kv_x': nrm((D_MODEL, 2 * D_MODEL), D_MODEL ** -0.5),
        'w_o_x': nrm((D_MODEL, D_MODEL), D_MODEL ** -0.5),
        'norm_ffn_g': gain(D_MODEL),
        'w_gate': nrm((D_MODEL, D_FF), D_MODEL ** -0.5),
        'w_up': nrm((D_MODEL, D_FF), D_MODEL ** -0.5),
        'w_down': nrm((D_FF, D_MODEL), D_FF ** -0.5),
    }


def reference(x, mem, rel_bias, norm_f_g, norm_mix_g, w_in, nsa_gate_b, cmp_pe_k, cmp_pe_v,
              cmp_k_w1, cmp_k_b1, cmp_k_w2, cmp_v_w1, cmp_v_b1, cmp_v_w2,
              rwkv_mu, rwkv_w0, rwkv_w_up, rwkv_a0, rwkv_a_up, rwkv_g_up,
              rwkv_k_k, rwkv_k_a, rwkv_r_k, rwkv_lnx_w, rwkv_lnx_b, w_out,
              norm_x_g, norm_mem_g, w_q_x, w_kv_x, w_o_x,
              norm_ffn_g, w_gate, w_up, w_down):
    for l in range(DEPTH):
        x = hybrid_layer(x, mem, rel_bias, norm_mix_g[l], w_in[l], nsa_gate_b[l], cmp_pe_k[l], cmp_pe_v[l],
                         cmp_k_w1[l], cmp_k_b1[l], cmp_k_w2[l], cmp_v_w1[l], cmp_v_b1[l], cmp_v_w2[l],
                         rwkv_mu[l], rwkv_w0[l], rwkv_w_up[l], rwkv_a0[l], rwkv_a_up[l], rwkv_g_up[l],
                         rwkv_k_k[l], rwkv_k_a[l], rwkv_r_k[l], rwkv_lnx_w[l], rwkv_lnx_b[l], w_out[l],
                         norm_x_g[l], norm_mem_g[l], w_q_x[l], w_kv_x[l], w_o_x[l],
                         norm_ffn_g[l], w_gate[l], w_up[l], w_down[l])
    return rms_norm(x, norm_f_g)
```

```cpp
#include <hip/hip_runtime.h>
#include <hip/hip_cooperative_groups.h>
#include <cstdio>
#include <cstdint>
namespace cg = cooperative_groups;

#define LAS __attribute__((address_space(3)))
#define GAS __attribute__((address_space(1)))
typedef unsigned short bf16_t;
typedef short bf16x8 __attribute__((ext_vector_type(8)));
typedef float f32x4 __attribute__((ext_vector_type(4)));
typedef float f32x2 __attribute__((ext_vector_type(2)));
typedef float f32x16 __attribute__((ext_vector_type(16)));
typedef unsigned u32x4 __attribute__((ext_vector_type(4)));
typedef unsigned u32x2 __attribute__((ext_vector_type(2)));

constexpr int NB = 2, T_ = 8192, M_ = NB * T_, D_ = 1024;
constexpr int NSA_COLS = 1304, RW_COLS = 1792, IN_COLS = 3096;
constexpr int PN_LD = 1536, PR_LD = 1792, NIN = 3328;
constexpr int DFF = 2816;
constexpr float RMS_EPS = 1e-6f;
constexpr float LOG2E = 1.4426950408889634f;
constexpr float QK_C = 0.125f * LOG2E;

constexpr size_t MiB = 1u << 20;
constexpr size_t OFF_LUT = 0;
constexpr size_t OFF_LTS = 512 * 1024, OFF_LTW = 640 * 1024;
constexpr size_t OFF_CBK = 64 * 1024, OFF_CBV = 66 * 1024;
constexpr size_t OFF_CBPART = 128 * 1024;
constexpr size_t OFF_SS1 = 1 * MiB, OFF_SS2 = 2 * MiB, OFF_SS3 = 3 * MiB;
constexpr size_t OFF_MEMN = 4 * MiB;
constexpr size_t OFF_KVX = 5 * MiB;
constexpr size_t OFF_KC = 7 * MiB, OFF_VC = 7 * MiB + 256 * 1024;
constexpr size_t OFF_H1K = 8 * MiB, OFF_H1V = 9 * MiB;
constexpr size_t OFF_WIN = 10 * MiB;
constexpr size_t OFF_WKV = 16 * MiB + 512 * 1024;
constexpr size_t OFF_WC1K = 20 * MiB + 512 * 1024, OFF_WC1V = 21 * MiB + 512 * 1024;
constexpr size_t OFF_WLORA = 22 * MiB + 512 * 1024;
constexpr size_t OFF_SUM = 8 * MiB;
constexpr size_t OFF_XN = 40 * MiB;
constexpr size_t OFF_PNSA = 72 * MiB;
constexpr size_t OFF_R1 = 120 * MiB;
constexpr size_t OFF_RW = 176 * MiB;
constexpr size_t OFF_WD = 168 * MiB;
constexpr size_t OFF_Q2 = 72 * MiB;
constexpr size_t OFF_XO = 176 * MiB;
constexpr size_t OFF_H = 72 * MiB;

__device__ __forceinline__ unsigned f2bf(float f) { unsigned u = __builtin_bit_cast(unsigned, f); return (u + 0x7fffu + ((u >> 16) & 1u)) >> 16; }
__device__ __forceinline__ unsigned pk2(float lo, float hi) { return f2bf(lo) | (f2bf(hi) << 16); }
__device__ __forceinline__ float bf2f(unsigned short b) { return __builtin_bit_cast(float, (unsigned)b << 16); }
__device__ __forceinline__ int lane_id() { int l; asm volatile("v_mbcnt_lo_u32_b32 %0, -1, 0\n\tv_mbcnt_hi_u32_b32 %0, -1, %0" : "=v"(l)); return l; }
__device__ __forceinline__ float wave_sum(float v) {
#pragma unroll
    for (int o = 1; o < 64; o <<= 1) v += __shfl_xor(v, o);
    return v;
}

typedef short s16x4 __attribute__((ext_vector_type(4)));
__device__ __forceinline__ int crow(int r, int hi) { return (r & 3) + 8 * (r >> 2) + 4 * hi; }
__device__ __forceinline__ s16x4 vtr(const LAS unsigned char* p) { return __builtin_bit_cast(s16x4, __builtin_amdgcn_ds_read_tr16_b64_v4i16((LAS s16x4*)p)); }

namespace pg8 {
constexpr int BM = 256, BK = 64, HALF = 128, HTB = HALF * BK * 2, STAGE_BYTES = 8 * HTB, NXCD = 8, WGM = 8;
__host__ __device__ __forceinline__ int lds_byte(int r, int c) { const int st = (r >> 4) * 2 + (c >> 5), rr = r & 15, cc = c & 31, ob = rr * 64 + cc * 2; return st * 1024 + (ob ^ (((ob >> 9) & 1) << 5)); }
__host__ __device__ __forceinline__ void stage_rc(int b, int& R, int& C) { const int st = b / 1024, sb = b % 1024, swz = sb ^ (((sb >> 9) & 1) << 5); R = (st >> 1) * 16 + swz / 64; C = (st & 1) * 32 + (swz % 64) / 2; }
__host__ __device__ __forceinline__ int perm32(int rho) { const int n = rho >> 4, i = rho & 15; return 8 * (i >> 2) + 4 * n + (i & 3); }

struct Unit { int pm, pn; };
struct Gemm { const bf16_t* A; const bf16_t* Bt; int M, N, K; int lda; int kstepA; int amode; };
__device__ __forceinline__ const char* a_tile(const Gemm& g, int pm) {
    if (g.amode == 0) return (const char*)g.A + (size_t)pm * BM * g.lda * 2;
    const int bh = pm >> 1, c0 = (pm & 1) * 256;
    return (const char*)g.A + ((size_t)((bh >> 1) * T_ + 16 * c0) * PN_LD + (bh & 1) * 64) * 2;
}

struct StaticOrder {
    int nM, nN, nwg, G, c;
    __device__ void init(int M, int N, int G_, int c_) { nM = M / BM; nN = N / BM; nwg = nM * nN; G = G_; c = c_; }
    __device__ bool next(int i, Unit& u) const {
        const long L = (long)i * G + c; if (L >= nwg || c < 0) return false;
        int wgid = (int)L; { const int q = nwg / NXCD, r = nwg % NXCD, xcd = wgid % NXCD, off = wgid / NXCD; wgid = (xcd < r ? xcd * (q + 1) : r * (q + 1) + (xcd - r) * q) + off; }
        const int nig = WGM * nN, gid = wgid / nig, fm = gid * WGM, gsz = (nM - fm) < WGM ? (nM - fm) : WGM;
        u.pm = fm + ((wgid % nig) % gsz); u.pn = (wgid % nig) / gsz; return true;
    }
};
struct ListOrder {
    int nN, n, j;
    __device__ void init(int M, int N, int first, int blk) { nN = N / BM; n = (M / BM) * nN; j = blk - first; }
    __device__ bool next(int i, Unit& u) const { if (i != 0 || j < 0 || j >= n) return false; u.pm = j / nN; u.pn = j % nN; return true; }
};

__device__ __forceinline__ unsigned cvt_pk_bf16(float lo, float hi) { unsigned r; asm volatile("v_cvt_pk_bf16_f32 %0, %1, %2" : "=v"(r) : "v"(lo), "v"(hi)); return r; }

template <class Epi, class Sched>
__device__ __forceinline__ void gemm_phase(LAS unsigned char* lds, const Gemm g, const Sched& S, const Epi& E, int wave_id) {
    const int wid = wave_id, lane = lane_id(), tid = wid * 64 + lane, wr = wid >> 2, wc = wid & 3, fr = lane & 15, fq = lane >> 4;
    const int K = g.K, nt = K / BK;
    unsigned voffA[2], voffB[2];
#pragma unroll
    for (int i = 0; i < 2; ++i) { int R, C; stage_rc(tid * 16 + i * 8192, R, C); const int Rb = (R & ~31) + perm32(R & 31);
        voffA[i] = (unsigned)(R * g.lda + C) * 2u; voffB[i] = (unsigned)(Rb * K + C) * 2u; }
    const size_t kstepA = (size_t)g.kstepA, kstepB = (size_t)(BK * 2);
    const size_t hstepA = (size_t)HALF * g.lda * 2, hstepB = (size_t)HALF * K * 2;
    const unsigned ldsw = (unsigned)wid * 1024u;
    const int aoff = lds_byte(wr * 64 + fr, fq * 8), boff = lds_byte(wc * 32 + fr, fq * 8);
#define PG8_SA(b, h) (((b) * 2 + (h)) * HTB)
#define PG8_SB(b, h) ((4 + (b) * 2 + (h)) * HTB)
#define PG8_STAGE(bufoff, gbase, voff) do { _Pragma("unroll") for (int _i = 0; _i < 2; ++_i) \
        __builtin_amdgcn_global_load_lds((const unsigned*)((const char*)(gbase) + (voff)[_i]), (LAS unsigned*)(lds + (bufoff) + ldsw + _i * 8192), 16, 0, 0); } while (0)
#define PG8_LDA(dst, b, h) do { _Pragma("unroll") for (int m = 0; m < 4; ++m) _Pragma("unroll") for (int k = 0; k < 2; ++k) dst[m][k] = *(const LAS bf16x8*)(lds + PG8_SA(b, h) + aoff + m * 2048 + k * 1024); } while (0)
#define PG8_LDB(dst, b, h) do { _Pragma("unroll") for (int n = 0; n < 2; ++n) _Pragma("unroll") for (int k = 0; k < 2; ++k) dst[n][k] = *(const LAS bf16x8*)(lds + PG8_SB(b, h) + boff + n * 2048 + k * 1024); } while (0)
#define PG8_MMA(ai, bj, At, Bt) do { __builtin_amdgcn_s_setprio(1); _Pragma("unroll") for (int m = 0; m < 4; ++m) _Pragma("unroll") for (int n = 0; n < 2; ++n) _Pragma("unroll") for (int k = 0; k < 2; ++k) \
        acc[ai][bj][m][n] = __builtin_amdgcn_mfma_f32_16x16x32_bf16(Bt[n][k], At[m][k], acc[ai][bj][m][n], 0, 0, 0); __builtin_amdgcn_s_setprio(0); } while (0)
#define PG8_WAIT_V(n) asm volatile("s_waitcnt vmcnt(" #n ")" ::: "memory")
#define PG8_WAIT_L(n) asm volatile("s_waitcnt lgkmcnt(" #n ")" ::: "memory")
#define PG8_BAR __builtin_amdgcn_s_barrier()
#define PG8_SCHED __builtin_amdgcn_sched_barrier(0)
    Unit cur, nxt; int ui = 0;
    if (!S.next(0, cur)) return;
    f32x4 acc[2][2][4][2];
#pragma unroll
    for (int a = 0; a < 2; ++a)
#pragma unroll
        for (int b = 0; b < 2; ++b)
#pragma unroll
            for (int m = 0; m < 4; ++m)
#pragma unroll
                for (int n = 0; n < 2; ++n) acc[a][b][m][n] = (f32x4){0.f, 0.f, 0.f, 0.f};
    bf16x8 At[4][2], B0[2][2], B1[2][2];
    const char* cA = a_tile(g, cur.pm); const char* cB = (const char*)g.Bt + (size_t)cur.pn * 2 * hstepB;
    PG8_STAGE(PG8_SB(0, 0), cB, voffB); PG8_STAGE(PG8_SB(0, 1), cB + hstepB, voffB); PG8_STAGE(PG8_SA(0, 0), cA, voffA); PG8_STAGE(PG8_SA(0, 1), cA + hstepA, voffA);
    if (wr == 1) PG8_BAR;
    PG8_WAIT_V(2); PG8_BAR;
    PG8_STAGE(PG8_SB(1, 0), cB + kstepB, voffB); PG8_STAGE(PG8_SA(1, 0), cA + kstepA, voffA); PG8_STAGE(PG8_SB(1, 1), cB + hstepB + kstepB, voffB);
    PG8_WAIT_V(6); PG8_BAR;
    for (;;) {
        const bool has_next = S.next(ui + 1, nxt);
        const char* nA = has_next ? a_tile(g, nxt.pm) : cA; const char* nB = has_next ? (const char*)g.Bt + (size_t)nxt.pn * 2 * hstepB : cB;
        for (int t = 0; t < nt; t += 2) {
            const bool last = (t == nt - 2);
            const char* a1 = cA + (size_t)(t + 1) * kstepA;
            const char* a2 = last ? nA : cA + (size_t)(t + 2) * kstepA; const char* b2 = last ? nB : cB + (size_t)(t + 2) * kstepB;
            const char* a3 = a2 + kstepA; const char* b3 = b2 + kstepB;
            PG8_LDB(B0, 0, 0); PG8_LDB(B1, 0, 1); PG8_SCHED; PG8_LDA(At, 0, 0); PG8_STAGE(PG8_SA(1, 1), a1 + hstepA, voffA);
            PG8_WAIT_V(8); PG8_WAIT_L(0); PG8_BAR; PG8_MMA(0, 0, At, B0); PG8_MMA(0, 1, At, B1); PG8_BAR; PG8_SCHED;
            PG8_LDA(At, 0, 1); PG8_STAGE(PG8_SB(0, 0), b2, voffB); PG8_STAGE(PG8_SB(0, 1), b2 + hstepB, voffB); PG8_STAGE(PG8_SA(0, 0), a2, voffA);
            PG8_WAIT_V(8); PG8_WAIT_L(0); PG8_BAR; PG8_MMA(1, 0, At, B0); PG8_MMA(1, 1, At, B1); PG8_BAR; PG8_SCHED;
            PG8_LDB(B0, 1, 0); PG8_LDB(B1, 1, 1); PG8_SCHED; PG8_LDA(At, 1, 0); PG8_STAGE(PG8_SA(0, 1), a2 + hstepA, voffA);
            PG8_WAIT_V(8); PG8_WAIT_L(0); PG8_BAR; PG8_MMA(0, 0, At, B0); PG8_MMA(0, 1, At, B1); PG8_BAR; PG8_SCHED;
            PG8_LDA(At, 1, 1); PG8_STAGE(PG8_SB(1, 0), b3, voffB); PG8_STAGE(PG8_SB(1, 1), b3 + hstepB, voffB); PG8_STAGE(PG8_SA(1, 0), a3, voffA);
            PG8_WAIT_V(8); PG8_WAIT_L(0); PG8_BAR; PG8_MMA(1, 0, At, B0); PG8_MMA(1, 1, At, B1); PG8_BAR; PG8_SCHED;
        }
        if (wr == 0) PG8_BAR;
        if constexpr (!Epi::AFTER_DRAIN) E(acc, cur, wr, wc, fr, fq);
        if (!has_next) break;
#pragma unroll
        for (int a = 0; a < 2; ++a)
#pragma unroll
            for (int b = 0; b < 2; ++b)
#pragma unroll
                for (int m = 0; m < 4; ++m)
#pragma unroll
                    for (int n = 0; n < 2; ++n) acc[a][b][m][n] = (f32x4){0.f, 0.f, 0.f, 0.f};
        cur = nxt; cA = nA; cB = nB; ++ui;
        if (wr == 1) PG8_BAR;
    }
    PG8_WAIT_V(0);
    PG8_BAR;
    if constexpr (Epi::AFTER_DRAIN) E.fused(acc, cur, wr, wc, fr, fq, lds, wid, lane);
#undef PG8_SA
#undef PG8_SB
#undef PG8_STAGE
#undef PG8_LDA
#undef PG8_LDB
#undef PG8_MMA
#undef PG8_WAIT_V
#undef PG8_WAIT_L
#undef PG8_BAR
#undef PG8_SCHED
}

typedef f32x4 Acc[2][2][4][2];
__device__ __forceinline__ float row_rs(const float* SS, int row) {
    const f32x4* p = (const f32x4*)(SS + (size_t)row * 16);
    const f32x4 a = p[0], b = p[1], c = p[2], d = p[3];
    const float s = ((a[0] + a[1]) + (a[2] + a[3])) + ((b[0] + b[1]) + (b[2] + b[3])) + ((c[0] + c[1]) + (c[2] + c[3])) + ((d[0] + d[1]) + (d[2] + d[3]));
    return __builtin_amdgcn_rsqf(s * (1.0f / D_) + RMS_EPS);
}
struct EpiStore {
    static constexpr bool AFTER_DRAIN = false;
    bf16_t* O0; int ld0; int npn0; bf16_t* O1; int ld1; int sc_lo, sc_hi; float scale;
    __device__ __forceinline__ void operator()(const Acc& acc, const Unit& u, int wr, int wc, int fr, int fq) const {
        bf16_t* base; int ld, colt;
        if (u.pn < npn0) { base = O0; ld = ld0; colt = u.pn * BM; } else { base = O1; ld = ld1; colt = (u.pn - npn0) * BM; }
        const int row0 = u.pm * BM + wr * 64 + fr, col0 = colt + wc * 32 + 8 * fq; const float sc = (u.pn >= sc_lo && u.pn < sc_hi) ? scale : 1.0f;
#pragma unroll
        for (int ai = 0; ai < 2; ++ai)
#pragma unroll
            for (int m = 0; m < 4; ++m) { bf16_t* rowp = base + (size_t)(row0 + ai * HALF + m * 16) * ld + col0;
#pragma unroll
                for (int bj = 0; bj < 2; ++bj) { const f32x4 v0 = acc[ai][bj][m][0] * sc, v1 = acc[ai][bj][m][1] * sc;
                    u32x4 w; w.x = cvt_pk_bf16(v0[0], v0[1]); w.y = cvt_pk_bf16(v0[2], v0[3]); w.z = cvt_pk_bf16(v1[0], v1[1]); w.w = cvt_pk_bf16(v1[2], v1[3]);
                    *(u32x4*)(rowp + bj * HALF) = w; } }
    }
};
__device__ __forceinline__ void load_base8(const float* basef, const bf16_t* baseb, const f32x4& gi0, const f32x4& gi1, bool base_xb, size_t off, f32x4& b0, f32x4& b1) {
    if (!base_xb) { b0 = *(const f32x4*)(basef + off); b1 = *(const f32x4*)(basef + off + 4); }
    else { const u32x4 w = *(const u32x4*)(baseb + off);
        b0 = (f32x4){__builtin_bit_cast(float, w.x << 16), __builtin_bit_cast(float, w.x & 0xffff0000u), __builtin_bit_cast(float, w.y << 16), __builtin_bit_cast(float, w.y & 0xffff0000u)} * gi0;
        b1 = (f32x4){__builtin_bit_cast(float, w.z << 16), __builtin_bit_cast(float, w.z & 0xffff0000u), __builtin_bit_cast(float, w.w << 16), __builtin_bit_cast(float, w.w & 0xffff0000u)} * gi1; }
}
__device__ __forceinline__ f32x4 rcp4(const f32x4 v) { return (f32x4){__builtin_amdgcn_rcpf(v[0]), __builtin_amdgcn_rcpf(v[1]), __builtin_amdgcn_rcpf(v[2]), __builtin_amdgcn_rcpf(v[3])}; }
template <bool BASE_XB> struct EpiResidual {
    static constexpr bool AFTER_DRAIN = false;
    const float* basef; const bf16_t* baseb; const float* gin; bf16_t* XB; const float* gout; float* SS;
    __device__ __forceinline__ void operator()(const Acc& acc, const Unit& u, int wr, int wc, int fr, int fq) const {
        const int row0 = u.pm * BM + wr * 64 + fr, col0 = u.pn * BM + wc * 32 + 8 * fq;
        f32x4 gv[2][2], gi[2][2];
#pragma unroll
        for (int bj = 0; bj < 2; ++bj)
#pragma unroll
            for (int n = 0; n < 2; ++n) { gv[bj][n] = *(const f32x4*)(gout + col0 + bj * HALF + 4 * n); gi[bj][n] = BASE_XB ? rcp4(*(const f32x4*)(gin + col0 + bj * HALF + 4 * n)) : gv[bj][n]; }
#pragma unroll
        for (int ai = 0; ai < 2; ++ai)
#pragma unroll
            for (int m = 0; m < 4; ++m) { const int row = row0 + ai * HALF + m * 16; const size_t off = (size_t)row * D_ + col0; float ss = 0.f;
#pragma unroll
                for (int bj = 0; bj < 2; ++bj) {
                    f32x4 b0, b1; load_base8(basef, baseb, gi[bj][0], gi[bj][1], BASE_XB, off + bj * HALF, b0, b1);
                    const f32x4 x0 = b0 + acc[ai][bj][m][0], x1 = b1 + acc[ai][bj][m][1];
                    ss += (x0[0] * x0[0] + x0[1] * x0[1]) + (x0[2] * x0[2] + x0[3] * x0[3]) + (x1[0] * x1[0] + x1[1] * x1[1]) + (x1[2] * x1[2] + x1[3] * x1[3]);
                    const f32x4 y0 = x0 * gv[bj][0], y1 = x1 * gv[bj][1];
                    u32x4 w; w.x = cvt_pk_bf16(y0[0], y0[1]); w.y = cvt_pk_bf16(y0[2], y0[3]); w.z = cvt_pk_bf16(y1[0], y1[1]); w.w = cvt_pk_bf16(y1[2], y1[3]);
                    *(u32x4*)(XB + off + bj * HALF) = w;
                }
                ss += __shfl_xor(ss, 16); ss += __shfl_xor(ss, 32);
                if (fq == 0) SS[(size_t)row * 16 + u.pn * 4 + wc] = ss;
            }
    }
};
struct EpiSwiglu {
    static constexpr bool AFTER_DRAIN = false;
    bf16_t* H; const float* SS;
    __device__ __forceinline__ void operator()(const Acc& acc, const Unit& u, int wr, int wc, int fr, int fq) const {
        const int row0 = u.pm * BM + wr * 64 + fr, col0 = u.pn * HALF + wc * 32 + 8 * fq;
#pragma unroll
        for (int ai = 0; ai < 2; ++ai)
#pragma unroll
            for (int m = 0; m < 4; ++m) { const int row = row0 + ai * HALF + m * 16; const float rs = row_rs(SS, row);
                float h[8];
#pragma unroll
                for (int n = 0; n < 2; ++n)
#pragma unroll
                    for (int j = 0; j < 4; ++j) { const float gt = acc[ai][0][m][n][j] * rs, up = acc[ai][1][m][n][j] * rs;
                        h[4 * n + j] = gt * __builtin_amdgcn_rcpf(1.0f + __builtin_amdgcn_exp2f(-gt * LOG2E)) * up; }
                u32x4 w; w.x = cvt_pk_bf16(h[0], h[1]); w.y = cvt_pk_bf16(h[2], h[3]); w.z = cvt_pk_bf16(h[4], h[5]); w.w = cvt_pk_bf16(h[6], h[7]);
                *(u32x4*)(H + (size_t)row * DFF + col0) = w; }
    }
};

struct EpiLora {
    static constexpr bool AFTER_DRAIN = false;
    float* W; bf16_t* Kp; const bf16_t* KK; bf16_t* Bv; bf16_t* G; const float* w0; const float* a0; const float* k_a;
    __device__ __forceinline__ void operator()(const Acc& acc, const Unit& u, int wr, int wc, int fr, int fq) const {
        const int region = u.pn >> 1, row0 = u.pm * BM + wr * 64 + fr, c0 = (u.pn & 1) * 256 + wc * 32 + 8 * fq;
#pragma unroll
        for (int ai = 0; ai < 2; ++ai)
#pragma unroll
            for (int m = 0; m < 4; ++m) { const int row = row0 + ai * HALF + m * 16;
#pragma unroll
                for (int bj = 0; bj < 2; ++bj) { const int c = c0 + bj * HALF; const size_t off = (size_t)row * 512 + c;
                    float v[8];
#pragma unroll
                    for (int i = 0; i < 8; ++i) v[i] = acc[ai][bj][m][i >> 2][i & 3];
                    if (region == 0) {
                        float o[8];
#pragma unroll
                        for (int i = 0; i < 8; ++i) { const float z = v[i] + w0[c + i]; const float sg = __builtin_amdgcn_rcpf(1.0f + __expf(-z)); o[i] = -0.6065306597126334f * sg; }
                        *(f32x4*)(W + off) = (f32x4){o[0], o[1], o[2], o[3]}; *(f32x4*)(W + off + 4) = (f32x4){o[4], o[5], o[6], o[7]};
                    } else if (region == 1) {
                        const u32x4 k8 = *(const u32x4*)(Kp + off), q8 = *(const u32x4*)(KK + off);
                        float kn[8], bn[8];
#pragma unroll
                        for (int i = 0; i < 8; ++i) { const float a = __builtin_amdgcn_rcpf(1.0f + __expf(-(v[i] + a0[c + i])));
                            const unsigned kw = k8[i >> 1], qw = q8[i >> 1];
                            const float kf = __builtin_bit_cast(float, (i & 1) ? (kw & 0xffff0000u) : (kw << 16)), qf = __builtin_bit_cast(float, (i & 1) ? (qw & 0xffff0000u) : (qw << 16));
                            kn[i] = kf * (1.0f + (a - 1.0f) * k_a[c + i]); bn[i] = qf * a; }
                        u32x4 w; w.x = cvt_pk_bf16(kn[0], kn[1]); w.y = cvt_pk_bf16(kn[2], kn[3]); w.z = cvt_pk_bf16(kn[4], kn[5]); w.w = cvt_pk_bf16(kn[6], kn[7]);
                        *(u32x4*)(Kp + off) = w;
                        w.x = cvt_pk_bf16(bn[0], bn[1]); w.y = cvt_pk_bf16(bn[2], bn[3]); w.z = cvt_pk_bf16(bn[4], bn[5]); w.w = cvt_pk_bf16(bn[6], bn[7]);
                        *(u32x4*)(Bv + off) = w;
                    } else {
                        u32x4 w; w.x = cvt_pk_bf16(v[0], v[1]); w.y = cvt_pk_bf16(v[2], v[3]); w.z = cvt_pk_bf16(v[4], v[5]); w.w = cvt_pk_bf16(v[6], v[7]);
                        *(u32x4*)(G + off) = w;
                    }
                } }
    }
};
struct EpiGelu {
    static constexpr bool AFTER_DRAIN = false;
    bf16_t* O; const float* cb;
    __device__ __forceinline__ void operator()(const Acc& acc, const Unit& u, int wr, int wc, int fr, int fq) const {
        const int row0 = u.pm * BM + wr * 64 + fr, col0 = u.pn * BM + wc * 32 + 8 * fq;
#pragma unroll
        for (int ai = 0; ai < 2; ++ai)
#pragma unroll
            for (int m = 0; m < 4; ++m) { const int row = row0 + ai * HALF + m * 16;
#pragma unroll
                for (int bj = 0; bj < 2; ++bj) { const int c = col0 + bj * HALF; float o[8];
#pragma unroll
                    for (int i = 0; i < 8; ++i) { const float z = acc[ai][bj][m][i >> 2][i & 3] + cb[c + i];
                        const float t = 0.7978845608028654f * (z + 0.044715f * z * z * z);
                        const float th = 1.0f - 2.0f * __builtin_amdgcn_rcpf(1.0f + __expf(2.0f * t));
                        o[i] = 0.5f * z * (1.0f + th); }
                    u32x4 w; w.x = cvt_pk_bf16(o[0], o[1]); w.y = cvt_pk_bf16(o[2], o[3]); w.z = cvt_pk_bf16(o[4], o[5]); w.w = cvt_pk_bf16(o[6], o[7]);
                    *(u32x4*)(O + (size_t)row * 256 + c) = w; } }
    }
};

struct EpiRowScale {
    static constexpr bool AFTER_DRAIN = false;
    bf16_t* O; const float* SS; float qscale;
    __device__ __forceinline__ void operator()(const Acc& acc, const Unit& u, int wr, int wc, int fr, int fq) const {
        const int row0 = u.pm * BM + wr * 64 + fr, col0 = u.pn * BM + wc * 32 + 8 * fq;
#pragma unroll
        for (int ai = 0; ai < 2; ++ai)
#pragma unroll
            for (int m = 0; m < 4; ++m) { const int row = row0 + ai * HALF + m * 16; const float rs = row_rs(SS, row) * qscale;
#pragma unroll
                for (int bj = 0; bj < 2; ++bj) { const f32x4 v0 = acc[ai][bj][m][0] * rs, v1 = acc[ai][bj][m][1] * rs;
                    u32x4 w; w.x = cvt_pk_bf16(v0[0], v0[1]); w.y = cvt_pk_bf16(v0[2], v0[3]); w.z = cvt_pk_bf16(v1[0], v1[1]); w.w = cvt_pk_bf16(v1[2], v1[3]);
                    *(u32x4*)(O + (size_t)row * D_ + col0 + bj * HALF) = w; } }
    }
};
struct EpiFinalNorm {
    static constexpr bool AFTER_DRAIN = true;
    const bf16_t* baseb; const float* gin; float* out; const float* gain; float* xs; unsigned* cnt;
    __device__ __forceinline__ void fused(Acc& acc, const Unit& u, int wr, int wc, int fr, int fq, LAS unsigned char* lds, int wid, int lane) const {
        LAS float* P = (LAS float*)lds;
        LAS float* S = (LAS float*)(lds + 4096);
        const int row0 = u.pm * BM + wr * 64 + fr, col0 = u.pn * BM + wc * 32 + 8 * fq;
#pragma unroll
        for (int ai = 0; ai < 2; ++ai)
#pragma unroll
            for (int m = 0; m < 4; ++m) { const size_t off = (size_t)(row0 + ai * HALF + m * 16) * D_ + col0; float ss = 0.f;
#pragma unroll
                for (int bj = 0; bj < 2; ++bj) { f32x4 b0, b1; load_base8(nullptr, baseb, rcp4(*(const f32x4*)(gin + col0 + bj * HALF)), rcp4(*(const f32x4*)(gin + col0 + bj * HALF + 4)), true, off + bj * HALF, b0, b1);
                    const f32x4 x0 = b0 + acc[ai][bj][m][0], x1 = b1 + acc[ai][bj][m][1];
                    acc[ai][bj][m][0] = x0; acc[ai][bj][m][1] = x1;
                    ss += (x0[0] * x0[0] + x0[1] * x0[1]) + (x0[2] * x0[2] + x0[3] * x0[3]) + (x1[0] * x1[0] + x1[1] * x1[1]) + (x1[2] * x1[2] + x1[3] * x1[3]); }
                ss += __shfl_xor(ss, 16); ss += __shfl_xor(ss, 32);
                if (fq == 0) P[(ai * HALF + wr * 64 + m * 16 + fr) * 4 + wc] = ss; }
        asm volatile("s_waitcnt lgkmcnt(0)" ::: "memory"); __builtin_amdgcn_s_barrier(); asm volatile("" ::: "memory");
        const int row = wid * 32 + (lane & 31);
        if (lane < 32) { const f32x4 pp = *(const LAS f32x4*)(P + row * 4);
            __hip_atomic_store(xs + (size_t)(u.pm * BM + row) * 4 + u.pn, (pp[0] + pp[1]) + (pp[2] + pp[3]), __ATOMIC_RELAXED, __HIP_MEMORY_SCOPE_AGENT); }
        asm volatile("s_waitcnt vmcnt(0)" ::: "memory");
        if (lane == 0) __hip_atomic_fetch_add(cnt + 64 * u.pm, 1u, __ATOMIC_RELAXED, __HIP_MEMORY_SCOPE_AGENT);
        if (wid == 0) { unsigned sp = 0;
            while ((unsigned)__builtin_amdgcn_readfirstlane(__hip_atomic_load(cnt + 64 * u.pm, __ATOMIC_RELAXED, __HIP_MEMORY_SCOPE_AGENT)) < 32u) { __builtin_amdgcn_s_sleep(2); if (++sp > (1u << 22)) break; }
            __builtin_amdgcn_fence(__ATOMIC_ACQUIRE, "agent"); }
        asm volatile("s_waitcnt vmcnt(0) lgkmcnt(0)" ::: "memory"); __builtin_amdgcn_s_barrier(); asm volatile("" ::: "memory");
        if (lane < 32) { const float* sl = xs + (size_t)(u.pm * BM + row) * 4; float t = 0.f;
#pragma unroll
            for (int k = 0; k < 4; ++k) t += __hip_atomic_load(sl + k, __ATOMIC_RELAXED, __HIP_MEMORY_SCOPE_AGENT);
            S[row] = __builtin_amdgcn_rsqf(t * (1.0f / D_) + RMS_EPS); }
        asm volatile("s_waitcnt lgkmcnt(0)" ::: "memory"); __builtin_amdgcn_s_barrier(); asm volatile("" ::: "memory");
        f32x4 gv[2][2];
#pragma unroll
        for (int bj = 0; bj < 2; ++bj)
#pragma unroll
            for (int n = 0; n < 2; ++n) gv[bj][n] = *(const f32x4*)(gain + col0 + bj * HALF + 4 * n);
#pragma unroll
        for (int ai = 0; ai < 2; ++ai)
#pragma unroll
            for (int m = 0; m < 4; ++m) { const int r = ai * HALF + wr * 64 + m * 16 + fr; const float rs = S[r]; const size_t off = (size_t)(u.pm * BM + r) * D_ + col0;
#pragma unroll
                for (int bj = 0; bj < 2; ++bj) { *(f32x4*)(out + off + bj * HALF) = acc[ai][bj][m][0] * rs * gv[bj][0]; *(f32x4*)(out + off + bj * HALF + 4) = acc[ai][bj][m][1] * rs * gv[bj][1]; } }
    }
};
}

constexpr int NWAVES = 8, NTHREADS = NWAVES * 64;
constexpr int RING_BYTES = 131072, LDS_CTRL = 147456, LDS_BYTES = 151552;
constexpr int N_PHASES = 14;
constexpr int CL = 128, NC = T_ / CL;
constexpr int TS = 8;
constexpr float LNX_EPS = 64e-5f;
constexpr size_t OFF_W = 120 * MiB, OFF_G = 152 * MiB;
constexpr size_t OFF_R = 176 * MiB, OFF_V = 192 * MiB, OFF_KK = 208 * MiB, OFF_KP = 224 * MiB, OFF_B = 240 * MiB;
constexpr size_t OFF_LORA_A = 24 * MiB, OFF_Y = 40 * MiB, OFF_PT = 56 * MiB;

struct Args { const float* in[36]; float* out; unsigned char* ws; int ph_lo, ph_hi; };

struct Frame {
    LAS unsigned char* lds;
    int wave, G, blk;
};

__device__ __forceinline__ int dst_row(int mode, int row_off, int n) {
    if (mode == 0) return row_off + n;
    if (mode == 1) return n < NSA_COLS ? RW_COLS + n : n - NSA_COLS;
    if (mode == 2) return 256 * (n >> 7) + (n & 127);
    return 256 * (n >> 7) + 128 + (n & 127);
}
__device__ __forceinline__ void p0_transpose_item(const float* W, int K, int N, bf16_t* WT, int ldt, int mode, int row_off, LAS float* scr, int item, int lane) {
    const int nblk = (N + 31) / 32, kb = item / nblk, nb = item % nblk, k0 = 64 * kb, n0 = 32 * nb;
    const int nq = n0 + 4 * (lane & 7); f32x4 ld[8];
#pragma unroll
    for (int i = 0; i < 8; ++i) ld[i] = nq < N ? *(const f32x4*)(W + (size_t)(k0 + 8 * i + (lane >> 3)) * N + nq) : (f32x4){0.f, 0.f, 0.f, 0.f};
#pragma unroll
    for (int i = 0; i < 8; ++i) { LAS float* d = scr + (8 * i + (lane >> 3)) * 33 + 4 * (lane & 7); d[0] = ld[i][0]; d[1] = ld[i][1]; d[2] = ld[i][2]; d[3] = ld[i][3]; }
    asm volatile("s_waitcnt lgkmcnt(0)" ::: "memory");
    const int c = lane & 7;
#pragma unroll
    for (int j = 0; j < 4; ++j) { const int n = (lane >> 3) + 8 * j; const LAS float* s = scr + (8 * c) * 33 + n;
        u32x4 o; o.x = pk2(s[0 * 33], s[1 * 33]); o.y = pk2(s[2 * 33], s[3 * 33]); o.z = pk2(s[4 * 33], s[5 * 33]); o.w = pk2(s[6 * 33], s[7 * 33]);
        if (n0 + n < N) *(u32x4*)(WT + (size_t)dst_row(mode, row_off, n0 + n) * ldt + k0 + 8 * c) = o; }
    asm volatile("s_waitcnt lgkmcnt(0)" ::: "memory");
}
__device__ __forceinline__ void rms_row_to_bf16(const float* xrow, const float* gain, bf16_t* orow, int lane) {
    const f32x4* xr = (const f32x4*)xrow + lane; f32x4 v[4]; float s = 0.f;
#pragma unroll
    for (int j = 0; j < 4; ++j) { v[j] = xr[64 * j]; s += (v[j][0] * v[j][0] + v[j][1] * v[j][1]) + (v[j][2] * v[j][2] + v[j][3] * v[j][3]); }
    const float rs = __builtin_amdgcn_rsqf(wave_sum(s) * (1.0f / D_) + RMS_EPS);
#pragma unroll
    for (int j = 0; j < 4; ++j) { const f32x4 g4 = *((const f32x4*)gain + lane + 64 * j); const f32x4 y = v[j] * rs * g4;
        u32x2 w; w.x = pk2(y[0], y[1]); w.y = pk2(y[2], y[3]); *((u32x2*)orow + lane + 64 * j) = w; }
}
__device__ __forceinline__ void unpack8(const u32x4 w, float* f) {
#pragma unroll
    for (int i = 0; i < 4; ++i) { f[2 * i] = __builtin_bit_cast(float, w[i] << 16); f[2 * i + 1] = __builtin_bit_cast(float, w[i] & 0xffff0000u); }
}
__device__ __forceinline__ u32x4 pack8(const float* f) { u32x4 w; w.x = pk2(f[0], f[1]); w.y = pk2(f[2], f[3]); w.z = pk2(f[4], f[5]); w.w = pk2(f[6], f[7]); return w; }

constexpr int RC_PITCH = 144, RC_SLOT = 9216, RC_GROUP = 8 * RC_SLOT;
__device__ __forceinline__ bf16x8 frag_nat(const LAS unsigned char* m, int kb, int col0, int lane) {
    const LAS unsigned char* p = m + (kb + 8 * (lane >> 5) + ((lane & 15) >> 2)) * RC_PITCH + (col0 + 16 * ((lane >> 4) & 1) + 4 * (lane & 3)) * 2;
    const s16x4 lo = vtr(p), hh = vtr(p + 4 * RC_PITCH);
    return (bf16x8){lo[0], lo[1], lo[2], lo[3], hh[0], hh[1], hh[2], hh[3]};
}
__device__ __forceinline__ bf16x8 frag_dir(const LAS unsigned char* m, int row0, int kb, int lane) {
    return *(const LAS bf16x8*)(m + (row0 + (lane & 31)) * RC_PITCH + (kb + 8 * (lane >> 5)) * 2);
}
template <bool TA, bool TB>
__device__ __forceinline__ f32x16 rc_mm(const LAS unsigned char* A, const LAS unsigned char* B, int i0, int j0, f32x16 acc, int lane) {
#pragma unroll
    for (int ks = 0; ks < 4; ++ks) { const bf16x8 a = TA ? frag_nat(A, 16 * ks, i0, lane) : frag_dir(A, i0, 16 * ks, lane), b = TB ? frag_nat(B, 16 * ks, j0, lane) : frag_dir(B, j0, 16 * ks, lane);
        acc = __builtin_amdgcn_mfma_f32_32x32x16_bf16(a, b, acc, 0, 0, 0); }
    return acc;
}
__device__ __forceinline__ void rc_store(LAS unsigned char* m, int i0, int j0, const f32x16& acc, int lane) {
    const int r32 = lane & 31, hi = lane >> 5;
#pragma unroll
    for (int r = 0; r < 16; ++r) *(LAS bf16_t*)(m + (i0 + crow(r, hi)) * RC_PITCH + (j0 + r32) * 2) = (bf16_t)f2bf(acc[r]);
}
#define RC_BAR() asm volatile("s_waitcnt lgkmcnt(0)\n\ts_barrier" ::: "memory")

__device__ __forceinline__ void rwkv_chunk(Frame& F, unsigned char* ws) {
    const float* LW = (const float*)(ws + OFF_W);
    const bf16_t* R = (const bf16_t*)(ws + OFF_R); const bf16_t* V = (const bf16_t*)(ws + OFF_V); const bf16_t* KK = (const bf16_t*)(ws + OFF_KK);
    const bf16_t* KP = (const bf16_t*)(ws + OFF_KP); const bf16_t* Bv = (const bf16_t*)(ws + OFF_B);
    bf16_t* Y = (bf16_t*)(ws + OFF_Y); bf16_t* PT = (bf16_t*)(ws + OFF_PT); float* SUM = (float*)(ws + OFF_SUM);
    const int lane = lane_id(), wave = F.wave, r32 = lane & 31, hi = lane >> 5;
    const int grp = wave >> 2, tw = wave & 3, i0 = (tw >> 1) * 32, j0 = (tw & 1) * 32, gtid = tw * 64 + lane;
    LAS unsigned char* gb = F.lds + grp * RC_GROUP;
#define SLOT(i) (gb + (i) * RC_SLOT)
    LAS float* gCl = (LAS float*)(F.lds + LDS_CTRL) + grp * 64;
    LAS float* clf = (LAS float*)SLOT(4);
    for (int hq = 0; hq < 4; ++hq) {
        const int hc = 4 * F.blk + hq, bh = hc / NC, c = hc % NC, h = bh & 7;
        const size_t m0 = (size_t)(bh >> 3) * T_ + (size_t)c * CL + 64 * grp;
        RC_BAR();
#pragma unroll
        for (int i = 0; i < 4; ++i) { const int t = (gtid >> 4) + 16 * i, c4 = (gtid & 15) * 4; *(LAS f32x4*)(clf + t * 64 + c4) = *(const f32x4*)(LW + (m0 + t) * 512 + h * 64 + c4); }
        RC_BAR();
        if (tw == 0) { float cv[64];
#pragma unroll
            for (int t = 0; t < 64; ++t) cv[t] = clf[t * 64 + lane];
#pragma unroll
            for (int t = 1; t < 64; ++t) cv[t] += cv[t - 1];
#pragma unroll
            for (int t = 0; t < 64; ++t) clf[t * 64 + lane] = cv[t];
            gCl[lane] = __expf(cv[63]); }
        RC_BAR();
        { const int t = gtid >> 2, c0 = (gtid & 3) * 16; const size_t go = (m0 + t) * 512 + h * 64 + c0;
#pragma unroll
          for (int hf = 0; hf < 2; ++hf) { const int cc = c0 + 8 * hf;
              float fk[8], fb[8], fp[8], fr[8]; unpack8(*(const u32x4*)(KK + go + 8 * hf), fk); unpack8(*(const u32x4*)(Bv + go + 8 * hf), fb); unpack8(*(const u32x4*)(KP + go + 8 * hf), fp); unpack8(*(const u32x4*)(R + go + 8 * hf), fr);
              float oa[8], ob[8], ok[8], orr[8];
#pragma unroll
              for (int e = 0; e < 8; ++e) { const float cl = clf[t * 64 + cc + e], clm = t ? clf[(t - 1) * 64 + cc + e] : 0.f;
                  const float ep = __expf(cl), en = __builtin_amdgcn_rcpf(ep);
                  oa[e] = -fk[e] * __expf(clm); ob[e] = fb[e] * en; ok[e] = fp[e] * en; orr[e] = fr[e] * ep; }
              *(LAS u32x4*)(SLOT(0) + t * RC_PITCH + cc * 2) = pack8(oa); *(LAS u32x4*)(SLOT(1) + t * RC_PITCH + cc * 2) = pack8(ob);
              *(LAS u32x4*)(SLOT(2) + t * RC_PITCH + cc * 2) = pack8(ok); *(LAS u32x4*)(SLOT(3) + t * RC_PITCH + cc * 2) = pack8(orr); } }
        RC_BAR();
        f32x16 Tacc;
        { f32x16 lab = rc_mm<false, false>(SLOT(1), SLOT(0), i0, j0, (f32x16){}, lane), lka = rc_mm<false, false>(SLOT(2), SLOT(0), i0, j0, (f32x16){}, lane);
#pragma unroll
          for (int r = 0; r < 16; ++r) { const int sI = i0 + crow(r, hi), tJ = j0 + r32; const bool keep = sI < tJ; lab[r] = keep ? lab[r] : 0.f; lka[r] = keep ? lka[r] : 0.f; Tacc[r] = lab[r] + (sI == tJ ? 1.f : 0.f); }
          rc_store(SLOT(4), i0, j0, lab, lane); rc_store(SLOT(5), i0, j0, lka, lane); rc_store(SLOT(6), i0, j0, Tacc, lane); }
        RC_BAR();
#pragma unroll 1
        for (int itn = 0; itn < 5; ++itn) {
            LAS unsigned char* Pc = (itn & 1) ? SLOT(7) : SLOT(4); LAS unsigned char* Pn = (itn & 1) ? SLOT(4) : SLOT(7);
            { const f32x16 pn = rc_mm<false, true>(Pc, Pc, i0, j0, (f32x16){}, lane); rc_store(Pn, i0, j0, pn, lane); }
            RC_BAR();
            Tacc = rc_mm<false, true>(SLOT(6), Pn, i0, j0, Tacc, lane);
            RC_BAR();
            rc_store(SLOT(6), i0, j0, Tacc, lane);
        }
        { const int t = gtid >> 2, c0 = (gtid & 3) * 16; const size_t go = (m0 + t) * 512 + h * 64 + c0;
          *(LAS u32x4*)(SLOT(7) + t * RC_PITCH + c0 * 2) = *(const u32x4*)(V + go); *(LAS u32x4*)(SLOT(7) + t * RC_PITCH + c0 * 2 + 16) = *(const u32x4*)(V + go + 8); }
        RC_BAR();
        { const f32x16 z = rc_mm<true, true>(SLOT(5), SLOT(7), i0, j0, (f32x16){}, lane); rc_store(SLOT(4), i0, j0, z, lane); }
        RC_BAR();
        { const f32x16 a2 = rc_mm<true, true>(SLOT(6), SLOT(0), i0, j0, (f32x16){}, lane); rc_store(SLOT(5), i0, j0, a2, lane); }
        RC_BAR();
        { const f32x16 w1 = rc_mm<true, true>(SLOT(6), SLOT(4), i0, j0, (f32x16){}, lane); rc_store(SLOT(0), i0, j0, w1, lane); }
        RC_BAR();
        { f32x16 mb = rc_mm<false, false>(SLOT(1), SLOT(3), i0, j0, (f32x16){}, lane), mk = rc_mm<false, false>(SLOT(2), SLOT(3), i0, j0, (f32x16){}, lane);
#pragma unroll
          for (int r = 0; r < 16; ++r) { const bool keep = (i0 + crow(r, hi)) <= (j0 + r32); mb[r] = keep ? mb[r] : 0.f; mk[r] = keep ? mk[r] : 0.f; }
          rc_store(SLOT(4), i0, j0, mb, lane); rc_store(SLOT(6), i0, j0, mk, lane); }
        RC_BAR();
        f32x16 qm = rc_mm<true, true>(SLOT(4), SLOT(5), i0, j0, (f32x16){}, lane);
        f32x16 yl = rc_mm<true, true>(SLOT(6), SLOT(7), i0, j0, rc_mm<true, true>(SLOT(4), SLOT(0), i0, j0, (f32x16){}, lane), lane);
        f32x16 gg = rc_mm<true, true>(SLOT(5), SLOT(1), i0, j0, (f32x16){}, lane);
        f32x16 hh = rc_mm<true, true>(SLOT(7), SLOT(2), i0, j0, rc_mm<true, true>(SLOT(0), SLOT(1), i0, j0, (f32x16){}, lane), lane);
        { const float gc = gCl[j0 + r32];
#pragma unroll
          for (int r = 0; r < 16; ++r) { const int iI = i0 + crow(r, hi), jJ = j0 + r32;
              qm[r] += bf2f(*(const LAS bf16_t*)(SLOT(3) + iI * RC_PITCH + jJ * 2));
              gg[r] = (gg[r] + (iI == jJ ? 1.f : 0.f)) * gc; hh[r] *= gc; } }
        RC_BAR();
        { LAS float* f32m = (LAS float*)(F.lds + (grp ? 34816 : 0));
#pragma unroll
          for (int r = 0; r < 16; ++r) { const int iI = i0 + crow(r, hi), jJ = j0 + r32; f32m[iI * 68 + jJ] = gg[r]; f32m[4352 + iI * 68 + jJ] = hh[r]; }
          if (grp == 0) { rc_store(F.lds + 73728, i0, j0, gg, lane); rc_store(F.lds + 82944, i0, j0, hh, lane);
#pragma unroll
              for (int r = 0; r < 16; ++r) { const size_t o = (m0 + i0 + crow(r, hi)) * 512 + h * 64 + j0 + r32; PT[o] = (bf16_t)f2bf(qm[r]); Y[o] = (bf16_t)f2bf(yl[r]); } }
          else rc_store(F.lds + 92160, i0, j0, qm, lane); }
        RC_BAR();
        if (grp == 1) {
            const f32x16 q2 = rc_mm<false, false>(F.lds + 92160, F.lds + 73728, i0, j0, (f32x16){}, lane);
            yl = rc_mm<false, false>(F.lds + 92160, F.lds + 82944, i0, j0, yl, lane);
#pragma unroll
            for (int r = 0; r < 16; ++r) { const size_t o = (m0 + i0 + crow(r, hi)) * 512 + h * 64 + j0 + r32; PT[o] = (bf16_t)f2bf(q2[r]); Y[o] = (bf16_t)f2bf(yl[r]); }
        }
        {
            const LAS float* Am = (const LAS float*)(F.lds + (grp ? 17408 : 0)); const LAS float* Bm = (const LAS float*)(F.lds + 34816); const LAS float* Hb = (const LAS float*)(F.lds + 52224);
            const int iR = gtid >> 2, jq = (gtid & 3) * 16;
            float acc[16];
#pragma unroll
            for (int e = 0; e < 16; ++e) acc[e] = grp ? Hb[iR * 68 + jq + e] : 0.f;
#pragma unroll 4
            for (int k = 0; k < 64; ++k) { const float a = Am[iR * 68 + k];
#pragma unroll
                for (int q4 = 0; q4 < 4; ++q4) { const f32x4 b4 = *(const LAS f32x4*)(Bm + k * 68 + jq + 4 * q4); acc[4 * q4] += a * b4[0]; acc[4 * q4 + 1] += a * b4[1]; acc[4 * q4 + 2] += a * b4[2]; acc[4 * q4 + 3] += a * b4[3]; } }
            float* dst = SUM + (size_t)hc * 8192 + (grp ? 0 : 4096) + iR * 64 + jq;
#pragma unroll
            for (int q4 = 0; q4 < 4; ++q4) *(f32x4*)(dst + 4 * q4) = (f32x4){acc[4 * q4], acc[4 * q4 + 1], acc[4 * q4 + 2], acc[4 * q4 + 3]};
        }
    }
    RC_BAR();
#undef SLOT
}
#undef RC_BAR

__device__ __forceinline__ void rwkv_combine(Frame& F, unsigned char* ws, int bh) {
    float* SUM = (float*)(ws + OFF_SUM);
    LAS float* Sl = (LAS float*)F.lds;
    LAS float* Pl = (LAS float*)(F.lds + 20480);
    const int tid = F.wave * 64 + lane_id(), v = tid >> 3, kq = tid & 7;
    float cur[8];
#pragma unroll
    for (int i = 0; i < 8; ++i) cur[i] = 0.f;
    for (int c = 0; c < NC; ++c) {
        const size_t hc = (size_t)bh * NC + c;
        const float* pc = SUM + (hc * 2 + 1) * 4096 + tid * 8;
        *(LAS f32x4*)(Pl + tid * 8) = *(const f32x4*)pc; *(LAS f32x4*)(Pl + tid * 8 + 4) = *(const f32x4*)(pc + 4);
#pragma unroll
        for (int i = 0; i < 8; ++i) Sl[v * 65 + 8 * kq + i] = cur[i];
        float* se = SUM + (hc * 2) * 4096 + v * 64 + 8 * kq;
        const f32x4 e0 = *(const f32x4*)se, e1 = *(const f32x4*)(se + 4);
        *(f32x4*)se = (f32x4){cur[0], cur[1], cur[2], cur[3]}; *(f32x4*)(se + 4) = (f32x4){cur[4], cur[5], cur[6], cur[7]};
        __syncthreads();
        float acc[8] = {e0[0], e0[1], e0[2], e0[3], e1[0], e1[1], e1[2], e1[3]};
#pragma unroll 8
        for (int j = 0; j < 64; ++j) { const float s = Sl[v * 65 + j]; const f32x4 p0 = *(const LAS f32x4*)(Pl + j * 64 + 8 * kq), p1 = *(const LAS f32x4*)(Pl + j * 64 + 8 * kq + 4);
            acc[0] += s * p0[0]; acc[1] += s * p0[1]; acc[2] += s * p0[2]; acc[3] += s * p0[3]; acc[4] += s * p1[0]; acc[5] += s * p1[1]; acc[6] += s * p1[2]; acc[7] += s * p1[3]; }
        __syncthreads();
#pragma unroll
        for (int i = 0; i < 8; ++i) cur[i] = acc[i];
    }
}
__device__ __forceinline__ void rwkv_fixup_task(unsigned char* ws, const float* lnx_w, const float* lnx_b, const float* r_k, int hc, int tl, int lane) {
    const bf16_t* R = (const bf16_t*)(ws + OFF_R); const bf16_t* V = (const bf16_t*)(ws + OFF_V); const bf16_t* KP = (const bf16_t*)(ws + OFF_KP);
    const bf16_t* G = (const bf16_t*)(ws + OFF_G); const bf16_t* Y = (const bf16_t*)(ws + OFF_Y); const bf16_t* PT = (const bf16_t*)(ws + OFF_PT);
    const float* S = (const float*)(ws + OFF_SUM) + (size_t)hc * 8192; bf16_t* MIX = (bf16_t*)(ws + OFF_PNSA);
    const int r32 = lane & 31, hi = lane >> 5, bh = hc / NC, c = hc % NC, h = bh & 7;
    const size_t m = (size_t)(bh >> 3) * T_ + (size_t)c * CL + 32 * tl + r32;
    const size_t row = m * 512 + h * 64;
    f32x16 acc[2]; acc[0] = (f32x16){}; acc[1] = (f32x16){};
#pragma unroll
    for (int ks = 0; ks < 4; ++ks) {
        const bf16x8 bfrag = *(const bf16x8*)(PT + row + 16 * ks + 8 * hi);
#pragma unroll
        for (int vt = 0; vt < 2; ++vt) { const float* sp = S + (size_t)(32 * vt + r32) * 64 + 16 * ks + 8 * hi; const f32x4 s0 = *(const f32x4*)sp, s1 = *(const f32x4*)(sp + 4);
            u32x4 w; w.x = pk2(s0[0], s0[1]); w.y = pk2(s0[2], s0[3]); w.z = pk2(s1[0], s1[1]); w.w = pk2(s1[2], s1[3]);
            acc[vt] = __builtin_amdgcn_mfma_f32_32x32x16_bf16(__builtin_bit_cast(bf16x8, w), bfrag, acc[vt], 0, 0, 0); }
    }
    float y[32], s1 = 0.f, rkdot = 0.f;
#pragma unroll
    for (int gq = 0; gq < 8; ++gq) { const int vo = 32 * (gq >> 2) + 8 * (gq & 3) + 4 * hi;
        if (gq == 4) __builtin_amdgcn_sched_barrier(0);
        const u32x2 yw = *(const u32x2*)(Y + row + vo), rw = *(const u32x2*)(R + row + vo), kw = *(const u32x2*)(KP + row + vo); const f32x4 rk4 = *(const f32x4*)(r_k + h * 64 + vo);
#pragma unroll
        for (int j = 0; j < 4; ++j) { const unsigned yu = j < 2 ? yw.x : yw.y, ru = j < 2 ? rw.x : rw.y, ku = j < 2 ? kw.x : kw.y;
            const float yl = __builtin_bit_cast(float, (j & 1) ? (yu & 0xffff0000u) : (yu << 16)), rf = __builtin_bit_cast(float, (j & 1) ? (ru & 0xffff0000u) : (ru << 16)), kf = __builtin_bit_cast(float, (j & 1) ? (ku & 0xffff0000u) : (ku << 16));
            const float yy = acc[gq >> 2][4 * (gq & 3) + j] + yl; y[4 * gq + j] = yy; s1 += yy; rkdot += rf * kf * rk4[j]; } }
    s1 += __shfl_xor(s1, 32); rkdot += __shfl_xor(rkdot, 32);
    const float mean = s1 * (1.0f / 64.0f); float s2 = 0.f;
#pragma unroll
    for (int i = 0; i < 32; ++i) { y[i] -= mean; s2 += y[i] * y[i]; }
    s2 += __shfl_xor(s2, 32);
    const float rstd = __builtin_amdgcn_rsqf(s2 * (1.0f / 64.0f) + LNX_EPS);
#pragma unroll
    for (int gq = 0; gq < 8; ++gq) { const int vo = 32 * (gq >> 2) + 8 * (gq & 3) + 4 * hi;
        const u32x2 vw = *(const u32x2*)(V + row + vo), gw_ = *(const u32x2*)(G + row + vo); const f32x4 lw4 = *(const f32x4*)(lnx_w + h * 64 + vo), lb4 = *(const f32x4*)(lnx_b + h * 64 + vo);
        float o4[4];
#pragma unroll
        for (int j = 0; j < 4; ++j) { const unsigned vu = j < 2 ? vw.x : vw.y, gu = j < 2 ? gw_.x : gw_.y;
            const float vf = __builtin_bit_cast(float, (j & 1) ? (vu & 0xffff0000u) : (vu << 16)), gf = __builtin_bit_cast(float, (j & 1) ? (gu & 0xffff0000u) : (gu << 16));
            o4[j] = (y[4 * gq + j] * rstd * lw4[j] + lb4[j] + rkdot * vf) * gf; }
        u32x2 w; w.x = pk2(o4[0], o4[1]); w.y = pk2(o4[2], o4[3]);
        *(u32x2*)(MIX + m * PN_LD + 512 + h * 64 + vo) = w; }
}

__device__ __forceinline__ bf16x8 v_frag(const LAS unsigned char* vbase, int VP, int kb, int dcol0, int lane) {
    const int hi = lane >> 5;
    const LAS unsigned char* p = vbase + (kb + 4 * hi + ((lane & 15) >> 2)) * VP + (dcol0 + 16 * ((lane >> 4) & 1) + 4 * (lane & 3)) * 2;
    const s16x4 lo = vtr(p), hh = vtr(p + 8 * VP);
    return (bf16x8){lo[0], lo[1], lo[2], lo[3], hh[0], hh[1], hh[2], hh[3]};
}
typedef __bf16 bf16x2_t __attribute__((ext_vector_type(2)));
__device__ __forceinline__ unsigned cvtpk(float lo, float hi) { const f32x2 v = {lo, hi}; return __builtin_bit_cast(unsigned, __builtin_convertvector(v, bf16x2_t)); }
__device__ __forceinline__ bf16x8 p_frag(const f32x16& p, int s) {
    u32x4 w; w.x = cvtpk(p[8 * s + 0], p[8 * s + 1]); w.y = cvtpk(p[8 * s + 2], p[8 * s + 3]); w.z = cvtpk(p[8 * s + 4], p[8 * s + 5]); w.w = cvtpk(p[8 * s + 6], p[8 * s + 7]);
    return __builtin_bit_cast(bf16x8, w);
}
__device__ __forceinline__ float max16(const f32x16& p) { float m = p[0];
#pragma unroll
    for (int r = 1; r < 16; ++r) m = fmaxf(m, p[r]);
    return m; }
__device__ __forceinline__ float sum16(const f32x16& p) { float a = 0.f;
#pragma unroll
    for (int r = 0; r < 16; ++r) a += p[r];
    return a; }

constexpr int XK_PITCH = 528, XV_PITCH = 144;
__device__ __forceinline__ void xattn_unit(Frame& F, const bf16_t* Q2, const bf16_t* KVX, bf16_t* XO, int b, int h4, int qt) {
    const int lane = lane_id(), wave = F.wave, tid = wave * 64 + lane, r32 = lane & 31, hi = lane >> 5;
    LAS unsigned char* kl = F.lds;
    LAS float* wsf = (LAS float*)(F.lds + 40960) + wave * 32;
    const size_t qrow = (size_t)b * T_ + (size_t)qt * 256 + wave * 32 + r32;
    bf16x8 qr[16];
#pragma unroll
    for (int ds = 0; ds < 16; ++ds) qr[ds] = *(const bf16x8*)(Q2 + qrow * D_ + h4 * 256 + 16 * ds + 8 * hi);
    const bf16_t* kg = KVX + (size_t)b * 256 * 2048 + h4 * 256;
    const bf16_t* vg = kg + 1024;
    float mref = 0.f, lrow = 0.f;
    bf16x8 PA[4][4];
    u32x4 pre[4];
#define XA_LOADK(kt_) do { _Pragma("unroll") for (int it = 0; it < 4; ++it) { const int idx = it * 512 + tid, row = idx >> 5, ch = idx & 31; pre[it] = *(const u32x4*)(kg + (size_t)((kt_) * 64 + row) * 2048 + ch * 8); } } while (0)
#define XA_WRITEK() do { _Pragma("unroll") for (int it = 0; it < 4; ++it) { const int idx = it * 512 + tid, row = idx >> 5, ch = idx & 31; *(LAS u32x4*)(kl + row * XK_PITCH + ch * 16) = pre[it]; } } while (0)
#define XA_LOADV(ds_) do { _Pragma("unroll") for (int it = 0; it < 4; ++it) { const int idx = it * 512 + tid, row = idx >> 3, ch = idx & 7; pre[it] = *(const u32x4*)(vg + (size_t)row * 2048 + (ds_) * 64 + ch * 8); } } while (0)
#define XA_WRITEV() do { _Pragma("unroll") for (int it = 0; it < 4; ++it) { const int idx = it * 512 + tid, row = idx >> 3, ch = idx & 7; *(LAS u32x4*)(kl + row * XV_PITCH + ch * 16) = pre[it]; } } while (0)
    __syncthreads();
    XA_LOADK(0); XA_WRITEK();
    __syncthreads();
#pragma unroll
    for (int kt = 0; kt < 4; ++kt) {
        if (kt < 3) XA_LOADK(kt + 1); else XA_LOADV(0);
        f32x16 p0 = {}, p1 = {};
#pragma unroll
        for (int ds = 0; ds < 16; ++ds) {
            const bf16x8 a0 = *(const LAS bf16x8*)(kl + r32 * XK_PITCH + (16 * ds + 8 * hi) * 2), a1 = *(const LAS bf16x8*)(kl + (32 + r32) * XK_PITCH + (16 * ds + 8 * hi) * 2);
            p0 = __builtin_amdgcn_mfma_f32_32x32x16_bf16(a0, qr[ds], p0, 0, 0, 0); p1 = __builtin_amdgcn_mfma_f32_32x32x16_bf16(a1, qr[ds], p1, 0, 0, 0); }
        float tmax = fmaxf(max16(p0), max16(p1)); tmax = fmaxf(tmax, __shfl_xor(tmax, 32));
        if (kt == 0) mref = tmax;
        else if (__any(tmax > mref + 16.0f)) {
            const float mnew = fmaxf(mref, tmax), alpha = __builtin_amdgcn_exp2f(mref - mnew);
            lrow *= alpha; mref = mnew;
#pragma unroll
            for (int kk = 0; kk < 4; ++kk) if (kk < kt) {
#pragma unroll
                for (int ks = 0; ks < 4; ++ks) { float f[8]; unpack8(__builtin_bit_cast(u32x4, PA[kk][ks]), f);
#pragma unroll
                    for (int e = 0; e < 8; ++e) f[e] *= alpha;
                    PA[kk][ks] = __builtin_bit_cast(bf16x8, pack8(f)); } }
        }
#pragma unroll
        for (int r = 0; r < 16; ++r) { p0[r] = __builtin_amdgcn_exp2f(p0[r] - mref); p1[r] = __builtin_amdgcn_exp2f(p1[r] - mref); }
        lrow += sum16(p0) + sum16(p1);
        PA[kt][0] = p_frag(p0, 0); PA[kt][1] = p_frag(p0, 1); PA[kt][2] = p_frag(p1, 0); PA[kt][3] = p_frag(p1, 1);
        __syncthreads();
        if (kt < 3) XA_WRITEK(); else XA_WRITEV();
        __syncthreads();
    }
    lrow += __shfl_xor(lrow, 32);
    if (hi == 0) wsf[r32] = __builtin_amdgcn_rcpf(lrow);
    asm volatile("s_waitcnt lgkmcnt(0)" ::: "memory");
#pragma unroll 1
    for (int dsl = 0; dsl < 4; ++dsl) {
        if (dsl < 3) XA_LOADV(dsl + 1);
        LAS unsigned char* ost = F.lds + 45056 + wave * 4608;
#pragma unroll
        for (int d0 = 0; d0 < 2; ++d0) {
            f32x16 o = {};
#pragma unroll
            for (int kt = 0; kt < 4; ++kt)
#pragma unroll
                for (int ks = 0; ks < 4; ++ks) o = __builtin_amdgcn_mfma_f32_32x32x16_bf16(PA[kt][ks], v_frag(kl, XV_PITCH, kt * 64 + 16 * ks, 32 * d0, lane), o, 0, 0, 0);
#pragma unroll
            for (int r = 0; r < 16; ++r) { const int q = crow(r, hi); *(LAS bf16_t*)(ost + q * 144 + (32 * d0 + r32) * 2) = (bf16_t)f2bf(o[r] * wsf[q]); }
        }
        asm volatile("s_waitcnt lgkmcnt(0)" ::: "memory");
#pragma unroll
        for (int i = 0; i < 4; ++i) { const int row = i * 8 + (lane >> 3), ch = lane & 7; *(u32x4*)(XO + (unsigned)(((b * T_ + qt * 256 + wave * 32 + row) * D_) + h4 * 256 + dsl * 64 + ch * 8)) = *(const LAS u32x4*)(ost + row * 144 + ch * 16); }
        __syncthreads();
        if (dsl < 3) XA_WRITEV();
        __syncthreads();
    }
#undef XA_LOADK
#undef XA_WRITEK
#undef XA_LOADV
#undef XA_WRITEV
}

constexpr int NK_PITCH = 128, NT_SLOT = 16384;
constexpr int NS_N = 2668, NW_N = 644;
constexpr int NL_IMP = 32768, NL_LUTS = 66560, NL_LUTW = 109248, NL_NEG = 119552, NL_SELM = 120064, NL_WSF = 121088, NL_B31 = 125184;
constexpr int IMP_PITCH = 132;

__device__ __forceinline__ void nsa_bias_cmp(f32x16& p0, f32x16& p1, const LAS float* lutsg, int db) {
    const int base = NS_N - 69 - db;
#pragma unroll
    for (int r = 0; r < 16; ++r) { const int kc = (r & 3) + 8 * (r >> 2);
        p0[r] += lutsg[min(base + 16 * kc, NS_N - 1)]; p1[r] += lutsg[min(base + 16 * (kc + 32), NS_N - 1)]; }
}
__device__ __forceinline__ void nsa_bias_tab(f32x16& p0, f32x16& p1, const LAS float* tab) {
#pragma unroll
    for (int r = 0; r < 16; ++r) { const int kc = (r & 3) + 8 * (r >> 2);
        p0[r] += tab[kc]; p1[r] += tab[kc + 32]; }
}
__device__ __forceinline__ void nsa_bias_const(f32x16& p0, f32x16& p1, float rt) {
#pragma unroll
    for (int r = 0; r < 16; ++r) { p0[r] += rt; p1[r] += rt; }
}
__device__ __forceinline__ void nsa_online(f32x16& p0, f32x16& p1, float& mrow, float& lrow, f32x16* o, LAS float* wsf, int hi, int r32) {
    float tmax = fmaxf(max16(p0), max16(p1)); tmax = fmaxf(tmax, __shfl_xor(tmax, 32));
    if (__any(tmax > mrow + 8.0f)) {
        const float mnew = fmaxf(mrow, tmax), msafe = (mnew == -INFINITY) ? 0.f : mnew;
        const float alpha = __builtin_amdgcn_exp2f(mrow - msafe);
        lrow *= alpha;
        if (o != nullptr) {
            if (hi == 0) wsf[r32] = alpha;
            asm volatile("s_waitcnt lgkmcnt(0)" ::: "memory");
#pragma unroll
            for (int r = 0; r < 16; ++r) { const float a = wsf[crow(r, hi)]; o[0][r] *= a; o[1][r] *= a; }
            asm volatile("s_waitcnt lgkmcnt(0)" ::: "memory");
        }
        mrow = mnew;
    }
    const float mref = (mrow == -INFINITY) ? 0.f : mrow;
#pragma unroll
    for (int r = 0; r < 16; ++r) { p0[r] = __builtin_amdgcn_exp2f(p0[r] - mref); p1[r] = __builtin_amdgcn_exp2f(p1[r] - mref); }
    lrow += (sum16(p0) + sum16(p1));
}
__device__ __forceinline__ void nsa_resc(float& mref, float psum, float& lrow, f32x16* o, LAS float* wsf, int hi, int r32) {
    if (__any(psum > 16384.0f)) {
        const float d = psum > 16384.0f ? __builtin_amdgcn_logf(psum) : 0.f, alpha = __builtin_amdgcn_exp2f(-d);
        lrow *= alpha; mref += d;
        if (hi == 0) wsf[r32] = alpha;
        asm volatile("s_waitcnt lgkmcnt(0)" ::: "memory");
#pragma unroll
        for (int r = 0; r < 16; ++r) { const float a = wsf[crow(r, hi)]; o[0][r] *= a; o[1][r] *= a; }
        asm volatile("s_waitcnt lgkmcnt(0)" ::: "memory");
    }
}
__device__ __forceinline__ int nsa_swz(int row) { const int x = (row >> 1) & 7; return ((x & 1) << 2) | (x & 2) | ((x >> 2) & 1); }
__device__ __forceinline__ void nsa_dma(const bf16_t* src, int pitch, LAS unsigned char* dst, int wave, int lane) {
    const int row = 8 * wave + (lane >> 3), c = (lane & 7) ^ nsa_swz(row);
    __builtin_amdgcn_global_load_lds((const unsigned*)(src + (size_t)row * pitch + c * 8), (LAS unsigned*)(dst + wave * 1024), 16, 0, 0);
}
__device__ __forceinline__ void nsa_qk(f32x16& p0, f32x16& p1, const LAS unsigned char* kl, const bf16x8* qr, int r32, int hi) {
    p0 = (f32x16){}; p1 = (f32x16){};
#pragma unroll
    for (int ds = 0; ds < 4; ++ds) {
        const int co = (((2 * ds + hi) ^ nsa_swz(r32)) << 4);
        const bf16x8 a0 = *(const LAS bf16x8*)(kl + r32 * NK_PITCH + co), a1 = *(const LAS bf16x8*)(kl + (32 + r32) * NK_PITCH + co);
        p0 = __builtin_amdgcn_mfma_f32_32x32x16_bf16(a0, qr[ds], p0, 0, 0, 0); p1 = __builtin_amdgcn_mfma_f32_32x32x16_bf16(a1, qr[ds], p1, 0, 0, 0); }
}
__device__ __forceinline__ void nsa_kfrags(bf16x8* ka, const LAS unsigned char* kl, int r32, int hi) {
#pragma unroll
    for (int ds = 0; ds < 4; ++ds) { const int co = (((2 * ds + hi) ^ nsa_swz(r32)) << 4);
        ka[2 * ds] = *(const LAS bf16x8*)(kl + r32 * NK_PITCH + co); ka[2 * ds + 1] = *(const LAS bf16x8*)(kl + (32 + r32) * NK_PITCH + co); }
}
__device__ __forceinline__ void nsa_qk_frags(f32x16& p0, f32x16& p1, const bf16x8* ka, const bf16x8* qr) {
    p0 = (f32x16){}; p1 = (f32x16){};
#pragma unroll
    for (int ds = 0; ds < 4; ++ds) { p0 = __builtin_amdgcn_mfma_f32_32x32x16_bf16(ka[2 * ds], qr[ds], p0, 0, 0, 0); p1 = __builtin_amdgcn_mfma_f32_32x32x16_bf16(ka[2 * ds + 1], qr[ds], p1, 0, 0, 0); }
}
__device__ __forceinline__ bf16x8 nsa_vfrag(const LAS unsigned char* vl, int kb, int d0, int lane) {
    const int hi = lane >> 5, row0 = 4 * hi + ((lane & 15) >> 2), chunk = 4 * d0 + 2 * ((lane >> 4) & 1) + ((lane & 3) >> 1), within = (lane & 1) * 8;
    const LAS unsigned char* pa = vl + (kb + row0) * NK_PITCH + ((chunk ^ nsa_swz(row0)) << 4) + within;
    const LAS unsigned char* pb = vl + (kb + row0 + 8) * NK_PITCH + ((chunk ^ nsa_swz(row0 + 8)) << 4) + within;
    const s16x4 lo = vtr(pa), hh = vtr(pb);
    return (bf16x8){lo[0], lo[1], lo[2], lo[3], hh[0], hh[1], hh[2], hh[3]};
}
__device__ __forceinline__ void nsa_pv(f32x16* o, const f32x16& p0, const f32x16& p1, const LAS unsigned char* vl, int lane) {
    const bf16x8 a0 = p_frag(p0, 0), a1 = p_frag(p0, 1), a2 = p_frag(p1, 0), a3 = p_frag(p1, 1);
#pragma unroll
    for (int d0 = 0; d0 < 2; ++d0) {
        o[d0] = __builtin_amdgcn_mfma_f32_32x32x16_bf16(a0, nsa_vfrag(vl, 0, d0, lane), o[d0], 0, 0, 0);
        o[d0] = __builtin_amdgcn_mfma_f32_32x32x16_bf16(a1, nsa_vfrag(vl, 16, d0, lane), o[d0], 0, 0, 0);
        o[d0] = __builtin_amdgcn_mfma_f32_32x32x16_bf16(a2, nsa_vfrag(vl, 32, d0, lane), o[d0], 0, 0, 0);
        o[d0] = __builtin_amdgcn_mfma_f32_32x32x16_bf16(a3, nsa_vfrag(vl, 48, d0, lane), o[d0], 0, 0, 0); }
}
typedef unsigned u32x2 __attribute__((ext_vector_type(2)));
__device__ __forceinline__ s16x4 nsa_cfrag(float c, int hi) {
    const unsigned ch = f2bf(c); const float rem = c - bf2f((bf16_t)ch); const unsigned cl = (c == -INFINITY) ? 0u : f2bf(rem);
    const unsigned w0 = hi ? 0u : (ch | (cl << 16));
    return __builtin_bit_cast(s16x4, (u32x2){w0, 0u});
}
__device__ __forceinline__ s16x4 nsa_onesfrag() { return __builtin_bit_cast(s16x4, (u32x2){0x3F803F80u, 0x3F803F80u}); }
__device__ __forceinline__ void nsa_qk_frags_c(f32x16& p0, f32x16& p1, const bf16x8* ka, const bf16x8* qr, s16x4 cf) {
    p0 = __builtin_amdgcn_mfma_f32_32x32x8bf16_1k(nsa_onesfrag(), cf, (f32x16){}, 0, 0, 0); p1 = __builtin_amdgcn_mfma_f32_32x32x8bf16_1k(nsa_onesfrag(), cf, (f32x16){}, 0, 0, 0);
#pragma unroll
    for (int ds = 0; ds < 4; ++ds) { p0 = __builtin_amdgcn_mfma_f32_32x32x16_bf16(ka[2 * ds], qr[ds], p0, 0, 0, 0); p1 = __builtin_amdgcn_mfma_f32_32x32x16_bf16(ka[2 * ds + 1], qr[ds], p1, 0, 0, 0); }
}
__device__ __forceinline__ void nsa_qk_c(f32x16& p0, f32x16& p1, const LAS unsigned char* kl, const bf16x8* qr, int r32, int hi, s16x4 cf) {
    p0 = __builtin_amdgcn_mfma_f32_32x32x8bf16_1k(nsa_onesfrag(), cf, (f32x16){}, 0, 0, 0); p1 = __builtin_amdgcn_mfma_f32_32x32x8bf16_1k(nsa_onesfrag(), cf, (f32x16){}, 0, 0, 0);
#pragma unroll
    for (int ds = 0; ds < 4; ++ds) {
        const int co = (((2 * ds + hi) ^ nsa_swz(r32)) << 4);
        const bf16x8 a0 = *(const LAS bf16x8*)(kl + r32 * NK_PITCH + co), a1 = *(const LAS bf16x8*)(kl + (32 + r32) * NK_PITCH + co);
        p0 = __builtin_amdgcn_mfma_f32_32x32x16_bf16(a0, qr[ds], p0, 0, 0, 0); p1 = __builtin_amdgcn_mfma_f32_32x32x16_bf16(a1, qr[ds], p1, 0, 0, 0); }
}
__device__ __forceinline__ float nsa_tile_exp_plain(f32x16& p0, f32x16& p1) {
#pragma unroll
    for (int r = 0; r < 16; ++r) { p0[r] = __builtin_amdgcn_exp2f(p0[r]); p1[r] = __builtin_amdgcn_exp2f(p1[r]); }
    return sum16(p0) + sum16(p1);
}
__device__ __forceinline__ float nsa_tile_exp_tab0(f32x16& p0, f32x16& p1, const LAS float* tab) {
#pragma unroll
    for (int r = 0; r < 16; ++r) { const int kc = (r & 3) + 8 * (r >> 2); p0[r] = __builtin_amdgcn_exp2f(p0[r] + tab[kc]); p1[r] = __builtin_amdgcn_exp2f(p1[r] + tab[kc + 32]); }
    return sum16(p0) + sum16(p1);
}
__device__ __forceinline__ void nsa_tile_exp_only(f32x16& p0, f32x16& p1) {
#pragma unroll
    for (int r = 0; r < 16; ++r) { p0[r] = __builtin_amdgcn_exp2f(p0[r]); p1[r] = __builtin_amdgcn_exp2f(p1[r]); }
}
__device__ __forceinline__ void nsa_tile_exp_tab_only(f32x16& p0, f32x16& p1, const LAS float* tab) {
#pragma unroll
    for (int r = 0; r < 16; ++r) { const int kc = (r & 3) + 8 * (r >> 2); p0[r] = __builtin_amdgcn_exp2f(p0[r] + tab[kc]); p1[r] = __builtin_amdgcn_exp2f(p1[r] + tab[kc + 32]); }
}
__device__ __forceinline__ float nsa_tile_exp_const(f32x16& p0, f32x16& p1, float c) {
#pragma unroll
    for (int r = 0; r < 16; ++r) { p0[r] = __builtin_amdgcn_exp2f(p0[r] + c); p1[r] = __builtin_amdgcn_exp2f(p1[r] + c); }
    return sum16(p0) + sum16(p1);
}
__device__ __forceinline__ float nsa_tile_exp_tab(f32x16& p0, f32x16& p1, const LAS float* tab, float mref) {
#pragma unroll
    for (int r = 0; r < 16; ++r) { const int kc = (r & 3) + 8 * (r >> 2); p0[r] += tab[kc]; p1[r] += tab[kc + 32]; }
#pragma unroll
    for (int r = 0; r < 16; ++r) { p0[r] = __builtin_amdgcn_exp2f(p0[r] - mref); p1[r] = __builtin_amdgcn_exp2f(p1[r] - mref); }
    return sum16(p0) + sum16(p1);
}
__device__ __forceinline__ void nsa_vfrags(bf16x8* vf, const LAS unsigned char* vl, int lane) {
#pragma unroll
    for (int d0 = 0; d0 < 2; ++d0)
#pragma unroll
        for (int k = 0; k < 4; ++k) vf[4 * d0 + k] = nsa_vfrag(vl, 16 * k, d0, lane);
}
__device__ __forceinline__ void nsa_pv_frags(f32x16* o, bf16x8 a0, bf16x8 a1, bf16x8 a2, bf16x8 a3, const bf16x8* vf) {
#pragma unroll
    for (int d0 = 0; d0 < 2; ++d0) {
        o[d0] = __builtin_amdgcn_mfma_f32_32x32x16_bf16(a0, vf[4 * d0 + 0], o[d0], 0, 0, 0);
        o[d0] = __builtin_amdgcn_mfma_f32_32x32x16_bf16(a1, vf[4 * d0 + 1], o[d0], 0, 0, 0);
        o[d0] = __builtin_amdgcn_mfma_f32_32x32x16_bf16(a2, vf[4 * d0 + 2], o[d0], 0, 0, 0);
        o[d0] = __builtin_amdgcn_mfma_f32_32x32x16_bf16(a3, vf[4 * d0 + 3], o[d0], 0, 0, 0); }
}
__device__ __forceinline__ void nsa_emit(bf16_t* dst0, const f32x16* o, float f, bool accumulate, bool dry, LAS float* wsf, int hi, int r32) {
    if (hi == 0) wsf[r32] = f;
    asm volatile("s_waitcnt lgkmcnt(0)" ::: "memory");
    float v0[16], v1[16];
#pragma unroll
    for (int r = 0; r < 16; ++r) { v0[r] = 0.f; v1[r] = 0.f; }
    if (accumulate) {
#pragma unroll
        for (int r = 0; r < 16; ++r) { const int q = crow(r, hi); const bf16_t* src = dst0 + (size_t)(q & 7) * PN_LD + (q >> 3) * 64; v0[r] = bf2f(src[0]); v1[r] = bf2f(src[32]); }
    }
#pragma unroll
    for (int r = 0; r < 16; ++r) { const float a = wsf[crow(r, hi)]; v0[r] += o[0][r] * a; v1[r] += o[1][r] * a; }
    if (!dry) {
#pragma unroll
        for (int r = 0; r < 16; ++r) { const int q = crow(r, hi); bf16_t* dst = dst0 + (size_t)(q & 7) * PN_LD + (q >> 3) * 64; dst[0] = (bf16_t)f2bf(v0[r]); dst[32] = (bf16_t)f2bf(v1[r]); }
    }
    asm volatile("s_waitcnt lgkmcnt(0)" ::: "memory");
}

__device__ __forceinline__ int sum8_dpp(int c) {
    c += __builtin_amdgcn_update_dpp(0, c, 0xB1, 0xF, 0xF, true);
    c += __builtin_amdgcn_update_dpp(0, c, 0x4E, 0xF, 0xF, true);
    c += __builtin_amdgcn_update_dpp(0, c, 0x141, 0xF, 0xF, true);
    return c;
}
__device__ __forceinline__ void nsa_unit(Frame& F, unsigned char* ws, const float* gate_b, int b, int hkv, int qblk, bool dry = false) {
    const int lane = lane_id(), wave = F.wave, tid = wave * 64 + lane, r32 = lane & 31, hi = lane >> 5;
    const int g = r32 >> 3, qi = r32 & 7;
    const int tq = 64 * qblk + 8 * wave + qi;
    bf16_t* PN = (bf16_t*)(ws + OFF_PNSA);
    const bf16_t* KCg = (const bf16_t*)(ws + OFF_KC) + (size_t)(b * 2 + hkv) * 512 * 64; const bf16_t* VCg = (const bf16_t*)(ws + OFF_VC) + (size_t)(b * 2 + hkv) * 512 * 64;
    LAS unsigned char* lds = F.lds;
    LAS float* luts = (LAS float*)(lds + NL_LUTS); LAS float* lutw = (LAS float*)(lds + NL_LUTW); LAS float* negt = (LAS float*)(lds + NL_NEG);
    LAS float* impl = (LAS float*)(lds + NL_IMP); LAS unsigned* selm = (LAS unsigned*)(lds + NL_SELM);
    LAS float* wsf = (LAS float*)(lds + NL_WSF) + wave * 128;
    const float* LUTg = (const float*)(ws + OFF_LUT) + (size_t)(hkv * 4) * 2048;
    __syncthreads();
    { const f32x4* ls4 = (const f32x4*)((const float*)(ws + OFF_LTS) + (size_t)(hkv * 4) * NS_N); const f32x4* lw4 = (const f32x4*)((const float*)(ws + OFF_LTW) + (size_t)(hkv * 4) * NW_N);
      for (int i = tid; i < NS_N; i += NTHREADS) ((LAS f32x4*)luts)[i] = ls4[i];
      for (int i = tid; i < NW_N; i += NTHREADS) ((LAS f32x4*)lutw)[i] = lw4[i]; }
    if (tid < 128) negt[tid] = -INFINITY;
    LAS float* b31t = (LAS float*)(lds + NL_B31);
    if (tid < 256) b31t[tid] = LUTg[(tid >> 6) * 2048 + 1535];
    const float* lutg = LUTg + g * 2048;
    const float b31 = lutg[1535];
    const size_t qoff = ((size_t)b * T_ + tq) * PN_LD;
    bf16x8 qr[4];
#pragma unroll
    for (int ds = 0; ds < 4; ++ds) qr[ds] = *(const bf16x8*)(PN + qoff + (hkv * 4 + g) * 64 + 16 * ds + 8 * hi);
#pragma unroll
    for (int j = 0; j < 3; ++j) { const int gc = (hkv * 4 + g) * 3 + j; const float gt = __builtin_amdgcn_rcpf(1.0f + __expf(-(bf2f(PN[qoff + 1280 + gc]) + gate_b[gc]))); if (hi == 0) wsf[32 + 32 * j + r32] = gt; }
#define NSA_GATE(j_) (wsf[32 + 32 * (j_) + r32])
    bf16_t* const dst0 = PN + ((size_t)b * T_ + 64 * qblk + 8 * wave) * PN_LD + hkv * 256 + r32;
#define NSA_DMA(kp, vp, pitch, tile, slot) do { nsa_dma((kp) + (size_t)(tile) * 64 * (pitch), (pitch), lds + (slot) * NT_SLOT, wave, lane); nsa_dma((vp) + (size_t)(tile) * 64 * (pitch), (pitch), lds + (slot) * NT_SLOT + 8192, wave, lane); } while (0)
#define NSA_SYNC() do { asm volatile("s_waitcnt vmcnt(0)" ::: "memory"); __syncthreads(); } while (0)
    f32x16 p0, p1, o[2];
    const int nct = (4 * qblk + 3 + 63) / 64;
    float mc = 0.f, lc = 0.f;
    for (int i = 0; i < nct; ++i) nsa_dma(KCg + (size_t)i * 64 * 64, 64, lds + i * 8192, wave, lane);
    NSA_SYNC();
    for (int i = 0; i < nct; ++i) {
        const bool farc = (64 * qblk + 8 * wave) - 1024 * i - 1039 >= 1535;
        nsa_qk_c(p0, p1, lds + i * 8192, qr, r32, hi, nsa_cfrag(farc ? b31 - mc : -mc, hi));
        if (!farc) nsa_bias_cmp(p0, p1, luts + g * NS_N, tq - 31 - 1024 * i - 64 * hi);
        const float ts = nsa_tile_exp_plain(p0, p1); lc += ts;
        const float ps = fmaxf(ts, __shfl_xor(ts, 32));
        if (__any(ps > 16384.0f)) { const float d = ps > 16384.0f ? __builtin_amdgcn_logf(ps) : 0.f; lc *= __builtin_amdgcn_exp2f(-d); mc += d; }
    }
    __syncthreads();
    lc += __shfl_xor(lc, 32);
    const float cnorm = lc > 0.f ? -mc - __builtin_amdgcn_logf(lc) : -INFINITY;
    o[0] = (f32x16){}; o[1] = (f32x16){};
    float carry = 0.f;
    NSA_DMA(KCg, VCg, 64, 0, 0);
    NSA_SYNC();
    for (int i = 0; i < nct; ++i) {
        if (i + 1 < nct) NSA_DMA(KCg, VCg, 64, i + 1, (i + 1) & 1);
        const bool farc = (64 * qblk + 8 * wave) - 1024 * i - 1039 >= 1535;
        nsa_qk_c(p0, p1, lds + (i & 1) * NT_SLOT, qr, r32, hi, nsa_cfrag(farc ? b31 + cnorm : cnorm, hi));
        if (!farc) nsa_bias_cmp(p0, p1, luts + g * NS_N, tq - 31 - 1024 * i - 64 * hi);
#pragma unroll
        for (int r = 0; r < 16; ++r) { p0[r] = __builtin_amdgcn_exp2f(p0[r]); p1[r] = __builtin_amdgcn_exp2f(p1[r]); }
        float gs[8], gl[8], rc[8];
#pragma unroll
        for (int k4 = 0; k4 < 4; ++k4) { gs[k4] = (p0[4 * k4] + p0[4 * k4 + 1]) + (p0[4 * k4 + 2] + p0[4 * k4 + 3]); gl[k4] = p0[4 * k4 + 3];
            gs[4 + k4] = (p1[4 * k4] + p1[4 * k4 + 1]) + (p1[4 * k4 + 2] + p1[4 * k4 + 3]); gl[4 + k4] = p1[4 * k4 + 3]; }
#pragma unroll
        for (int k = 0; k < 8; ++k) rc[k] = __shfl_xor(gl[k], 32);
#pragma unroll
        for (int k = 0; k < 8; ++k) { const float prev = hi ? rc[k] : (k == 0 ? carry : rc[k - 1]); float v = gs[k] + prev;
            v += __shfl_xor(v, 8); v += __shfl_xor(v, 16);
            if (g == 0) impl[(8 * wave + qi) * IMP_PITCH + 16 * i + 2 * k + hi] = v; }
        carry = rc[7];
        nsa_pv(o, p0, p1, lds + (i & 1) * NT_SLOT + 8192, lane);
        NSA_SYNC();
    }
    nsa_emit(dst0, o, NSA_GATE(0), false, dry, wsf, hi, r32);
    {
        const int q8 = lane >> 3, jg = lane & 7, qq = 8 * wave + q8, cur = qblk;
        unsigned bits = 0u;
        if (cur >= 16) {
            unsigned key[16];
#pragma unroll
            for (int jj = 0; jj < 16; ++jj) { const int j = 16 * jg + jj; const unsigned kb_ = __builtin_bit_cast(unsigned, impl[qq * IMP_PITCH + j]); key[jj] = (j >= 1 && j <= cur - 2) ? kb_ + 1u : 0u; }
            unsigned Tsel = 0u; bool done = false;
            int bb0 = 30; asm volatile("" : "+s"(bb0));
#pragma unroll 2
            for (int bb = bb0; bb >= 0; --bb) { const unsigned Tt = Tsel | (1u << bb); int c = 0;
#pragma unroll
                for (int jj = 0; jj < 16; ++jj) c += (key[jj] >= Tt) ? 1 : 0;
                c = sum8_dpp(c);
                Tsel = (!done && c >= 13) ? Tt : Tsel;
                done = done || c == 13;
                if (__all(done)) break; }
            int ngt = 0, neq = 0;
#pragma unroll
            for (int jj = 0; jj < 16; ++jj) { ngt += (key[jj] > Tsel) ? 1 : 0; neq += (key[jj] == Tsel) ? 1 : 0; }
            ngt = sum8_dpp(ngt);
            int pre = neq;
            { int t = __shfl_up(pre, 1, 8); if (jg >= 1) pre += t; t = __shfl_up(pre, 2, 8); if (jg >= 2) pre += t; t = __shfl_up(pre, 4, 8); if (jg >= 4) pre += t; }
            int run = pre - neq; const int need = 13 - ngt;
#pragma unroll
            for (int jj = 0; jj < 16; ++jj) { const int j = 16 * jg + jj; bool sel = key[jj] > Tsel;
                if (key[jj] == Tsel && Tsel != 0u) { sel = run < need; ++run; }
                sel = sel || j == 0 || j == cur || j == cur - 1; bits |= sel ? (1u << jj) : 0u; }
        } else {
#pragma unroll
            for (int jj = 0; jj < 16; ++jj) { const int j = 16 * jg + jj; bits |= (j <= cur) ? (1u << jj) : 0u; }
        }
        const unsigned other = (unsigned)__shfl_xor((int)bits, 1);
        if ((jg & 1) == 0) selm[qq * 4 + (jg >> 1)] = bits | (other << 16);
        asm volatile("s_waitcnt lgkmcnt(0)" ::: "memory");
    }
    const LAS unsigned* sm = selm + (8 * wave + qi) * 4;
#define NSA_SB() __builtin_amdgcn_sched_barrier(0)
#define NSA_PAIR(EXPA, EXPB) do { \
            { bf16x8 ka_[8]; nsa_kfrags(ka_, sl_, r32, hi); NSA_SB(); nsa_qk_frags(p0, p1, ka_, qr); } \
            NSA_SB(); \
            nsa_qk(q0, q1, sl_ + NT_SLOT, qr, r32, hi); \
            EXPA; \
            fa0 = p_frag(p0, 0); fa1 = p_frag(p0, 1); fa2 = p_frag(p1, 0); fa3 = p_frag(p1, 1); \
            NSA_SB(); \
            { bf16x8 va_[8]; nsa_vfrags(va_, sl_ + 8192, lane); NSA_SB(); nsa_pv_frags(o, fa0, fa1, fa2, fa3, va_); } \
            EXPB; \
            fa0 = p_frag(q0, 0); fa1 = p_frag(q0, 1); fa2 = p_frag(q1, 0); fa3 = p_frag(q1, 1); \
            NSA_SB(); \
            { bf16x8 vb_[8]; nsa_vfrags(vb_, sl_ + NT_SLOT + 8192, lane); NSA_SB(); nsa_pv_frags(o, fa0, fa1, fa2, fa3, vb_); } \
        } while (0)
#define NSA_PAIR_C(CFA, CFB, EXPA, EXPB) do { \
            { bf16x8 ka_[8]; nsa_kfrags(ka_, sl_, r32, hi); const s16x4 cfa_ = (CFA); NSA_SB(); nsa_qk_frags_c(p0, p1, ka_, qr, cfa_); } \
            NSA_SB(); \
            nsa_qk_c(q0, q1, sl_ + NT_SLOT, qr, r32, hi, (CFB)); \
            EXPA; \
            fa0 = p_frag(p0, 0); fa1 = p_frag(p0, 1); fa2 = p_frag(p1, 0); fa3 = p_frag(p1, 1); \
            NSA_SB(); \
            { bf16x8 va_[8]; nsa_vfrags(va_, sl_ + 8192, lane); NSA_SB(); nsa_pv_frags(o, fa0, fa1, fa2, fa3, va_); } \
            EXPB; \
            fa0 = p_frag(q0, 0); fa1 = p_frag(q0, 1); fa2 = p_frag(q1, 0); fa3 = p_frag(q1, 1); \
            NSA_SB(); \
            { bf16x8 vb_[8]; nsa_vfrags(vb_, sl_ + NT_SLOT + 8192, lane); NSA_SB(); nsa_pv_frags(o, fa0, fa1, fa2, fa3, vb_); } \
            tsa_ = sum16(p0) + sum16(p1); tsb_ = sum16(q0) + sum16(q1);     \
        } while (0)
#define NSA_ITER_HEAD(kp, vp, t0, nt) \
            const int jn_ = (j + 1 < np_) ? j + 1 : j, tb_ = (2 * jn_ + 1 < (nt)) ? 2 * jn_ + 1 : 2 * jn_; \
            NSA_DMA(kp, vp, PN_LD, (t0) + 2 * jn_, 2 * ((j + 1) & 1)); NSA_DMA(kp, vp, PN_LD, (t0) + tb_, 2 * ((j + 1) & 1) + 1);        \
            const LAS unsigned char* sl_ = lds + (j & 1) * 2 * NT_SLOT; \
            f32x16 q0, q1; float tsa_, tsb_; bf16x8 fa0, fa1, fa2, fa3;
#define NSA_ITER_TAIL(mref, psum, lvar) \
            { float ts_ = tsa_ + tsb_; lvar += ts_; psum = fmaxf(ts_, __shfl_xor(ts_, 32)); } \
            NSA_SYNC(); \
            nsa_resc(mref, psum, lvar, o, wsf, hi, r32);
#define NSA_LOOP2(kp, vp, t0, nt, TABF, NFAR, SELBIT, mref, psum, lvar) do { \
        const int np_ = ((nt) + 1) >> 1, nf_ = (NFAR) < np_ ? (NFAR) : np_; \
        __syncthreads();                                                \
        NSA_DMA(kp, vp, PN_LD, (t0), 0); NSA_DMA(kp, vp, PN_LD, (t0) + ((nt) > 1 ? 1 : 0), 1); \
        NSA_SYNC(); \
        int j = 0; \
        for (; j < nf_; ++j) { \
            NSA_ITER_HEAD(kp, vp, t0, nt) \
            float ca_, cb_; { const int i = 2 * j; ca_ = (SELBIT) ? b31 : -INFINITY; } { const int i = 2 * j + 1; cb_ = (SELBIT) ? b31 : -INFINITY; } \
            NSA_PAIR_C(nsa_cfrag(ca_ - mref, hi), nsa_cfrag(cb_ - mref, hi), nsa_tile_exp_only(p0, p1), nsa_tile_exp_only(q0, q1)); \
            NSA_ITER_TAIL(mref, psum, lvar) \
        } \
        for (; j < np_; ++j) { \
            NSA_ITER_HEAD(kp, vp, t0, nt) \
            const s16x4 cfm_ = nsa_cfrag(-mref, hi); \
            NSA_PAIR_C(cfm_, cfm_, { const int i = 2 * j; nsa_tile_exp_tab_only(p0, p1, TABF); }, { const int i = 2 * j + 1; nsa_tile_exp_tab_only(q0, q1, (i < (nt)) ? (TABF) : (const LAS float*)negt); }); \
            NSA_ITER_TAIL(mref, psum, lvar) \
        } } while (0)
    {
        const bf16_t* kp = PN + (size_t)b * T_ * PN_LD + 768 + hkv * 64; const bf16_t* vp = kp + 128;
        float ms = 0.f, mp = 0.f, ls = 0.f; o[0] = (f32x16){}; o[1] = (f32x16){};
        const int nt = qblk + 1;
        const LAS float* lutsg = luts + g * NS_N + (NS_N - 69 - (tq - 4 * hi)); const LAS float* b31g = b31t + g * 64;
        const int dmin0 = 64 * qblk + 8 * wave - 63;
        NSA_LOOP2(kp, vp, 0, nt, (((sm[(i >> 5) & 3] >> (i & 31)) & 1u) ? ((dmin0 - 64 * i >= 1535) ? b31g : lutsg + 64 * i) : (const LAS float*)negt), (dmin0 >= 1599 ? (dmin0 - 1599) / 128 + 1 : 0), ((sm[(i >> 5) & 3] >> (i & 31)) & 1u), ms, mp, ls);
        ls += __shfl_xor(ls, 32);
        nsa_emit(dst0, o, NSA_GATE(1) * __builtin_amdgcn_rcpf(ls), true, dry, wsf, hi, r32);
    }
    {
        const bf16_t* kp = PN + (size_t)b * T_ * PN_LD + 1024 + hkv * 64; const bf16_t* vp = kp + 128;
        float mw = 0.f, mp = 0.f, lw = 0.f; o[0] = (f32x16){}; o[1] = (f32x16){};
        const int first = qblk >= 8 ? qblk - 8 : 0, nt = qblk - first + 1;
        const LAS float* lutwg = lutw + g * NW_N + (NW_N - 69 - (tq - 64 * first - 4 * hi));
        NSA_LOOP2(kp, vp, first, nt, (lutwg + 64 * i), 0, true, mw, mp, lw);
        lw += __shfl_xor(lw, 32);
        nsa_emit(dst0, o, NSA_GATE(2) * __builtin_amdgcn_rcpf(lw), true, dry, wsf, hi, r32);
    }
#undef NSA_LOOP2
#undef NSA_ITER_HEAD
#undef NSA_ITER_TAIL
#undef NSA_PAIR
#undef NSA_PAIR_C
#undef NSA_SB
#undef NSA_DMA
#undef NSA_SYNC
#undef NSA_GATE
}

#define XB_TMO      128
#define XB_XCNT(j)  (256  + 64 * (j))
#define XB_XSUB(j)  (1280 + 64 * (j))
#define XB_XGEN(j)  (2304 + 64 * (j))
#define XB_TOP      3328
#define XB_TOPGEN   3392
#define XCD_BAR_WORDS 3456
#define XB_SPIN_CAP (1u << 18)
__device__ __forceinline__ unsigned xb_ld(unsigned* p)              { return __hip_atomic_load(p, __ATOMIC_RELAXED, __HIP_MEMORY_SCOPE_AGENT); }
__device__ __forceinline__ unsigned xb_add(unsigned* p, unsigned v) { return __hip_atomic_fetch_add(p, v, __ATOMIC_RELAXED, __HIP_MEMORY_SCOPE_AGENT); }
__device__ __forceinline__ unsigned xb_xcc_id() { return (unsigned)__builtin_amdgcn_s_getreg((3 << 11) | 20) & 0xFu; }
#define XB_SPIN(cond, bar) do { unsigned _sp = 0; while (cond) { __builtin_amdgcn_s_sleep(1); \
    if ((++_sp & 255u) == 0u) { if (xb_ld(&(bar)[XB_TMO])) break; if (_sp > XB_SPIN_CAP) { atomicAdd(&(bar)[XB_TMO], 1u); break; } } } } while (0)
struct XcdBarrier { unsigned* bar; unsigned x; volatile LAS unsigned* st; };
__device__ __forceinline__ void xcd_barrier_complete(unsigned* bar, unsigned x, unsigned& nloc, unsigned& nx) {
    const unsigned G = gridDim.x;
    unsigned sum, cnt, mine, sp = 0u;
    for (;;) {
        sum = 0u; cnt = 0u; mine = 0u;
#pragma unroll
        for (unsigned j = 0; j < 16; ++j) { const unsigned c = xb_ld(&bar[XB_XCNT(j)]); sum += c; cnt += (c > 0u) ? 1u : 0u; mine = (j == x) ? c : mine; }
        if (sum == G) break;
        __builtin_amdgcn_s_sleep(1);
        if ((++sp & 255u) == 0u) { if (xb_ld(&bar[XB_TMO])) break; if (sp > XB_SPIN_CAP) { atomicAdd(&bar[XB_TMO], 1u); break; } }
    }
    nloc = mine > 0u ? mine : 1u; nx = cnt > 0u ? cnt : 1u;
}
__device__ __forceinline__ void xcd_barrier(const XcdBarrier& b, bool leader_thread) {
    asm volatile("s_waitcnt vmcnt(0)" ::: "memory");
    __syncthreads();
    if (leader_thread) {
        unsigned* bar = b.bar;
        __builtin_amdgcn_s_waitcnt(0);
        unsigned nloc = b.st[0], nx = b.st[1];
        if (nloc == 0u) { xcd_barrier_complete(bar, b.x, nloc, nx); b.st[0] = nloc; b.st[1] = nx; }
        const unsigned old = xb_add(&bar[XB_XSUB(b.x)], 1u);
        const unsigned gen = old / nloc;
        if (old + 1u == (gen + 1u) * nloc) {
            __builtin_amdgcn_fence(__ATOMIC_RELEASE, "agent");
            asm volatile("s_waitcnt vmcnt(0)" ::: "memory");
            const unsigned og = xb_add(&bar[XB_TOP], 1u);
            const unsigned tg = og / nx;
            if (og + 1u == (tg + 1u) * nx) xb_add(&bar[XB_TOPGEN], 1u);
            else XB_SPIN(xb_ld(&bar[XB_TOPGEN]) == tg, bar);
            __builtin_amdgcn_fence(__ATOMIC_ACQUIRE, "agent");
            xb_add(&bar[XB_XGEN(b.x)], 1u);
            asm volatile("s_waitcnt vmcnt(0)" ::: "memory");
        } else {
            XB_SPIN(xb_ld(&bar[XB_XGEN(b.x)]) == gen, bar);
            __builtin_amdgcn_fence(__ATOMIC_ACQUIRE, "agent");
            asm volatile("s_waitcnt vmcnt(0)" ::: "memory");
        }
    }
    __syncthreads();
}
constexpr size_t OFF_BAR = 256 * 1024;
constexpr size_t OFF_CNT = 320 * 1024;
constexpr size_t OFF_PCNT = 384 * 1024;

__global__ void __launch_bounds__(NTHREADS, 2) hybrid_fwd(Args args) {
    extern __shared__ __attribute__((aligned(16))) unsigned char lds_raw[];
    Frame F;
    F.lds = (LAS unsigned char*)lds_raw;
    F.wave = __builtin_amdgcn_readfirstlane(threadIdx.x >> 6);
    F.G = gridDim.x; F.blk = blockIdx.x;
    XcdBarrier xbar; xbar.bar = (unsigned*)(args.ws + OFF_BAR); xbar.x = xb_xcc_id(); xbar.st = (volatile LAS unsigned*)(F.lds + LDS_CTRL + 1024);
    if (threadIdx.x < 2) xbar.st[threadIdx.x] = 0u;
    if (threadIdx.x == 0) (void)xb_add(&xbar.bar[XB_XCNT(xbar.x)], 1u);
    __syncthreads();
#define IN(k) (true)
#define SEAM(k) xcd_barrier(xbar, F.wave == 0 && lane_id() == 0)
#define WSP(type, off) ((type*)(args.ws + (off)))
#define PHASE_IDS() unsigned char* ws = args.ws; (void)ws; const int lane = lane_id(), tid = F.wave * 64 + lane, gw = F.blk * NWAVES + F.wave, NGW = F.G * NWAVES, gt = F.blk * NTHREADS + tid, NGT = F.G * NTHREADS; (void)gw; (void)NGW; (void)gt; (void)NGT; (void)tid; (void)lane
#define XIN (args.in[0])
#define SS1 WSP(float, OFF_SS1)
#define SS2 WSP(float, OFF_SS2)
#define SS3 WSP(float, OFF_SS3)
#define XN WSP(bf16_t, OFF_XN)
#define XB WSP(bf16_t, OFF_XN)
#define Win_t WSP(bf16_t, OFF_WIN)
#define Wkv_t ((bf16_t*)args.out + (size_t)10 * 1024 * 1024)
#define Wc1k_t WSP(bf16_t, OFF_WC1K)
#define Wc1v_t WSP(bf16_t, OFF_WC1V)
#define Wlora_t WSP(bf16_t, OFF_WLORA)
#define Wout_t ((bf16_t*)args.out)
#define Wq_t ((bf16_t*)args.out + (size_t)1024 * 1024)
#define Wo_t ((bf16_t*)args.out + (size_t)2 * 1024 * 1024)
#define Wgu_t ((bf16_t*)args.out + (size_t)3 * 1024 * 1024)
#define Wd_t WSP(bf16_t, OFF_WD)
#define Hb WSP(bf16_t, OFF_H)
#define MEMN WSP(bf16_t, OFF_MEMN)
#define KVX WSP(bf16_t, OFF_KVX)
#define PNSA WSP(bf16_t, OFF_PNSA)
#define PRW WSP(bf16_t, OFF_R1)
#define LUT WSP(float, OFF_LUT)
#define CBK WSP(float, OFF_CBK)
#define CBPART WSP(float, OFF_CBPART)
#define H1K WSP(bf16_t, OFF_H1K)
#define H1V WSP(bf16_t, OFF_H1V)
#define KC WSP(bf16_t, OFF_KC)

    if (IN(0)) { PHASE_IDS();
        {
          LAS float* scr = (LAS float*)(F.lds + F.wave * 16384);
          for (int it = gw; it < 3088; it += NGW) {
              if (it < 1552) p0_transpose_item(args.in[5], D_, IN_COLS, Win_t, D_, 1, 0, scr, it, lane);
              else if (it < 2576) p0_transpose_item(args.in[30], D_, 2 * D_, Wkv_t, D_, 0, 0, scr, it - 1552, lane);
              else if (it < 2832) p0_transpose_item(args.in[9], 2048, 256, Wc1k_t, 2048, 0, 0, scr, it - 2576, lane);
              else p0_transpose_item(args.in[12], 2048, 256, Wc1v_t, 2048, 0, 0, scr, it - 2832, lane); } }
        for (int i = gt; i < (NIN - IN_COLS) * (D_ / 8); i += NGT) *(u32x4*)(Win_t + (size_t)IN_COLS * D_ + (size_t)i * 8) = (u32x4){0u, 0u, 0u, 0u};
        for (int i = gt; i < 1536 * 32; i += NGT) { const int n = i >> 5, kc = (i & 31) * 8, reg = n >> 9, nn = n & 511; float f[8];
#pragma unroll
            for (int j = 0; j < 8; ++j) { const int k = kc + j; float v = 0.f;
                if (reg == 0 && k < 64) v = args.in[17][(size_t)k * 512 + nn];
                else if (reg == 1 && k >= 64 && k < 128) v = args.in[19][(size_t)(k - 64) * 512 + nn];
                else if (reg == 2 && k >= 128) v = args.in[20][(size_t)(k - 128) * 512 + nn];
                f[j] = v; }
            *(u32x4*)(Wlora_t + (size_t)n * 256 + kc) = pack8(f); }
        for (int m = gw; m < M_; m += 2 * NGW) {
            const int m2 = m + NGW; const bool two = m2 < M_;
            const f32x4* xa = (const f32x4*)(XIN + (size_t)m * D_) + lane; const f32x4* xb = (const f32x4*)(XIN + (size_t)(two ? m2 : m) * D_) + lane;
            f32x4 va[4], vb[4]; float sa = 0.f, sb = 0.f;
#pragma unroll
            for (int j = 0; j < 4; ++j) { va[j] = xa[64 * j]; vb[j] = xb[64 * j]; }
#pragma unroll
            for (int j = 0; j < 4; ++j) { sa += (va[j][0] * va[j][0] + va[j][1] * va[j][1]) + (va[j][2] * va[j][2] + va[j][3] * va[j][3]); sb += (vb[j][0] * vb[j][0] + vb[j][1] * vb[j][1]) + (vb[j][2] * vb[j][2] + vb[j][3] * vb[j][3]); }
#pragma unroll
            for (int o = 1; o < 64; o <<= 1) { sa += __shfl_xor(sa, o); sb += __shfl_xor(sb, o); }
            const float ra = __builtin_amdgcn_rsqf(sa * (1.0f / D_) + RMS_EPS), rb = __builtin_amdgcn_rsqf(sb * (1.0f / D_) + RMS_EPS);
#pragma unroll
            for (int j = 0; j < 4; ++j) { const f32x4 g4 = *((const f32x4*)args.in[4] + lane + 64 * j); const f32x4 ya = va[j] * ra * g4, yb = vb[j] * rb * g4;
                u32x2 w; w.x = pk2(ya[0], ya[1]); w.y = pk2(ya[2], ya[3]); *((u32x2*)(XN + (size_t)m * D_) + lane + 64 * j) = w;
                if (two) { w.x = pk2(yb[0], yb[1]); w.y = pk2(yb[2], yb[3]); *((u32x2*)(XN + (size_t)m2 * D_) + lane + 64 * j) = w; } }
        }
        for (int m = gw; m < 512; m += NGW) rms_row_to_bf16(args.in[1] + (size_t)m * D_, args.in[28], MEMN + (size_t)m * D_, lane);
        for (int i = gt; i < 8 * 2048; i += NGT) { const int h = i >> 11, d = i & 2047; int bk;
            if (d < 16) bk = d; else { bk = 16; const int thr[15] = {22, 30, 40, 54, 73, 99, 134, 182, 246, 332, 450, 609, 825, 1117, 1513};
#pragma unroll
                for (int j = 0; j < 15; ++j) bk += (d >= thr[j]) ? 1 : 0; }
            LUT[i] = args.in[2][bk * 8 + h] * LOG2E; }
        for (int i = gt; i < 8 * (NS_N + NW_N); i += NGT) { const bool isw = i >= 8 * NS_N; const int ii = isw ? i - 8 * NS_N : i, n = isw ? NW_N : NS_N, h = ii / n, dist = (n - 1 - (ii % n)) - 68;
            const int d = dist < 0 ? 0 : (dist < 1535 ? dist : 1535); int bk;
            if (d < 16) bk = d; else { bk = 16; const int thr[15] = {22, 30, 40, 54, 73, 99, 134, 182, 246, 332, 450, 609, 825, 1117, 1513};
#pragma unroll
                for (int j = 0; j < 15; ++j) bk += (d >= thr[j]) ? 1 : 0; }
            const bool valid = isw ? (dist >= 0 && dist < 512) : (dist >= 0);
            (isw ? WSP(float, OFF_LTW) : WSP(float, OFF_LTS))[ii] = valid ? args.in[2][bk * 8 + h] * LOG2E : -INFINITY; }
        for (int i = gt; i < 32 * 512; i += NGT) { const int lc = i >> 9, j = i & 511; const float* pe = (j < 256 ? args.in[7] : args.in[8]) + lc * 64; const float* w1 = (j < 256 ? args.in[9] : args.in[12]) + (size_t)lc * 64 * 256 + (j & 255);
            float s = 0.f;
#pragma unroll 8
            for (int d = 0; d < 64; ++d) s += pe[d] * w1[(size_t)d * 256];
            CBPART[i] = s; }
    }
    SEAM(0);
    if (IN(1)) { PHASE_IDS();
        if (F.blk == 100) { const int j = tid; float s = (j < 256 ? args.in[10] : args.in[13])[j & 255];
            for (int lc = 0; lc < 32; ++lc) s += CBPART[lc * 512 + j];
            CBK[j < 256 ? j : 512 + (j - 256)] = s; }
        { pg8::Gemm g{XN, Win_t, M_, NIN - 256, D_, D_, 128, 0}; pg8::StaticOrder S; S.init(M_, NIN - 256, F.G, F.blk);
          pg8::EpiStore E{PRW, PR_LD, 7, PNSA, PN_LD, 7, 9, QK_C};
          pg8::gemm_phase(F.lds, g, S, E, F.wave); }
    }
    SEAM(1);
    if (IN(2)) { PHASE_IDS();
        bf16_t* R = (bf16_t*)(ws + OFF_R); bf16_t* V = (bf16_t*)(ws + OFF_V); bf16_t* KK = (bf16_t*)(ws + OFF_KK); bf16_t* KP = (bf16_t*)(ws + OFF_KP);
        bf16_t* LA = (bf16_t*)(ws + OFF_LORA_A);
        const float* mu = args.in[15]; const float* k_k = args.in[21];
        for (int m = (F.blk >= 16 ? (F.blk - 16) * NWAVES + F.wave : M_); m < M_; m += (F.G - 16) * NWAVES) {
            const bf16_t* pr = PRW + (size_t)m * PR_LD; const bool hp = (m % T_) != 0;
#pragma unroll
            for (int q = 0; q < 3; ++q) { const int col = q * 512 + 8 * lane;
                const u32x4 cw = *(const u32x4*)(pr + col); u32x4 pw = (u32x4){0u, 0u, 0u, 0u}; if (hp) pw = *(const u32x4*)(pr - PR_LD + col);
                float cf[8], pf[8], val[8]; unpack8(cw, cf); unpack8(pw, pf);
                const f32x4 m0 = *(const f32x4*)(mu + col), m1 = *(const f32x4*)(mu + col + 4);
#pragma unroll
                for (int i = 0; i < 8; ++i) val[i] = cf[i] + (pf[i] - cf[i]) * (i < 4 ? m0[i & 3] : m1[i & 3]);
                const size_t o = (size_t)m * 512 + 8 * lane;
                if (q == 0) *(u32x4*)(R + o) = pack8(val);
                else if (q == 2) *(u32x4*)(V + o) = pack8(val);
                else { *(u32x4*)(KP + o) = pack8(val);
                    const f32x4 k0 = *(const f32x4*)(k_k + 8 * lane), k1 = *(const f32x4*)(k_k + 8 * lane + 4); float kr[8], ss = 0.f;
#pragma unroll
                    for (int i = 0; i < 8; ++i) { kr[i] = val[i] * (i < 4 ? k0[i & 3] : k1[i & 3]); ss += kr[i] * kr[i]; }
                    ss += __shfl_xor(ss, 1); ss += __shfl_xor(ss, 2); ss += __shfl_xor(ss, 4);
                    const float inv = __builtin_amdgcn_rsqf(fmaxf(ss, 1e-24f));
#pragma unroll
                    for (int i = 0; i < 8; ++i) kr[i] *= inv;
                    *(u32x4*)(KK + o) = pack8(kr); }
            }
            { const int col = 1536 + 4 * lane; const u32x2 cw = *(const u32x2*)(pr + col); u32x2 pw = (u32x2){0u, 0u}; if (hp) pw = *(const u32x2*)(pr - PR_LD + col);
              const f32x4 mm = *(const f32x4*)(mu + col); float o4[4];
#pragma unroll
              for (int i = 0; i < 4; ++i) { const unsigned cu = i < 2 ? cw.x : cw.y, pu = i < 2 ? pw.x : pw.y;
                  const float cf = __builtin_bit_cast(float, (i & 1) ? (cu & 0xffff0000u) : (cu << 16)), pf = __builtin_bit_cast(float, (i & 1) ? (pu & 0xffff0000u) : (pu << 16));
                  const float v = cf + (pf - cf) * mm[i];
                  o4[i] = lane < 16 ? (1.0f - 2.0f * __builtin_amdgcn_rcpf(1.0f + __expf(2.0f * v))) : (lane < 32 ? v : __builtin_amdgcn_rcpf(1.0f + __expf(-v))); }
              u32x2 w; w.x = pk2(o4[0], o4[1]); w.y = pk2(o4[2], o4[3]); *(u32x2*)(LA + (size_t)m * 256 + 4 * lane) = w; }
        }
        { pg8::Gemm g{PNSA + 512, Wc1k_t, 2048, 256, 2048, 16 * PN_LD, PN_LD * 2, 1}; pg8::ListOrder S; S.init(2048, 256, 0, F.blk);
          pg8::EpiGelu E{H1K, CBK};
          pg8::gemm_phase(F.lds, g, S, E, F.wave); }
        { pg8::Gemm g{PNSA + 640, Wc1v_t, 2048, 256, 2048, 16 * PN_LD, PN_LD * 2, 1}; pg8::ListOrder S; S.init(2048, 256, 8, F.blk);
          pg8::EpiGelu E{H1V, CBK + 512};
          pg8::gemm_phase(F.lds, g, S, E, F.wave); }
    }
    SEAM(2);
    if (IN(3)) { PHASE_IDS();
        { pg8::Gemm g{(const bf16_t*)(ws + OFF_LORA_A), Wlora_t, M_, 1536, 256, 256, 128, 0}; pg8::StaticOrder S; S.init(M_, 1536, F.G, F.blk);
          pg8::EpiLora E{(float*)(ws + OFF_W), (bf16_t*)(ws + OFF_KP), (const bf16_t*)(ws + OFF_KK), (bf16_t*)(ws + OFF_B), (bf16_t*)(ws + OFF_G), args.in[16], args.in[18], args.in[22]};
          pg8::gemm_phase(F.lds, g, S, E, F.wave);
          }
        { pg8::Gemm g{XN, Win_t + (size_t)(NIN - 256) * D_, M_, 256, D_, D_, 128, 0}; pg8::ListOrder S; S.init(M_, 256, 128, F.blk);
          pg8::EpiStore E{PNSA + 1280, PN_LD, 1000, nullptr, 0, 0, 0, 1.0f};
          pg8::gemm_phase(F.lds, g, S, E, F.wave); }
        {
          LAS float* scr = (LAS float*)(F.lds + F.wave * 16384);
          const int q3 = F.G >> 2, grp3 = F.blk < 2 * q3 ? 0 : (F.blk < 3 * q3 ? 1 : 2);
          const int it0 = grp3 == 0 ? gw : (grp3 == 2 ? 2880 + (F.blk - 3 * q3) * NWAVES + F.wave : 5760), itn = grp3 == 0 ? 2880 : 5760, its = grp3 == 0 ? 2 * q3 * NWAVES : q3 * NWAVES;
          for (int it = it0; it < itn; it += its) {
              if (it < 512) p0_transpose_item(args.in[26], D_, D_, Wout_t, D_, 0, 0, scr, it, lane);
              else if (it < 1024) p0_transpose_item(args.in[29], D_, D_, Wq_t, D_, 0, 0, scr, it - 512, lane);
              else if (it < 1536) p0_transpose_item(args.in[31], D_, D_, Wo_t, D_, 0, 0, scr, it - 1024, lane);
              else if (it < 2944) p0_transpose_item(args.in[33], D_, DFF, Wgu_t, D_, 2, 0, scr, it - 1536, lane);
              else if (it < 4352) p0_transpose_item(args.in[34], D_, DFF, Wgu_t, D_, 3, 0, scr, it - 2944, lane);
              else p0_transpose_item(args.in[35], DFF, D_, Wd_t, DFF, 0, 0, scr, it - 4352, lane); } }
        for (int r = gw; r < 4096; r += NGW) { const int kv = r >> 11, row = r & 2047; const bf16_t* h1 = (kv ? H1V : H1K) + (size_t)row * 256; const float* w2 = args.in[kv ? 14 : 11] + lane;
            float s0 = 0.f, s1 = 0.f;
#pragma unroll 8
            for (int j = 0; j < 256; j += 2) { const unsigned hw = *(const unsigned*)(h1 + j); s0 += __builtin_bit_cast(float, hw << 16) * w2[(size_t)j * 64]; s1 += __builtin_bit_cast(float, hw & 0xffff0000u) * w2[(size_t)(j + 1) * 64]; }
            float s = s0 + s1; if ((row & 511) == 511) s = 0.f;
            (KC + (size_t)kv * 131072)[(size_t)row * 64 + lane] = (bf16_t)f2bf(s); }
    }
    SEAM(3);
    if (IN(4)) { PHASE_IDS();
        rwkv_chunk(F, ws);
    }
    SEAM(4);
    if (IN(5)) { PHASE_IDS();
        if (F.blk < 16) rwkv_combine(F, ws, F.blk);
        { pg8::Gemm g{MEMN, Wkv_t, 512, 2 * D_, D_, D_, 128, 0}; pg8::ListOrder S; S.init(512, 2 * D_, 16, F.blk);
          pg8::EpiStore E{KVX, 2 * D_, 1000, nullptr, 0, 0, 0, 1.0f};
          pg8::gemm_phase(F.lds, g, S, E, F.wave); }
        volatile LAS unsigned* uw = (volatile LAS unsigned*)(F.lds + LDS_CTRL + 1024 + 64);
        for (;;) {
            __syncthreads();
            if (tid == 0) uw[0] = xb_add(WSP(unsigned, OFF_CNT), 1u);
            __syncthreads();
            const unsigned u = uw[0];
            if (u >= 512u) break;
            nsa_unit(F, ws, args.in[6], (int)(u & 1u), (int)((u >> 1) & 1u), 127 - (int)(u >> 2));
        }
    }
    SEAM(5);
    if (IN(6)) { PHASE_IDS();
        for (int task = gw; task < 16 * NC * 4; task += NGW) rwkv_fixup_task(ws, args.in[24], args.in[25], args.in[23], task >> 2, task & 3, lane);
    }
    SEAM(6);
    if (IN(7)) { PHASE_IDS();
        pg8::Gemm g{PNSA, Wout_t, M_, D_, D_, PN_LD, 128, 0}; pg8::StaticOrder S; S.init(M_, D_, F.G, F.blk);
        pg8::EpiResidual<false> E{XIN, nullptr, nullptr, XB, args.in[27], SS1};
        pg8::gemm_phase(F.lds, g, S, E, F.wave);
    }
    SEAM(7);
    if (IN(8)) { PHASE_IDS();
        pg8::Gemm g{XB, Wq_t, M_, D_, D_, D_, 128, 0}; pg8::StaticOrder S; S.init(M_, D_, F.G, F.blk);
        pg8::EpiRowScale E{WSP(bf16_t, OFF_Q2), SS1, 0.0625f * LOG2E};
        pg8::gemm_phase(F.lds, g, S, E, F.wave);
        asm volatile("s_waitcnt vmcnt(0)" ::: "memory");
        __syncthreads();
        asm volatile("buffer_inv sc0\n\ts_waitcnt vmcnt(0)" ::: "memory");
    }
    if (IN(9)) { PHASE_IDS();
        const int c = F.blk, pm = 8 * (c & 7) + ((c >> 3) & 7), pn = c >> 6;
        xattn_unit(F, WSP(bf16_t, OFF_Q2), KVX, WSP(bf16_t, OFF_XO), pm >> 5, pn, pm & 31);
    }
    SEAM(9);
    if (IN(10)) { PHASE_IDS();
        pg8::Gemm g{WSP(bf16_t, OFF_XO), Wo_t, M_, D_, D_, D_, 128, 0}; pg8::StaticOrder S; S.init(M_, D_, F.G, F.blk);
        pg8::EpiResidual<true> E{nullptr, XB, args.in[27], XB, args.in[32], SS2};
        pg8::gemm_phase(F.lds, g, S, E, F.wave);
    }
    SEAM(10);
    if (IN(11)) { PHASE_IDS();
        pg8::Gemm g{XB, Wgu_t, M_, 2 * DFF, D_, D_, 128, 0}; pg8::StaticOrder S; S.init(M_, 2 * DFF, F.G, F.blk);
        pg8::EpiSwiglu E{Hb, SS2};
        pg8::gemm_phase(F.lds, g, S, E, F.wave);
    }
    SEAM(11);
    if (IN(12)) { PHASE_IDS();
        pg8::Gemm g{Hb, Wd_t, M_, D_, DFF, DFF, 128, 0}; pg8::StaticOrder S; S.init(M_, D_, F.G, F.blk);
        pg8::EpiFinalNorm E{XB, args.in[32], args.out, args.in[3], SS3, WSP(unsigned, OFF_PCNT)};
        pg8::gemm_phase(F.lds, g, S, E, F.wave);
    }
#undef IN
#undef SEAM
}

extern "C" void kernel_launch(void* const* d_in, const int* in_sizes, int n_in, void* d_out, int out_size, void* d_ws, size_t ws_size, hipStream_t stream) {
    static int grid = 0;
    if (grid == 0) {
        int dev = 0, cus = 0, per_cu = 0;
        (void)hipGetDevice(&dev);
        (void)hipDeviceGetAttribute(&cus, hipDeviceAttributeMultiprocessorCount, dev);
        (void)hipFuncSetAttribute((const void*)hybrid_fwd, hipFuncAttributeMaxDynamicSharedMemorySize, LDS_BYTES);
        (void)hipOccupancyMaxActiveBlocksPerMultiprocessor(&per_cu, (const void*)hybrid_fwd, NTHREADS, LDS_BYTES);
        if (per_cu < 1) { fprintf(stderr, "kernel_launch: occupancy query reports %d blocks per CU\n", per_cu); per_cu = 1; }
        (void)hipGetLastError();
        grid = cus;
        if (n_in != 36 || ws_size < 256 * MiB) fprintf(stderr, "kernel_launch: unexpected n_in %d / ws %zu\n", n_in, ws_size);
    }
    Args a{};
    for (int i = 0; i < 36; ++i) a.in[i] = (const float*)d_in[i];
    a.out = (float*)d_out; a.ws = (unsigned char*)d_ws; a.ph_lo = 0; a.ph_hi = N_PHASES;
    (void)hipMemsetAsync((char*)d_ws + OFF_BAR, 0, 256 * 1024, stream);
    void* kargs[] = {&a};
    hipError_t e = hipLaunchCooperativeKernel((const void*)hybrid_fwd, dim3(grid), dim3(NTHREADS), kargs, LDS_BYTES, stream);
    if (e != hipSuccess) fprintf(stderr, "cooperative launch failed: %s (grid %d)\n", hipGetErrorString(e), grid);
}
```

```cpp
#include <hip/hip_runtime.h>
#include <hip/hip_cooperative_groups.h>
#include <cstdio>
#include <cstdint>
namespace cg = cooperative_groups;

#define LAS __attribute__((address_space(3)))
#define GAS __attribute__((address_space(1)))
typedef unsigned short bf16_t;
typedef short bf16x8 __attribute__((ext_vector_type(8)));
typedef float f32x4 __attribute__((ext_vector_type(4)));
typedef float f32x2 __attribute__((ext_vector_type(2)));
typedef float f32x16 __attribute__((ext_vector_type(16)));
typedef unsigned u32x4 __attribute__((ext_vector_type(4)));
typedef unsigned u32x2 __attribute__((ext_vector_type(2)));

constexpr int NB = 2, T_ = 8192, M_ = NB * T_, D_ = 1024;
constexpr int NSA_COLS = 1304, RW_COLS = 1792, IN_COLS = 3096;
constexpr int PN_LD = 1536, PR_LD = 1792, NIN = 3328;
constexpr int DFF = 2816;
constexpr float RMS_EPS = 1e-6f;
constexpr float LOG2E = 1.4426950408889634f;
constexpr float QK_C = 0.125f * LOG2E;

constexpr size_t MiB = 1u << 20;
constexpr size_t OFF_LUT = 0;
constexpr size_t OFF_LTS = 512 * 1024, OFF_LTW = 640 * 1024;
constexpr size_t OFF_CBK = 64 * 1024, OFF_CBV = 66 * 1024;
constexpr size_t OFF_CBPART = 128 * 1024;
constexpr size_t OFF_SS1 = 1 * MiB, OFF_SS2 = 2 * MiB, OFF_SS3 = 3 * MiB;
constexpr size_t OFF_MEMN = 4 * MiB;
constexpr size_t OFF_KVX = 5 * MiB;
constexpr size_t OFF_KC = 7 * MiB, OFF_VC = 7 * MiB + 256 * 1024;
constexpr size_t OFF_H1K = 8 * MiB, OFF_H1V = 9 * MiB;
constexpr size_t OFF_WIN = 10 * MiB;
constexpr size_t OFF_WKV = 16 * MiB + 512 * 1024;
constexpr size_t OFF_WC1K = 20 * MiB + 512 * 1024, OFF_WC1V = 21 * MiB + 512 * 1024;
constexpr size_t OFF_WLORA = 22 * MiB + 512 * 1024;
constexpr size_t OFF_SUM = 8 * MiB;
constexpr size_t OFF_XN = 40 * MiB;
constexpr size_t OFF_PNSA = 72 * MiB;
constexpr size_t OFF_R1 = 120 * MiB;
constexpr size_t OFF_RW = 176 * MiB;
constexpr size_t OFF_WD = 168 * MiB;
constexpr size_t OFF_Q2 = 72 * MiB;
constexpr size_t OFF_XO = 176 * MiB;
constexpr size_t OFF_H = 72 * MiB;

__device__ __forceinline__ unsigned f2bf(float f) { unsigned u = __builtin_bit_cast(unsigned, f); return (u + 0x7fffu + ((u >> 16) & 1u)) >> 16; }
__device__ __forceinline__ unsigned pk2(float lo, float hi) { return f2bf(lo) | (f2bf(hi) << 16); }
__device__ __forceinline__ float bf2f(unsigned short b) { return __builtin_bit_cast(float, (unsigned)b << 16); }
__device__ __forceinline__ int lane_id() { int l; asm volatile("v_mbcnt_lo_u32_b32 %0, -1, 0\n\tv_mbcnt_hi_u32_b32 %0, -1, %0" : "=v"(l)); return l; }
__device__ __forceinline__ float wave_sum(float v) {
#pragma unroll
    for (int o = 1; o < 64; o <<= 1) v += __shfl_xor(v, o);
    return v;
}

typedef short s16x4 __attribute__((ext_vector_type(4)));
__device__ __forceinline__ int crow(int r, int hi) { return (r & 3) + 8 * (r >> 2) + 4 * hi; }
__device__ __forceinline__ s16x4 vtr(const LAS unsigned char* p) { return __builtin_bit_cast(s16x4, __builtin_amdgcn_ds_read_tr16_b64_v4i16((LAS s16x4*)p)); }

namespace pg8 {
constexpr int BM = 256, BK = 64, HALF = 128, HTB = HALF * BK * 2, STAGE_BYTES = 8 * HTB, NXCD = 8, WGM = 8;
__host__ __device__ __forceinline__ int lds_byte(int r, int c) { const int st = (r >> 4) * 2 + (c >> 5), rr = r & 15, cc = c & 31, ob = rr * 64 + cc * 2; return st * 1024 + (ob ^ (((ob >> 9) & 1) << 5)); }
__host__ __device__ __forceinline__ void stage_rc(int b, int& R, int& C) { const int st = b / 1024, sb = b % 1024, swz = sb ^ (((sb >> 9) & 1) << 5); R = (st >> 1) * 16 + swz / 64; C = (st & 1) * 32 + (swz % 64) / 2; }
__host__ __device__ __forceinline__ int perm32(int rho) { const int n = rho >> 4, i = rho & 15; return 8 * (i >> 2) + 4 * n + (i & 3); }

struct Unit { int pm, pn; };
struct Gemm { const bf16_t* A; const bf16_t* Bt; int M, N, K; int lda; int kstepA; int amode; };
__device__ __forceinline__ const char* a_tile(const Gemm& g, int pm) {
    if (g.amode == 0) return (const char*)g.A + (size_t)pm * BM * g.lda * 2;
    const int bh = pm >> 1, c0 = (pm & 1) * 256;
    return (const char*)g.A + ((size_t)((bh >> 1) * T_ + 16 * c0) * PN_LD + (bh & 1) * 64) * 2;
}

struct StaticOrder {
    int nM, nN, nwg, G, c;
    __device__ void init(int M, int N, int G_, int c_) { nM = M / BM; nN = N / BM; nwg = nM * nN; G = G_; c = c_; }
    __device__ bool next(int i, Unit& u) const {
        const long L = (long)i * G + c; if (L >= nwg || c < 0) return false;
        int wgid = (int)L; { const int q = nwg / NXCD, r = nwg % NXCD, xcd = wgid % NXCD, off = wgid / NXCD; wgid = (xcd < r ? xcd * (q + 1) : r * (q + 1) + (xcd - r) * q) + off; }
        const int nig = WGM * nN, gid = wgid / nig, fm = gid * WGM, gsz = (nM - fm) < WGM ? (nM - fm) : WGM;
        u.pm = fm + ((wgid % nig) % gsz); u.pn = (wgid % nig) / gsz; return true;
    }
};
struct ListOrder {
    int nN, n, j;
    __device__ void init(int M, int N, int first, int blk) { nN = N / BM; n = (M / BM) * nN; j = blk - first; }
    __device__ bool next(int i, Unit& u) const { if (i != 0 || j < 0 || j >= n) return false; u.pm = j / nN; u.pn = j % nN; return true; }
};

__device__ __forceinline__ unsigned cvt_pk_bf16(float lo, float hi) { unsigned r; asm volatile("v_cvt_pk_bf16_f32 %0, %1, %2" : "=v"(r) : "v"(lo), "v"(hi)); return r; }

template <class Epi, class Sched>
__device__ __forceinline__ void gemm_phase(LAS unsigned char* lds, const Gemm g, const Sched& S, const Epi& E, int wave_id) {
    const int wid = wave_id, lane = lane_id(), tid = wid * 64 + lane, wr = wid >> 2, wc = wid & 3, fr = lane & 15, fq = lane >> 4;
    const int K = g.K, nt = K / BK;
    unsigned voffA[2], voffB[2];
#pragma unroll
    for (int i = 0; i < 2; ++i) { int R, C; stage_rc(tid * 16 + i * 8192, R, C); const int Rb = (R & ~31) + perm32(R & 31);
        voffA[i] = (unsigned)(R * g.lda + C) * 2u; voffB[i] = (unsigned)(Rb * K + C) * 2u; }
    const size_t kstepA = (size_t)g.kstepA, kstepB = (size_t)(BK * 2);
    const size_t hstepA = (size_t)HALF * g.lda * 2, hstepB = (size_t)HALF * K * 2;
    const unsigned ldsw = (unsigned)wid * 1024u;
    const int aoff = lds_byte(wr * 64 + fr, fq * 8), boff = lds_byte(wc * 32 + fr, fq * 8);
#define PG8_SA(b, h) (((b) * 2 + (h)) * HTB)
#define PG8_SB(b, h) ((4 + (b) * 2 + (h)) * HTB)
#define PG8_STAGE(bufoff, gbase, voff) do { _Pragma("unroll") for (int _i = 0; _i < 2; ++_i) \
        __builtin_amdgcn_global_load_lds((const unsigned*)((const char*)(gbase) + (voff)[_i]), (LAS unsigned*)(lds + (bufoff) + ldsw + _i * 8192), 16, 0, 0); } while (0)
#define PG8_LDA(dst, b, h) do { _Pragma("unroll") for (int m = 0; m < 4; ++m) _Pragma("unroll") for (int k = 0; k < 2; ++k) dst[m][k] = *(const LAS bf16x8*)(lds + PG8_SA(b, h) + aoff + m * 2048 + k * 1024); } while (0)
#define PG8_LDB(dst, b, h) do { _Pragma("unroll") for (int n = 0; n < 2; ++n) _Pragma("unroll") for (int k = 0; k < 2; ++k) dst[n][k] = *(const LAS bf16x8*)(lds + PG8_SB(b, h) + boff + n * 2048 + k * 1024); } while (0)
#define PG8_MMA(ai, bj, At, Bt) do { __builtin_amdgcn_s_setprio(1); _Pragma("unroll") for (int m = 0; m < 4; ++m) _Pragma("unroll") for (int n = 0; n < 2; ++n) _Pragma("unroll") for (int k = 0; k < 2; ++k) \
        acc[ai][bj][m][n] = __builtin_amdgcn_mfma_f32_16x16x32_bf16(Bt[n][k], At[m][k], acc[ai][bj][m][n], 0, 0, 0); __builtin_amdgcn_s_setprio(0); } while (0)
#define PG8_WAIT_V(n) asm volatile("s_waitcnt vmcnt(" #n ")" ::: "memory")
#define PG8_WAIT_L(n) asm volatile("s_waitcnt lgkmcnt(" #n ")" ::: "memory")
#define PG8_BAR __builtin_amdgcn_s_barrier()
#define PG8_SCHED __builtin_amdgcn_sched_barrier(0)
    Unit cur, nxt; int ui = 0;
    if (!S.next(0, cur)) return;
    f32x4 acc[2][2][4][2];
#pragma unroll
    for (int a = 0; a < 2; ++a)
#pragma unroll
        for (int b = 0; b < 2; ++b)
#pragma unroll
            for (int m = 0; m < 4; ++m)
#pragma unroll
                for (int n = 0; n < 2; ++n) acc[a][b][m][n] = (f32x4){0.f, 0.f, 0.f, 0.f};
    bf16x8 At[4][2], B0[2][2], B1[2][2];
    const char* cA = a_tile(g, cur.pm); const char* cB = (const char*)g.Bt + (size_t)cur.pn * 2 * hstepB;
    PG8_STAGE(PG8_SB(0, 0), cB, voffB); PG8_STAGE(PG8_SB(0, 1), cB + hstepB, voffB); PG8_STAGE(PG8_SA(0, 0), cA, voffA); PG8_STAGE(PG8_SA(0, 1), cA + hstepA, voffA);
    if (wr == 1) PG8_BAR;
    PG8_WAIT_V(2); PG8_BAR;
    PG8_STAGE(PG8_SB(1, 0), cB + kstepB, voffB); PG8_STAGE(PG8_SA(1, 0), cA + kstepA, voffA); PG8_STAGE(PG8_SB(1, 1), cB + hstepB + kstepB, voffB);
    PG8_WAIT_V(6); PG8_BAR;
    for (;;) {
        const bool has_next = S.next(ui + 1, nxt);
        const char* nA = has_next ? a_tile(g, nxt.pm) : cA; const char* nB = has_next ? (const char*)g.Bt + (size_t)nxt.pn * 2 * hstepB : cB;
        for (int t = 0; t < nt; t += 2) {
            const bool last = (t == nt - 2);
            const char* a1 = cA + (size_t)(t + 1) * kstepA;
            const char* a2 = last ? nA : cA + (size_t)(t + 2) * kstepA; const char* b2 = last ? nB : cB + (size_t)(t + 2) * kstepB;
            const char* a3 = a2 + kstepA; const char* b3 = b2 + kstepB;
            PG8_LDB(B0, 0, 0); PG8_LDB(B1, 0, 1); PG8_SCHED; PG8_LDA(At, 0, 0); PG8_STAGE(PG8_SA(1, 1), a1 + hstepA, voffA);
            PG8_WAIT_V(8); PG8_WAIT_L(0); PG8_BAR; PG8_MMA(0, 0, At, B0); PG8_MMA(0, 1, At, B1); PG8_BAR; PG8_SCHED;
            PG8_LDA(At, 0, 1); PG8_STAGE(PG8_SB(0, 0), b2, voffB); PG8_STAGE(PG8_SB(0, 1), b2 + hstepB, voffB); PG8_STAGE(PG8_SA(0, 0), a2, voffA);
            PG8_WAIT_V(8); PG8_WAIT_L(0); PG8_BAR; PG8_MMA(1, 0, At, B0); PG8_MMA(1, 1, At, B1); PG8_BAR; PG8_SCHED;
            PG8_LDB(B0, 1, 0); PG8_LDB(B1, 1, 1); PG8_SCHED; PG8_LDA(At, 1, 0); PG8_STAGE(PG8_SA(0, 1), a2 + hstepA, voffA);
            PG8_WAIT_V(8); PG8_WAIT_L(0); PG8_BAR; PG8_MMA(0, 0, At, B0); PG8_MMA(0, 1, At, B1); PG8_BAR; PG8_SCHED;
            PG8_LDA(At, 1, 1); PG8_STAGE(PG8_SB(1, 0), b3, voffB); PG8_STAGE(PG8_SB(1, 1), b3 + hstepB, voffB); PG8_STAGE(PG8_SA(1, 0), a3, voffA);
            PG8_WAIT_V(8); PG8_WAIT_L(0); PG8_BAR; PG8_MMA(1, 0, At, B0); PG8_MMA(1, 1, At, B1); PG8_BAR; PG8_SCHED;
        }
        if (wr == 0) PG8_BAR;
        if constexpr (!Epi::AFTER_DRAIN) E(acc, cur, wr, wc, fr, fq);
        if (!has_next) break;
#pragma unroll
        for (int a = 0; a < 2; ++a)
#pragma unroll
            for (int b = 0; b < 2; ++b)
#pragma unroll
                for (int m = 0; m < 4; ++m)
#pragma unroll
                    for (int n = 0; n < 2; ++n) acc[a][b][m][n] = (f32x4){0.f, 0.f, 0.f, 0.f};
        cur = nxt; cA = nA; cB = nB; ++ui;
        if (wr == 1) PG8_BAR;
    }
    PG8_WAIT_V(0);
    PG8_BAR;
    if constexpr (Epi::AFTER_DRAIN) E.fused(acc, cur, wr, wc, fr, fq, lds, wid, lane);
#undef PG8_SA
#undef PG8_SB
#undef PG8_STAGE
#undef PG8_LDA
#undef PG8_LDB
#undef PG8_MMA
#undef PG8_WAIT_V
#undef PG8_WAIT_L
#undef PG8_BAR
#undef PG8_SCHED
}

typedef f32x4 Acc[2][2][4][2];
__device__ __forceinline__ float row_rs(const float* SS, int row) {
    const f32x4* p = (const f32x4*)(SS + (size_t)row * 16);
    const f32x4 a = p[0], b = p[1], c = p[2], d = p[3];
    const float s = ((a[0] + a[1]) + (a[2] + a[3])) + ((b[0] + b[1]) + (b[2] + b[3])) + ((c[0] + c[1]) + (c[2] + c[3])) + ((d[0] + d[1]) + (d[2] + d[3]));
    return __builtin_amdgcn_rsqf(s * (1.0f / D_) + RMS_EPS);
}
struct EpiStore {
    static constexpr bool AFTER_DRAIN = false;
    bf16_t* O0; int ld0; int npn0; bf16_t* O1; int ld1; int sc_lo, sc_hi; float scale;
    __device__ __forceinline__ void operator()(const Acc& acc, const Unit& u, int wr, int wc, int fr, int fq) const {
        bf16_t* base; int ld, colt;
        if (u.pn < npn0) { base = O0; ld = ld0; colt = u.pn * BM; } else { base = O1; ld = ld1; colt = (u.pn - npn0) * BM; }
        const int row0 = u.pm * BM + wr * 64 + fr, col0 = colt + wc * 32 + 8 * fq; const float sc = (u.pn >= sc_lo && u.pn < sc_hi) ? scale : 1.0f;
#pragma unroll
        for (int ai = 0; ai < 2; ++ai)
#pragma unroll
            for (int m = 0; m < 4; ++m) { bf16_t* rowp = base + (size_t)(row0 + ai * HALF + m * 16) * ld + col0;
#pragma unroll
                for (int bj = 0; bj < 2; ++bj) { const f32x4 v0 = acc[ai][bj][m][0] * sc, v1 = acc[ai][bj][m][1] * sc;
                    u32x4 w; w.x = cvt_pk_bf16(v0[0], v0[1]); w.y = cvt_pk_bf16(v0[2], v0[3]); w.z = cvt_pk_bf16(v1[0], v1[1]); w.w = cvt_pk_bf16(v1[2], v1[3]);
                    *(u32x4*)(rowp + bj * HALF) = w; } }
    }
};
__device__ __forceinline__ void load_base8(const float* basef, const bf16_t* baseb, const f32x4& gi0, const f32x4& gi1, bool base_xb, size_t off, f32x4& b0, f32x4& b1) {
    if (!base_xb) { b0 = *(const f32x4*)(basef + off); b1 = *(const f32x4*)(basef + off + 4); }
    else { const u32x4 w = *(const u32x4*)(baseb + off);
        b0 = (f32x4){__builtin_bit_cast(float, w.x << 16), __builtin_bit_cast(float, w.x & 0xffff0000u), __builtin_bit_cast(float, w.y << 16), __builtin_bit_cast(float, w.y & 0xffff0000u)} * gi0;
        b1 = (f32x4){__builtin_bit_cast(float, w.z << 16), __builtin_bit_cast(float, w.z & 0xffff0000u), __builtin_bit_cast(float, w.w << 16), __builtin_bit_cast(float, w.w & 0xffff0000u)} * gi1; }
}
__device__ __forceinline__ f32x4 rcp4(const f32x4 v) { return (f32x4){__builtin_amdgcn_rcpf(v[0]), __builtin_amdgcn_rcpf(v[1]), __builtin_amdgcn_rcpf(v[2]), __builtin_amdgcn_rcpf(v[3])}; }
template <bool BASE_XB> struct EpiResidual {
    static constexpr bool AFTER_DRAIN = false;
    const float* basef; const bf16_t* baseb; const float* gin; bf16_t* XB; const float* gout; float* SS;
    __device__ __forceinline__ void operator()(const Acc& acc, const Unit& u, int wr, int wc, int fr, int fq) const {
        const int row0 = u.pm * BM + wr * 64 + fr, col0 = u.pn * BM + wc * 32 + 8 * fq;
        f32x4 gv[2][2], gi[2][2];
#pragma unroll
        for (int bj = 0; bj < 2; ++bj)
#pragma unroll
            for (int n = 0; n < 2; ++n) { gv[bj][n] = *(const f32x4*)(gout + col0 + bj * HALF + 4 * n); gi[bj][n] = BASE_XB ? rcp4(*(const f32x4*)(gin + col0 + bj * HALF + 4 * n)) : gv[bj][n]; }
#pragma unroll
        for (int ai = 0; ai < 2; ++ai)
#pragma unroll
            for (int m = 0; m < 4; ++m) { const int row = row0 + ai * HALF + m * 16; const size_t off = (size_t)row * D_ + col0; float ss = 0.f;
#pragma unroll
                for (int bj = 0; bj < 2; ++bj) {
                    f32x4 b0, b1; load_base8(basef, baseb, gi[bj][0], gi[bj][1], BASE_XB, off + bj * HALF, b0, b1);
                    const f32x4 x0 = b0 + acc[ai][bj][m][0], x1 = b1 + acc[ai][bj][m][1];
                    ss += (x0[0] * x0[0] + x0[1] * x0[1]) + (x0[2] * x0[2] + x0[3] * x0[3]) + (x1[0] * x1[0] + x1[1] * x1[1]) + (x1[2] * x1[2] + x1[3] * x1[3]);
                    const f32x4 y0 = x0 * gv[bj][0], y1 = x1 * gv[bj][1];
                    u32x4 w; w.x = cvt_pk_bf16(y0[0], y0[1]); w.y = cvt_pk_bf16(y0[2], y0[3]); w.z = cvt_pk_bf16(y1[0], y1[1]); w.w = cvt_pk_bf16(y1[2], y1[3]);
                    *(u32x4*)(XB + off + bj * HALF) = w;
                }
                ss += __shfl_xor(ss, 16); ss += __shfl_xor(ss, 32);
                if (fq == 0) SS[(size_t)row * 16 + u.pn * 4 + wc] = ss;
            }
    }
};
struct EpiSwiglu {
    static constexpr bool AFTER_DRAIN = false;
    bf16_t* H; const float* SS;
    __device__ __forceinline__ void operator()(const Acc& acc, const Unit& u, int wr, int wc, int fr, int fq) const {
        const int row0 = u.pm * BM + wr * 64 + fr, col0 = u.pn * HALF + wc * 32 + 8 * fq;
#pragma unroll
        for (int ai = 0; ai < 2; ++ai)
#pragma unroll
            for (int m = 0; m < 4; ++m) { const int row = row0 + ai * HALF + m * 16; const float rs = row_rs(SS, row);
                float h[8];
#pragma unroll
                for (int n = 0; n < 2; ++n)
#pragma unroll
                    for (int j = 0; j < 4; ++j) { const float gt = acc[ai][0][m][n][j] * rs, up = acc[ai][1][m][n][j] * rs;
                        h[4 * n + j] = gt * __builtin_amdgcn_rcpf(1.0f + __builtin_amdgcn_exp2f(-gt * LOG2E)) * up; }
                u32x4 w; w.x = cvt_pk_bf16(h[0], h[1]); w.y = cvt_pk_bf16(h[2], h[3]); w.z = cvt_pk_bf16(h[4], h[5]); w.w = cvt_pk_bf16(h[6], h[7]);
                *(u32x4*)(H + (size_t)row * DFF + col0) = w; }
    }
};

struct EpiLora {
    static constexpr bool AFTER_DRAIN = false;
    float* W; bf16_t* Kp; const bf16_t* KK; bf16_t* Bv; bf16_t* G; const float* w0; const float* a0; const float* k_a;
    __device__ __forceinline__ void operator()(const Acc& acc, const Unit& u, int wr, int wc, int fr, int fq) const {
        const int region = u.pn >> 1, row0 = u.pm * BM + wr * 64 + fr, c0 = (u.pn & 1) * 256 + wc * 32 + 8 * fq;
#pragma unroll
        for (int ai = 0; ai < 2; ++ai)
#pragma unroll
            for (int m = 0; m < 4; ++m) { const int row = row0 + ai * HALF + m * 16;
#pragma unroll
                for (int bj = 0; bj < 2; ++bj) { const int c = c0 + bj * HALF; const size_t off = (size_t)row * 512 + c;
                    float v[8];
#pragma unroll
                    for (int i = 0; i < 8; ++i) v[i] = acc[ai][bj][m][i >> 2][i & 3];
                    if (region == 0) {
                        float o[8];
#pragma unroll
                        for (int i = 0; i < 8; ++i) { const float z = v[i] + w0[c + i]; const float sg = __builtin_amdgcn_rcpf(1.0f + __expf(-z)); o[i] = -0.6065306597126334f * sg; }
                        *(f32x4*)(W + off) = (f32x4){o[0], o[1], o[2], o[3]}; *(f32x4*)(W + off + 4) = (f32x4){o[4], o[5], o[6], o[7]};
                    } else if (region == 1) {
                        const u32x4 k8 = *(const u32x4*)(Kp + off), q8 = *(const u32x4*)(KK + off);
                        float kn[8], bn[8];
#pragma unroll
                        for (int i = 0; i < 8; ++i) { const float a = __builtin_amdgcn_rcpf(1.0f + __expf(-(v[i] + a0[c + i])));
                            const unsigned kw = k8[i >> 1], qw = q8[i >> 1];
                            const float kf = __builtin_bit_cast(float, (i & 1) ? (kw & 0xffff0000u) : (kw << 16)), qf = __builtin_bit_cast(float, (i & 1) ? (qw & 0xffff0000u) : (qw << 16));
                            kn[i] = kf * (1.0f + (a - 1.0f) * k_a[c + i]); bn[i] = qf * a; }
                        u32x4 w; w.x = cvt_pk_bf16(kn[0], kn[1]); w.y = cvt_pk_bf16(kn[2], kn[3]); w.z = cvt_pk_bf16(kn[4], kn[5]); w.w = cvt_pk_bf16(kn[6], kn[7]);
                        *(u32x4*)(Kp + off) = w;
                        w.x = cvt_pk_bf16(bn[0], bn[1]); w.y = cvt_pk_bf16(bn[2], bn[3]); w.z = cvt_pk_bf16(bn[4], bn[5]); w.w = cvt_pk_bf16(bn[6], bn[7]);
                        *(u32x4*)(Bv + off) = w;
                    } else {
                        u32x4 w; w.x = cvt_pk_bf16(v[0], v[1]); w.y = cvt_pk_bf16(v[2], v[3]); w.z = cvt_pk_bf16(v[4], v[5]); w.w = cvt_pk_bf16(v[6], v[7]);
                        *(u32x4*)(G + off) = w;
                    }
                } }
    }
};
struct EpiGelu {
    static constexpr bool AFTER_DRAIN = false;
    bf16_t* O; const float* cb;
    __device__ __forceinline__ void operator()(const Acc& acc, const Unit& u, int wr, int wc, int fr, int fq) const {
        const int row0 = u.pm * BM + wr * 64 + fr, col0 = u.pn * BM + wc * 32 + 8 * fq;
#pragma unroll
        for (int ai = 0; ai < 2; ++ai)
#pragma unroll
            for (int m = 0; m < 4; ++m) { const int row = row0 + ai * HALF + m * 16;
#pragma unroll
                for (int bj = 0; bj < 2; ++bj) { const int c = col0 + bj * HALF; float o[8];
#pragma unroll
                    for (int i = 0; i < 8; ++i) { const float z = acc[ai][bj][m][i >> 2][i & 3] + cb[c + i];
                        const float t = 0.7978845608028654f * (z + 0.044715f * z * z * z);
                        const float th = 1.0f - 2.0f * __builtin_amdgcn_rcpf(1.0f + __expf(2.0f * t));
                        o[i] = 0.5f * z * (1.0f + th); }
                    u32x4 w; w.x = cvt_pk_bf16(o[0], o[1]); w.y = cvt_pk_bf16(o[2], o[3]); w.z = cvt_pk_bf16(o[4], o[5]); w.w = cvt_pk_bf16(o[6], o[7]);
                    *(u32x4*)(O + (size_t)row * 256 + c) = w; } }
    }
};

struct EpiRowScale {
    static constexpr bool AFTER_DRAIN = false;
    bf16_t* O; const float* SS; float qscale;
    __device__ __forceinline__ void operator()(const Acc& acc, const Unit& u, int wr, int wc, int fr, int fq) const {
        const int row0 = u.pm * BM + wr * 64 + fr, col0 = u.pn * BM + wc * 32 + 8 * fq;
#pragma unroll
        for (int ai = 0; ai < 2; ++ai)
#pragma unroll
            for (int m = 0; m < 4; ++m) { const int row = row0 + ai * HALF + m * 16; const float rs = row_rs(SS, row) * qscale;
#pragma unroll
                for (int bj = 0; bj < 2; ++bj) { const f32x4 v0 = acc[ai][bj][m][0] * rs, v1 = acc[ai][bj][m][1] * rs;
                    u32x4 w; w.x = cvt_pk_bf16(v0[0], v0[1]); w.y = cvt_pk_bf16(v0[2], v0[3]); w.z = cvt_pk_bf16(v1[0], v1[1]); w.w = cvt_pk_bf16(v1[2], v1[3]);
                    *(u32x4*)(O + (size_t)row * D_ + col0 + bj * HALF) = w; } }
    }
};
struct EpiFinalNorm {
    static constexpr bool AFTER_DRAIN = true;
    const bf16_t* baseb; const float* gin; float* out; const float* gain; float* xs; unsigned* cnt;
    __device__ __forceinline__ void fused(Acc& acc, const Unit& u, int wr, int wc, int fr, int fq, LAS unsigned char* lds, int wid, int lane) const {
        LAS float* P = (LAS float*)lds;
        LAS float* S = (LAS float*)(lds + 4096);
        const int row0 = u.pm * BM + wr * 64 + fr, col0 = u.pn * BM + wc * 32 + 8 * fq;
#pragma unroll
        for (int ai = 0; ai < 2; ++ai)
#pragma unroll
            for (int m = 0; m < 4; ++m) { const size_t off = (size_t)(row0 + ai * HALF + m * 16) * D_ + col0; float ss = 0.f;
#pragma unroll
                for (int bj = 0; bj < 2; ++bj) { f32x4 b0, b1; load_base8(nullptr, baseb, rcp4(*(const f32x4*)(gin + col0 + bj * HALF)), rcp4(*(const f32x4*)(gin + col0 + bj * HALF + 4)), true, off + bj * HALF, b0, b1);
                    const f32x4 x0 = b0 + acc[ai][bj][m][0], x1 = b1 + acc[ai][bj][m][1];
                    acc[ai][bj][m][0] = x0; acc[ai][bj][m][1] = x1;
                    ss += (x0[0] * x0[0] + x0[1] * x0[1]) + (x0[2] * x0[2] + x0[3] * x0[3]) + (x1[0] * x1[0] + x1[1] * x1[1]) + (x1[2] * x1[2] + x1[3] * x1[3]); }
                ss += __shfl_xor(ss, 16); ss += __shfl_xor(ss, 32);
                if (fq == 0) P[(ai * HALF + wr * 64 + m * 16 + fr) * 4 + wc] = ss; }
        asm volatile("s_waitcnt lgkmcnt(0)" ::: "memory"); __builtin_amdgcn_s_barrier(); asm volatile("" ::: "memory");
        const int row = wid * 32 + (lane & 31);
        if (lane < 32) { const f32x4 pp = *(const LAS f32x4*)(P + row * 4);
            __hip_atomic_store(xs + (size_t)(u.pm * BM + row) * 4 + u.pn, (pp[0] + pp[1]) + (pp[2] + pp[3]), __ATOMIC_RELAXED, __HIP_MEMORY_SCOPE_AGENT); }
        asm volatile("s_waitcnt vmcnt(0)" ::: "memory");
        if (lane == 0) __hip_atomic_fetch_add(cnt + 64 * u.pm, 1u, __ATOMIC_RELAXED, __HIP_MEMORY_SCOPE_AGENT);
        if (wid == 0) { unsigned sp = 0;
            while ((unsigned)__builtin_amdgcn_readfirstlane(__hip_atomic_load(cnt + 64 * u.pm, __ATOMIC_RELAXED, __HIP_MEMORY_SCOPE_AGENT)) < 32u) { __builtin_amdgcn_s_sleep(2); if (++sp > (1u << 22)) break; }
            __builtin_amdgcn_fence(__ATOMIC_ACQUIRE, "agent"); }
        asm volatile("s_waitcnt vmcnt(0) lgkmcnt(0)" ::: "memory"); __builtin_amdgcn_s_barrier(); asm volatile("" ::: "memory");
        if (lane < 32) { const float* sl = xs + (size_t)(u.pm * BM + row) * 4; float t = 0.f;
#pragma unroll
            for (int k = 0; k < 4; ++k) t += __hip_atomic_load(sl + k, __ATOMIC_RELAXED, __HIP_MEMORY_SCOPE_AGENT);
            S[row] = __builtin_amdgcn_rsqf(t * (1.0f / D_) + RMS_EPS); }
        asm volatile("s_waitcnt lgkmcnt(0)" ::: "memory"); __builtin_amdgcn_s_barrier(); asm volatile("" ::: "memory");
        f32x4 gv[2][2];
#pragma unroll
        for (int bj = 0; bj < 2; ++bj)
#pragma unroll
            for (int n = 0; n < 2; ++n) gv[bj][n] = *(const f32x4*)(gain + col0 + bj * HALF + 4 * n);
#pragma unroll
        for (int ai = 0; ai < 2; ++ai)
#pragma unroll
            for (int m = 0; m < 4; ++m) { const int r = ai * HALF + wr * 64 + m * 16 + fr; const float rs = S[r]; const size_t off = (size_t)(u.pm * BM + r) * D_ + col0;
#pragma unroll
                for (int bj = 0; bj < 2; ++bj) { *(f32x4*)(out + off + bj * HALF) = acc[ai][bj][m][0] * rs * gv[bj][0]; *(f32x4*)(out + off + bj * HALF + 4) = acc[ai][bj][m][1] * rs * gv[bj][1]; } }
    }
};
}

constexpr int NWAVES = 8, NTHREADS = NWAVES * 64;
constexpr int RING_BYTES = 131072, LDS_CTRL = 147456, LDS_BYTES = 151552;
constexpr int N_PHASES = 14;
constexpr int CL = 128, NC = T_ / CL;
constexpr int TS = 8;
constexpr float LNX_EPS = 64e-5f;
constexpr size_t OFF_W = 120 * MiB, OFF_G = 152 * MiB;
constexpr size_t OFF_R = 176 * MiB, OFF_V = 192 * MiB, OFF_KK = 208 * MiB, OFF_KP = 224 * MiB, OFF_B = 240 * MiB;
constexpr size_t OFF_LORA_A = 24 * MiB, OFF_Y = 40 * MiB, OFF_PT = 56 * MiB;

struct Args { const float* in[36]; float* out; unsigned char* ws; int ph_lo, ph_hi; };

struct Frame {
    LAS unsigned char* lds;
    int wave, G, blk;
};

__device__ __forceinline__ int dst_row(int mode, int row_off, int n) {
    if (mode == 0) return row_off + n;
    if (mode == 1) return n < NSA_COLS ? RW_COLS + n : n - NSA_COLS;
    if (mode == 2) return 256 * (n >> 7) + (n & 127);
    return 256 * (n >> 7) + 128 + (n & 127);
}
__device__ __forceinline__ void p0_transpose_item(const float* W, int K, int N, bf16_t* WT, int ldt, int mode, int row_off, LAS float* scr, int item, int lane) {
    const int nblk = (N + 31) / 32, kb = item / nblk, nb = item % nblk, k0 = 64 * kb, n0 = 32 * nb;
    const int nq = n0 + 4 * (lane & 7); f32x4 ld[8];
#pragma unroll
    for (int i = 0; i < 8; ++i) ld[i] = nq < N ? *(const f32x4*)(W + (size_t)(k0 + 8 * i + (lane >> 3)) * N + nq) : (f32x4){0.f, 0.f, 0.f, 0.f};
#pragma unroll
    for (int i = 0; i < 8; ++i) { LAS float* d = scr + (8 * i + (lane >> 3)) * 33 + 4 * (lane & 7); d[0] = ld[i][0]; d[1] = ld[i][1]; d[2] = ld[i][2]; d[3] = ld[i][3]; }
    asm volatile("s_waitcnt lgkmcnt(0)" ::: "memory");
    const int c = lane & 7;
#pragma unroll
    for (int j = 0; j < 4; ++j) { const int n = (lane >> 3) + 8 * j; const LAS float* s = scr + (8 * c) * 33 + n;
        u32x4 o; o.x = pk2(s[0 * 33], s[1 * 33]); o.y = pk2(s[2 * 33], s[3 * 33]); o.z = pk2(s[4 * 33], s[5 * 33]); o.w = pk2(s[6 * 33], s[7 * 33]);
        if (n0 + n < N) *(u32x4*)(WT + (size_t)dst_row(mode, row_off, n0 + n) * ldt + k0 + 8 * c) = o; }
    asm volatile("s_waitcnt lgkmcnt(0)" ::: "memory");
}
__device__ __forceinline__ void rms_row_to_bf16(const float* xrow, const float* gain, bf16_t* orow, int lane) {
    const f32x4* xr = (const f32x4*)xrow + lane; f32x4 v[4]; float s = 0.f;
#pragma unroll
    for (int j = 0; j < 4; ++j) { v[j] = xr[64 * j]; s += (v[j][0] * v[j][0] + v[j][1] * v[j][1]) + (v[j][2] * v[j][2] + v[j][3] * v[j][3]); }
    const float rs = __builtin_amdgcn_rsqf(wave_sum(s) * (1.0f / D_) + RMS_EPS);
#pragma unroll
    for (int j = 0; j < 4; ++j) { const f32x4 g4 = *((const f32x4*)gain + lane + 64 * j); const f32x4 y = v[j] * rs * g4;
        u32x2 w; w.x = pk2(y[0], y[1]); w.y = pk2(y[2], y[3]); *((u32x2*)orow + lane + 64 * j) = w; }
}
__device__ __forceinline__ void unpack8(const u32x4 w, float* f) {
#pragma unroll
    for (int i = 0; i < 4; ++i) { f[2 * i] = __builtin_bit_cast(float, w[i] << 16); f[2 * i + 1] = __builtin_bit_cast(float, w[i] & 0xffff0000u); }
}
__device__ __forceinline__ u32x4 pack8(const float* f) { u32x4 w; w.x = pk2(f[0], f[1]); w.y = pk2(f[2], f[3]); w.z = pk2(f[4], f[5]); w.w = pk2(f[6], f[7]); return w; }

constexpr int RC_PITCH = 144, RC_SLOT = 9216, RC_GROUP = 8 * RC_SLOT;
__device__ __forceinline__ bf16x8 frag_nat(const LAS unsigned char* m, int kb, int col0, int lane) {
    const LAS unsigned char* p = m + (kb + 8 * (lane >> 5) + ((lane & 15) >> 2)) * RC_PITCH + (col0 + 16 * ((lane >> 4) & 1) + 4 * (lane & 3)) * 2;
    const s16x4 lo = vtr(p), hh = vtr(p + 4 * RC_PITCH);
    return (bf16x8){lo[0], lo[1], lo[2], lo[3], hh[0], hh[1], hh[2], hh[3]};
}
__device__ __forceinline__ bf16x8 frag_dir(const LAS unsigned char* m, int row0, int kb, int lane) {
    return *(const LAS bf16x8*)(m + (row0 + (lane & 31)) * RC_PITCH + (kb + 8 * (lane >> 5)) * 2);
}
template <bool TA, bool TB>
__device__ __forceinline__ f32x16 rc_mm(const LAS unsigned char* A, const LAS unsigned char* B, int i0, int j0, f32x16 acc, int lane) {
#pragma unroll
    for (int ks = 0; ks < 4; ++ks) { const bf16x8 a = TA ? frag_nat(A, 16 * ks, i0, lane) : frag_dir(A, i0, 16 * ks, lane), b = TB ? frag_nat(B, 16 * ks, j0, lane) : frag_dir(B, j0, 16 * ks, lane);
        acc = __builtin_amdgcn_mfma_f32_32x32x16_bf16(a, b, acc, 0, 0, 0); }
    return acc;
}
__device__ __forceinline__ void rc_store(LAS unsigned char* m, int i0, int j0, const f32x16& acc, int lane) {
    const int r32 = lane & 31, hi = lane >> 5;
#pragma unroll
    for (int r = 0; r < 16; ++r) *(LAS bf16_t*)(m + (i0 + crow(r, hi)) * RC_PITCH + (j0 + r32) * 2) = (bf16_t)f2bf(acc[r]);
}
#define RC_BAR() asm volatile("s_waitcnt lgkmcnt(0)\n\ts_barrier" ::: "memory")

__device__ __forceinline__ void rwkv_chunk(Frame& F, unsigned char* ws) {
    const float* LW = (const float*)(ws + OFF_W);
    const bf16_t* R = (const bf16_t*)(ws + OFF_R); const bf16_t* V = (const bf16_t*)(ws + OFF_V); const bf16_t* KK = (const bf16_t*)(ws + OFF_KK);
    const bf16_t* KP = (const bf16_t*)(ws + OFF_KP); const bf16_t* Bv = (const bf16_t*)(ws + OFF_B);
    bf16_t* Y = (bf16_t*)(ws + OFF_Y); bf16_t* PT = (bf16_t*)(ws + OFF_PT); float* SUM = (float*)(ws + OFF_SUM);
    const int lane = lane_id(), wave = F.wave, r32 = lane & 31, hi = lane >> 5;
    const int grp = wave >> 2, tw = wave & 3, i0 = (tw >> 1) * 32, j0 = (tw & 1) * 32, gtid = tw * 64 + lane;
    LAS unsigned char* gb = F.lds + grp * RC_GROUP;
#define SLOT(i) (gb + (i) * RC_SLOT)
    LAS float* gCl = (LAS float*)(F.lds + LDS_CTRL) + grp * 64;
    LAS float* clf = (LAS float*)SLOT(4);
    for (int hq = 0; hq < 4; ++hq) {
        const int hc = 4 * F.blk + hq, bh = hc / NC, c = hc % NC, h = bh & 7;
        const size_t m0 = (size_t)(bh >> 3) * T_ + (size_t)c * CL + 64 * grp;
        RC_BAR();
        u32x4 gk[2], gb2[2], gp[2], gr[2], gv[2]; f32x4 lw4[4];
#pragma unroll
        for (int i = 0; i < 4; ++i) { const int t = (gtid >> 4) + 16 * i, c4 = (gtid & 15) * 4; lw4[i] = *(const f32x4*)(LW + (m0 + t) * 512 + h * 64 + c4); }
        { const int t = gtid >> 2, c0 = (gtid & 3) * 16; const size_t go = (m0 + t) * 512 + h * 64 + c0;
#pragma unroll
          for (int hf = 0; hf < 2; ++hf) { gk[hf] = *(const u32x4*)(KK + go + 8 * hf); gb2[hf] = *(const u32x4*)(Bv + go + 8 * hf); gp[hf] = *(const u32x4*)(KP + go + 8 * hf); gr[hf] = *(const u32x4*)(R + go + 8 * hf); gv[hf] = *(const u32x4*)(V + go + 8 * hf); } }
#pragma unroll
        for (int i = 0; i < 4; ++i) { const int t = (gtid >> 4) + 16 * i, c4 = (gtid & 15) * 4; *(LAS f32x4*)(clf + t * 64 + c4) = lw4[i]; }
        RC_BAR();
        if (tw == 0) { float cv[64];
#pragma unroll
            for (int t = 0; t < 64; ++t) cv[t] = clf[t * 64 + lane];
#pragma unroll
            for (int t = 1; t < 64; ++t) cv[t] += cv[t - 1];
#pragma unroll
            for (int t = 0; t < 64; ++t) clf[t * 64 + lane] = cv[t];
            gCl[lane] = __expf(cv[63]); }
        RC_BAR();
        { const int t = gtid >> 2, c0 = (gtid & 3) * 16; const size_t go = (m0 + t) * 512 + h * 64 + c0;
#pragma unroll
          for (int hf = 0; hf < 2; ++hf) { const int cc = c0 + 8 * hf;
              float fk[8], fb[8], fp[8], fr[8]; unpack8(gk[hf], fk); unpack8(gb2[hf], fb); unpack8(gp[hf], fp); unpack8(gr[hf], fr);
              float oa[8], ob[8], ok[8], orr[8];
#pragma unroll
              for (int e = 0; e < 8; ++e) { const float cl = clf[t * 64 + cc + e], clm = t ? clf[(t - 1) * 64 + cc + e] : 0.f;
                  const float ep = __expf(cl), en = __builtin_amdgcn_rcpf(ep);
                  oa[e] = -fk[e] * __expf(clm); ob[e] = fb[e] * en; ok[e] = fp[e] * en; orr[e] = fr[e] * ep; }
              *(LAS u32x4*)(SLOT(0) + t * RC_PITCH + cc * 2) = pack8(oa); *(LAS u32x4*)(SLOT(1) + t * RC_PITCH + cc * 2) = pack8(ob);
              *(LAS u32x4*)(SLOT(2) + t * RC_PITCH + cc * 2) = pack8(ok); *(LAS u32x4*)(SLOT(3) + t * RC_PITCH + cc * 2) = pack8(orr); } }
        RC_BAR();
        f32x16 Tacc;
        { f32x16 lab = rc_mm<false, false>(SLOT(1), SLOT(0), i0, j0, (f32x16){}, lane), lka = rc_mm<false, false>(SLOT(2), SLOT(0), i0, j0, (f32x16){}, lane);
#pragma unroll
          for (int r = 0; r < 16; ++r) { const int sI = i0 + crow(r, hi), tJ = j0 + r32; const bool keep = sI < tJ; lab[r] = keep ? lab[r] : 0.f; lka[r] = keep ? lka[r] : 0.f; Tacc[r] = lab[r] + (sI == tJ ? 1.f : 0.f); }
          rc_store(SLOT(4), i0, j0, lab, lane); rc_store(SLOT(5), i0, j0, lka, lane); rc_store(SLOT(6), i0, j0, Tacc, lane); }
        RC_BAR();
#pragma unroll 1
        for (int itn = 0; itn < 5; ++itn) {
            LAS unsigned char* Pc = (itn & 1) ? SLOT(7) : SLOT(4); LAS unsigned char* Pn = (itn & 1) ? SLOT(4) : SLOT(7);
            { const f32x16 pn = rc_mm<false, true>(Pc, Pc, i0, j0, (f32x16){}, lane); rc_store(Pn, i0, j0, pn, lane); }
            RC_BAR();
            Tacc = rc_mm<false, true>(SLOT(6), Pn, i0, j0, Tacc, lane);
            RC_BAR();
            rc_store(SLOT(6), i0, j0, Tacc, lane);
        }
        { const int t = gtid >> 2, c0 = (gtid & 3) * 16; const size_t go = (m0 + t) * 512 + h * 64 + c0;
          (void)go; *(LAS u32x4*)(SLOT(7) + t * RC_PITCH + c0 * 2) = gv[0]; *(LAS u32x4*)(SLOT(7) + t * RC_PITCH + c0 * 2 + 16) = gv[1]; }
        RC_BAR();
        { const f32x16 z = rc_mm<true, true>(SLOT(5), SLOT(7), i0, j0, (f32x16){}, lane); rc_store(SLOT(4), i0, j0, z, lane); }
        RC_BAR();
        { const f32x16 a2 = rc_mm<true, true>(SLOT(6), SLOT(0), i0, j0, (f32x16){}, lane); rc_store(SLOT(5), i0, j0, a2, lane); }
        RC_BAR();
        { const f32x16 w1 = rc_mm<true, true>(SLOT(6), SLOT(4), i0, j0, (f32x16){}, lane); rc_store(SLOT(0), i0, j0, w1, lane); }
        RC_BAR();
        { f32x16 mb = rc_mm<false, false>(SLOT(1), SLOT(3), i0, j0, (f32x16){}, lane), mk = rc_mm<false, false>(SLOT(2), SLOT(3), i0, j0, (f32x16){}, lane);
#pragma unroll
          for (int r = 0; r < 16; ++r) { const bool keep = (i0 + crow(r, hi)) <= (j0 + r32); mb[r] = keep ? mb[r] : 0.f; mk[r] = keep ? mk[r] : 0.f; }
          rc_store(SLOT(4), i0, j0, mb, lane); rc_store(SLOT(6), i0, j0, mk, lane); }
        RC_BAR();
        f32x16 qm = rc_mm<true, true>(SLOT(4), SLOT(5), i0, j0, (f32x16){}, lane);
        f32x16 yl = rc_mm<true, true>(SLOT(6), SLOT(7), i0, j0, rc_mm<true, true>(SLOT(4), SLOT(0), i0, j0, (f32x16){}, lane), lane);
        f32x16 gg = rc_mm<true, true>(SLOT(5), SLOT(1), i0, j0, (f32x16){}, lane);
        f32x16 hh = rc_mm<true, true>(SLOT(7), SLOT(2), i0, j0, rc_mm<true, true>(SLOT(0), SLOT(1), i0, j0, (f32x16){}, lane), lane);
        { const float gc = gCl[j0 + r32];
#pragma unroll
          for (int r = 0; r < 16; ++r) { const int iI = i0 + crow(r, hi), jJ = j0 + r32;
              qm[r] += bf2f(*(const LAS bf16_t*)(SLOT(3) + iI * RC_PITCH + jJ * 2));
              gg[r] = (gg[r] + (iI == jJ ? 1.f : 0.f)) * gc; hh[r] *= gc; } }
        RC_BAR();
        { LAS float* f32m = (LAS float*)(F.lds + (grp ? 34816 : 0));
#pragma unroll
          for (int r = 0; r < 16; ++r) { const int iI = i0 + crow(r, hi), jJ = j0 + r32; f32m[iI * 68 + jJ] = gg[r]; f32m[4352 + iI * 68 + jJ] = hh[r]; }
          if (grp == 0) { rc_store(F.lds + 73728, i0, j0, gg, lane); rc_store(F.lds + 82944, i0, j0, hh, lane);
#pragma unroll
              for (int r = 0; r < 16; ++r) { const size_t o = (m0 + i0 + crow(r, hi)) * 512 + h * 64 + j0 + r32; PT[o] = (bf16_t)f2bf(qm[r]); Y[o] = (bf16_t)f2bf(yl[r]); } }
          else rc_store(F.lds + 92160, i0, j0, qm, lane); }
        RC_BAR();
        if (grp == 1) {
            const f32x16 q2 = rc_mm<false, false>(F.lds + 92160, F.lds + 73728, i0, j0, (f32x16){}, lane);
            yl = rc_mm<false, false>(F.lds + 92160, F.lds + 82944, i0, j0, yl, lane);
#pragma unroll
            for (int r = 0; r < 16; ++r) { const size_t o = (m0 + i0 + crow(r, hi)) * 512 + h * 64 + j0 + r32; PT[o] = (bf16_t)f2bf(q2[r]); Y[o] = (bf16_t)f2bf(yl[r]); }
        }
        {
            const LAS float* Am = (const LAS float*)(F.lds + (grp ? 17408 : 0)); const LAS float* Bm = (const LAS float*)(F.lds + 34816); const LAS float* Hb = (const LAS float*)(F.lds + 52224);
            const int iR = gtid >> 2, jq = (gtid & 3) * 16;
            float acc[16];
#pragma unroll
            for (int e = 0; e < 16; ++e) acc[e] = grp ? Hb[iR * 68 + jq + e] : 0.f;
#pragma unroll 4
            for (int k = 0; k < 64; ++k) { const float a = Am[iR * 68 + k];
#pragma unroll
                for (int q4 = 0; q4 < 4; ++q4) { const f32x4 b4 = *(const LAS f32x4*)(Bm + k * 68 + jq + 4 * q4); acc[4 * q4] += a * b4[0]; acc[4 * q4 + 1] += a * b4[1]; acc[4 * q4 + 2] += a * b4[2]; acc[4 * q4 + 3] += a * b4[3]; } }
            float* dst = SUM + (size_t)hc * 8192 + (grp ? 0 : 4096) + iR * 64 + jq;
#pragma unroll
            for (int q4 = 0; q4 < 4; ++q4) *(f32x4*)(dst + 4 * q4) = (f32x4){acc[4 * q4], acc[4 * q4 + 1], acc[4 * q4 + 2], acc[4 * q4 + 3]};
        }
    }
    RC_BAR();
#undef SLOT
}
#undef RC_BAR

__device__ __forceinline__ void rwkv_combine(Frame& F, unsigned char* ws, int bh) {
    float* SUM = (float*)(ws + OFF_SUM);
    LAS float* Sl = (LAS float*)F.lds;
    LAS float* Pl = (LAS float*)(F.lds + 20480);
    const int tid = F.wave * 64 + lane_id(), v = tid >> 3, kq = tid & 7;
    float cur[8];
#pragma unroll
    for (int i = 0; i < 8; ++i) cur[i] = 0.f;
    for (int c = 0; c < NC; ++c) {
        const size_t hc = (size_t)bh * NC + c;
        const float* pc = SUM + (hc * 2 + 1) * 4096 + tid * 8;
        *(LAS f32x4*)(Pl + tid * 8) = *(const f32x4*)pc; *(LAS f32x4*)(Pl + tid * 8 + 4) = *(const f32x4*)(pc + 4);
#pragma unroll
        for (int i = 0; i < 8; ++i) Sl[v * 65 + 8 * kq + i] = cur[i];
        float* se = SUM + (hc * 2) * 4096 + v * 64 + 8 * kq;
        const f32x4 e0 = *(const f32x4*)se, e1 = *(const f32x4*)(se + 4);
        *(f32x4*)se = (f32x4){cur[0], cur[1], cur[2], cur[3]}; *(f32x4*)(se + 4) = (f32x4){cur[4], cur[5], cur[6], cur[7]};
        __syncthreads();
        float acc[8] = {e0[0], e0[1], e0[2], e0[3], e1[0], e1[1], e1[2], e1[3]};
#pragma unroll 8
        for (int j = 0; j < 64; ++j) { const float s = Sl[v * 65 + j]; const f32x4 p0 = *(const LAS f32x4*)(Pl + j * 64 + 8 * kq), p1 = *(const LAS f32x4*)(Pl + j * 64 + 8 * kq + 4);
            acc[0] += s * p0[0]; acc[1] += s * p0[1]; acc[2] += s * p0[2]; acc[3] += s * p0[3]; acc[4] += s * p1[0]; acc[5] += s * p1[1]; acc[6] += s * p1[2]; acc[7] += s * p1[3]; }
        __syncthreads();
#pragma unroll
        for (int i = 0; i < 8; ++i) cur[i] = acc[i];
    }
}
__device__ __forceinline__ void rwkv_fixup_task(unsigned char* ws, const float* lnx_w, const float* lnx_b, const float* r_k, int hc, int tl, int lane) {
    const bf16_t* R = (const bf16_t*)(ws + OFF_R); const bf16_t* V = (const bf16_t*)(ws + OFF_V); const bf16_t* KP = (const bf16_t*)(ws + OFF_KP);
    const bf16_t* G = (const bf16_t*)(ws + OFF_G); const bf16_t* Y = (const bf16_t*)(ws + OFF_Y); const bf16_t* PT = (const bf16_t*)(ws + OFF_PT);
    const float* S = (const float*)(ws + OFF_SUM) + (size_t)hc * 8192; bf16_t* MIX = (bf16_t*)(ws + OFF_PNSA);
    const int r32 = lane & 31, hi = lane >> 5, bh = hc / NC, c = hc % NC, h = bh & 7;
    const size_t m = (size_t)(bh >> 3) * T_ + (size_t)c * CL + 32 * tl + r32;
    const size_t row = m * 512 + h * 64;
    f32x16 acc[2]; acc[0] = (f32x16){}; acc[1] = (f32x16){};
#pragma unroll
    for (int ks = 0; ks < 4; ++ks) {
        const bf16x8 bfrag = *(const bf16x8*)(PT + row + 16 * ks + 8 * hi);
#pragma unroll
        for (int vt = 0; vt < 2; ++vt) { const float* sp = S + (size_t)(32 * vt + r32) * 64 + 16 * ks + 8 * hi; const f32x4 s0 = *(const f32x4*)sp, s1 = *(const f32x4*)(sp + 4);
            u32x4 w; w.x = pk2(s0[0], s0[1]); w.y = pk2(s0[2], s0[3]); w.z = pk2(s1[0], s1[1]); w.w = pk2(s1[2], s1[3]);
            acc[vt] = __builtin_amdgcn_mfma_f32_32x32x16_bf16(__builtin_bit_cast(bf16x8, w), bfrag, acc[vt], 0, 0, 0); }
    }
    float y[32], s1 = 0.f, rkdot = 0.f;
#pragma unroll
    for (int gq = 0; gq < 8; ++gq) { const int vo = 32 * (gq >> 2) + 8 * (gq & 3) + 4 * hi;
        if (gq == 4) __builtin_amdgcn_sched_barrier(0);
        const u32x2 yw = *(const u32x2*)(Y + row + vo), rw = *(const u32x2*)(R + row + vo), kw = *(const u32x2*)(KP + row + vo); const f32x4 rk4 = *(const f32x4*)(r_k + h * 64 + vo);
#pragma unroll
        for (int j = 0; j < 4; ++j) { const unsigned yu = j < 2 ? yw.x : yw.y, ru = j < 2 ? rw.x : rw.y, ku = j < 2 ? kw.x : kw.y;
            const float yl = __builtin_bit_cast(float, (j & 1) ? (yu & 0xffff0000u) : (yu << 16)), rf = __builtin_bit_cast(float, (j & 1) ? (ru & 0xffff0000u) : (ru << 16)), kf = __builtin_bit_cast(float, (j & 1) ? (ku & 0xffff0000u) : (ku << 16));
            const float yy = acc[gq >> 2][4 * (gq & 3) + j] + yl; y[4 * gq + j] = yy; s1 += yy; rkdot += rf * kf * rk4[j]; } }
    s1 += __shfl_xor(s1, 32); rkdot += __shfl_xor(rkdot, 32);
    const float mean = s1 * (1.0f / 64.0f); float s2 = 0.f;
#pragma unroll
    for (int i = 0; i < 32; ++i) { y[i] -= mean; s2 += y[i] * y[i]; }
    s2 += __shfl_xor(s2, 32);
    const float rstd = __builtin_amdgcn_rsqf(s2 * (1.0f / 64.0f) + LNX_EPS);
#pragma unroll
    for (int gq = 0; gq < 8; ++gq) { const int vo = 32 * (gq >> 2) + 8 * (gq & 3) + 4 * hi;
        const u32x2 vw = *(const u32x2*)(V + row + vo), gw_ = *(const u32x2*)(G + row + vo); const f32x4 lw4 = *(const f32x4*)(lnx_w + h * 64 + vo), lb4 = *(const f32x4*)(lnx_b + h * 64 + vo);
        float o4[4];
#pragma unroll
        for (int j = 0; j < 4; ++j) { const unsigned vu = j < 2 ? vw.x : vw.y, gu = j < 2 ? gw_.x : gw_.y;
            const float vf = __builtin_bit_cast(float, (j & 1) ? (vu & 0xffff0000u) : (vu << 16)), gf = __builtin_bit_cast(float, (j & 1) ? (gu & 0xffff0000u) : (gu << 16));
            o4[j] = (y[4 * gq + j] * rstd * lw4[j] + lb4[j] + rkdot * vf) * gf; }
        u32x2 w; w.x = pk2(o4[0], o4[1]); w.y = pk2(o4[2], o4[3]);
        *(u32x2*)(MIX + m * PN_LD + 512 + h * 64 + vo) = w; }
}

__device__ __forceinline__ bf16x8 v_frag(const LAS unsigned char* vbase, int VP, int kb, int dcol0, int lane) {
    const int hi = lane >> 5;
    const LAS unsigned char* p = vbase + (kb + 4 * hi + ((lane & 15) >> 2)) * VP + (dcol0 + 16 * ((lane >> 4) & 1) + 4 * (lane & 3)) * 2;
    const s16x4 lo = vtr(p), hh = vtr(p + 8 * VP);
    return (bf16x8){lo[0], lo[1], lo[2], lo[3], hh[0], hh[1], hh[2], hh[3]};
}
typedef __bf16 bf16x2_t __attribute__((ext_vector_type(2)));
__device__ __forceinline__ unsigned cvtpk(float lo, float hi) { const f32x2 v = {lo, hi}; return __builtin_bit_cast(unsigned, __builtin_convertvector(v, bf16x2_t)); }
__device__ __forceinline__ bf16x8 p_frag(const f32x16& p, int s) {
    u32x4 w; w.x = cvtpk(p[8 * s + 0], p[8 * s + 1]); w.y = cvtpk(p[8 * s + 2], p[8 * s + 3]); w.z = cvtpk(p[8 * s + 4], p[8 * s + 5]); w.w = cvtpk(p[8 * s + 6], p[8 * s + 7]);
    return __builtin_bit_cast(bf16x8, w);
}
__device__ __forceinline__ float max16(const f32x16& p) { float m = p[0];
#pragma unroll
    for (int r = 1; r < 16; ++r) m = fmaxf(m, p[r]);
    return m; }
__device__ __forceinline__ float sum16(const f32x16& p) { float a = 0.f;
#pragma unroll
    for (int r = 0; r < 16; ++r) a += p[r];
    return a; }

constexpr int XK_PITCH = 528, XV_PITCH = 144;
__device__ __forceinline__ void xattn_unit(Frame& F, const bf16_t* Q2, const bf16_t* KVX, bf16_t* XO, int b, int h4, int qt) {
    const int lane = lane_id(), wave = F.wave, tid = wave * 64 + lane, r32 = lane & 31, hi = lane >> 5;
    LAS unsigned char* kl = F.lds;
    LAS float* wsf = (LAS float*)(F.lds + 40960) + wave * 32;
    const size_t qrow = (size_t)b * T_ + (size_t)qt * 256 + wave * 32 + r32;
    bf16x8 qr[16];
#pragma unroll
    for (int ds = 0; ds < 16; ++ds) qr[ds] = *(const bf16x8*)(Q2 + qrow * D_ + h4 * 256 + 16 * ds + 8 * hi);
    const bf16_t* kg = KVX + (size_t)b * 256 * 2048 + h4 * 256;
    const bf16_t* vg = kg + 1024;
    float mref = 0.f, lrow = 0.f;
    bf16x8 PA[4][4];
    u32x4 pre[4];
#define XA_LOADK(kt_) do { _Pragma("unroll") for (int it = 0; it < 4; ++it) { const int idx = it * 512 + tid, row = idx >> 5, ch = idx & 31; pre[it] = *(const u32x4*)(kg + (size_t)((kt_) * 64 + row) * 2048 + ch * 8); } } while (0)
#define XA_WRITEK() do { _Pragma("unroll") for (int it = 0; it < 4; ++it) { const int idx = it * 512 + tid, row = idx >> 5, ch = idx & 31; *(LAS u32x4*)(kl + row * XK_PITCH + ch * 16) = pre[it]; } } while (0)
#define XA_LOADV(ds_) do { _Pragma("unroll") for (int it = 0; it < 4; ++it) { const int idx = it * 512 + tid, row = idx >> 3, ch = idx & 7; pre[it] = *(const u32x4*)(vg + (size_t)row * 2048 + (ds_) * 64 + ch * 8); } } while (0)
#define XA_WRITEV() do { _Pragma("unroll") for (int it = 0; it < 4; ++it) { const int idx = it * 512 + tid, row = idx >> 3, ch = idx & 7; *(LAS u32x4*)(kl + row * XV_PITCH + ch * 16) = pre[it]; } } while (0)
    __syncthreads();
    XA_LOADK(0); XA_WRITEK();
    __syncthreads();
#pragma unroll
    for (int kt = 0; kt < 4; ++kt) {
        if (kt < 3) XA_LOADK(kt + 1); else XA_LOADV(0);
        f32x16 p0 = {}, p1 = {};
#pragma unroll
        for (int ds = 0; ds < 16; ++ds) {
            const bf16x8 a0 = *(const LAS bf16x8*)(kl + r32 * XK_PITCH + (16 * ds + 8 * hi) * 2), a1 = *(const LAS bf16x8*)(kl + (32 + r32) * XK_PITCH + (16 * ds + 8 * hi) * 2);
            p0 = __builtin_amdgcn_mfma_f32_32x32x16_bf16(a0, qr[ds], p0, 0, 0, 0); p1 = __builtin_amdgcn_mfma_f32_32x32x16_bf16(a1, qr[ds], p1, 0, 0, 0); }
        float tmax = fmaxf(max16(p0), max16(p1)); tmax = fmaxf(tmax, __shfl_xor(tmax, 32));
        if (kt == 0) mref = tmax;
        else if (__any(tmax > mref + 16.0f)) {
            const float mnew = fmaxf(mref, tmax), alpha = __builtin_amdgcn_exp2f(mref - mnew);
            lrow *= alpha; mref = mnew;
#pragma unroll
            for (int kk = 0; kk < 4; ++kk) if (kk < kt) {
#pragma unroll
                for (int ks = 0; ks < 4; ++ks) { float f[8]; unpack8(__builtin_bit_cast(u32x4, PA[kk][ks]), f);
#pragma unroll
                    for (int e = 0; e < 8; ++e) f[e] *= alpha;
                    PA[kk][ks] = __builtin_bit_cast(bf16x8, pack8(f)); } }
        }
#pragma unroll
        for (int r = 0; r < 16; ++r) { p0[r] = __builtin_amdgcn_exp2f(p0[r] - mref); p1[r] = __builtin_amdgcn_exp2f(p1[r] - mref); }
        lrow += sum16(p0) + sum16(p1);
        PA[kt][0] = p_frag(p0, 0); PA[kt][1] = p_frag(p0, 1); PA[kt][2] = p_frag(p1, 0); PA[kt][3] = p_frag(p1, 1);
        __syncthreads();
        if (kt < 3) XA_WRITEK(); else XA_WRITEV();
        __syncthreads();
    }
    lrow += __shfl_xor(lrow, 32);
    if (hi == 0) wsf[r32] = __builtin_amdgcn_rcpf(lrow);
    asm volatile("s_waitcnt lgkmcnt(0)" ::: "memory");
#pragma unroll 1
    for (int dsl = 0; dsl < 4; ++dsl) {
        if (dsl < 3) XA_LOADV(dsl + 1);
        LAS unsigned char* ost = F.lds + 45056 + wave * 4608;
#pragma unroll
        for (int d0 = 0; d0 < 2; ++d0) {
            f32x16 o = {};
#pragma unroll
            for (int kt = 0; kt < 4; ++kt)
#pragma unroll
                for (int ks = 0; ks < 4; ++ks) o = __builtin_amdgcn_mfma_f32_32x32x16_bf16(PA[kt][ks], v_frag(kl, XV_PITCH, kt * 64 + 16 * ks, 32 * d0, lane), o, 0, 0, 0);
#pragma unroll
            for (int r = 0; r < 16; ++r) { const int q = crow(r, hi); *(LAS bf16_t*)(ost + q * 144 + (32 * d0 + r32) * 2) = (bf16_t)f2bf(o[r] * wsf[q]); }
        }
        asm volatile("s_waitcnt lgkmcnt(0)" ::: "memory");
#pragma unroll
        for (int i = 0; i < 4; ++i) { const int row = i * 8 + (lane >> 3), ch = lane & 7; *(u32x4*)(XO + (unsigned)(((b * T_ + qt * 256 + wave * 32 + row) * D_) + h4 * 256 + dsl * 64 + ch * 8)) = *(const LAS u32x4*)(ost + row * 144 + ch * 16); }
        __syncthreads();
        if (dsl < 3) XA_WRITEV();
        __syncthreads();
    }
#undef XA_LOADK
#undef XA_WRITEK
#undef XA_LOADV
#undef XA_WRITEV
}

constexpr int NK_PITCH = 128, NT_SLOT = 16384;
constexpr int NS_N = 2668, NW_N = 644;
constexpr int NL_IMP = 32768, NL_LUTS = 66560, NL_LUTW = 109248, NL_NEG = 119552, NL_SELM = 120064, NL_WSF = 121088, NL_B31 = 125184;
constexpr int IMP_PITCH = 132;

__device__ __forceinline__ void nsa_bias_cmp(f32x16& p0, f32x16& p1, const LAS float* lutsg, int db) {
    const int base = NS_N - 69 - db;
#pragma unroll
    for (int r = 0; r < 16; ++r) { const int kc = (r & 3) + 8 * (r >> 2);
        p0[r] += lutsg[min(base + 16 * kc, NS_N - 1)]; p1[r] += lutsg[min(base + 16 * (kc + 32), NS_N - 1)]; }
}
__device__ __forceinline__ void nsa_bias_tab(f32x16& p0, f32x16& p1, const LAS float* tab) {
#pragma unroll
    for (int r = 0; r < 16; ++r) { const int kc = (r & 3) + 8 * (r >> 2);
        p0[r] += tab[kc]; p1[r] += tab[kc + 32]; }
}
__device__ __forceinline__ void nsa_bias_const(f32x16& p0, f32x16& p1, float rt) {
#pragma unroll
    for (int r = 0; r < 16; ++r) { p0[r] += rt; p1[r] += rt; }
}
__device__ __forceinline__ void nsa_online(f32x16& p0, f32x16& p1, float& mrow, float& lrow, f32x16* o, LAS float* wsf, int hi, int r32) {
    float tmax = fmaxf(max16(p0), max16(p1)); tmax = fmaxf(tmax, __shfl_xor(tmax, 32));
    if (__any(tmax > mrow + 8.0f)) {
        const float mnew = fmaxf(mrow, tmax), msafe = (mnew == -INFINITY) ? 0.f : mnew;
        const float alpha = __builtin_amdgcn_exp2f(mrow - msafe);
        lrow *= alpha;
        if (o != nullptr) {
            if (hi == 0) wsf[r32] = alpha;
            asm volatile("s_waitcnt lgkmcnt(0)" ::: "memory");
#pragma unroll
            for (int r = 0; r < 16; ++r) { const float a = wsf[crow(r, hi)]; o[0][r] *= a; o[1][r] *= a; }
            asm volatile("s_waitcnt lgkmcnt(0)" ::: "memory");
        }
        mrow = mnew;
    }
    const float mref = (mrow == -INFINITY) ? 0.f : mrow;
#pragma unroll
    for (int r = 0; r < 16; ++r) { p0[r] = __builtin_amdgcn_exp2f(p0[r] - mref); p1[r] = __builtin_amdgcn_exp2f(p1[r] - mref); }
    lrow += (sum16(p0) + sum16(p1));
}
__device__ __forceinline__ void nsa_resc(float& mref, float psum, float& lrow, f32x16* o, LAS float* wsf, int hi, int r32) {
    if (__any(psum > 16384.0f)) {
        const float d = psum > 16384.0f ? __builtin_amdgcn_logf(psum) : 0.f, alpha = __builtin_amdgcn_exp2f(-d);
        lrow *= alpha; mref += d;
        if (hi == 0) wsf[r32] = alpha;
        asm volatile("s_waitcnt lgkmcnt(0)" ::: "memory");
#pragma unroll
        for (int r = 0; r < 16; ++r) { const float a = wsf[crow(r, hi)]; o[0][r] *= a; o[1][r] *= a; }
        asm volatile("s_waitcnt lgkmcnt(0)" ::: "memory");
    }
}
__device__ __forceinline__ int nsa_swz(int row) { const int x = (row >> 1) & 7; return ((x & 1) << 2) | (x & 2) | ((x >> 2) & 1); }
__device__ __forceinline__ void nsa_dma(const bf16_t* src, int pitch, LAS unsigned char* dst, int wave, int lane) {
    const int row = 8 * wave + (lane >> 3), c = (lane & 7) ^ nsa_swz(row);
    __builtin_amdgcn_global_load_lds((const unsigned*)(src + (size_t)row * pitch + c * 8), (LAS unsigned*)(dst + wave * 1024), 16, 0, 0);
}
__device__ __forceinline__ void nsa_qk(f32x16& p0, f32x16& p1, const LAS unsigned char* kl, const bf16x8* qr, int r32, int hi) {
    p0 = (f32x16){}; p1 = (f32x16){};
#pragma unroll
    for (int ds = 0; ds < 4; ++ds) {
        const int co = (((2 * ds + hi) ^ nsa_swz(r32)) << 4);
        const bf16x8 a0 = *(const LAS bf16x8*)(kl + r32 * NK_PITCH + co), a1 = *(const LAS bf16x8*)(kl + (32 + r32) * NK_PITCH + co);
        p0 = __builtin_amdgcn_mfma_f32_32x32x16_bf16(a0, qr[ds], p0, 0, 0, 0); p1 = __builtin_amdgcn_mfma_f32_32x32x16_bf16(a1, qr[ds], p1, 0, 0, 0); }
}
__device__ __forceinline__ void nsa_kfrags(bf16x8* ka, const LAS unsigned char* kl, int r32, int hi) {
#pragma unroll
    for (int ds = 0; ds < 4; ++ds) { const int co = (((2 * ds + hi) ^ nsa_swz(r32)) << 4);
        ka[2 * ds] = *(const LAS bf16x8*)(kl + r32 * NK_PITCH + co); ka[2 * ds + 1] = *(const LAS bf16x8*)(kl + (32 + r32) * NK_PITCH + co); }
}
__device__ __forceinline__ void nsa_qk_frags(f32x16& p0, f32x16& p1, const bf16x8* ka, const bf16x8* qr) {
    p0 = (f32x16){}; p1 = (f32x16){};
#pragma unroll
    for (int ds = 0; ds < 4; ++ds) { p0 = __builtin_amdgcn_mfma_f32_32x32x16_bf16(ka[2 * ds], qr[ds], p0, 0, 0, 0); p1 = __builtin_amdgcn_mfma_f32_32x32x16_bf16(ka[2 * ds + 1], qr[ds], p1, 0, 0, 0); }
}
__device__ __forceinline__ bf16x8 nsa_vfrag(const LAS unsigned char* vl, int kb, int d0, int lane) {
    const int hi = lane >> 5, row0 = 4 * hi + ((lane & 15) >> 2), chunk = 4 * d0 + 2 * ((lane >> 4) & 1) + ((lane & 3) >> 1), within = (lane & 1) * 8;
    const LAS unsigned char* pa = vl + (kb + row0) * NK_PITCH + ((chunk ^ nsa_swz(row0)) << 4) + within;
    const LAS unsigned char* pb = vl + (kb + row0 + 8) * NK_PITCH + ((chunk ^ nsa_swz(row0 + 8)) << 4) + within;
    const s16x4 lo = vtr(pa), hh = vtr(pb);
    return (bf16x8){lo[0], lo[1], lo[2], lo[3], hh[0], hh[1], hh[2], hh[3]};
}
__device__ __forceinline__ void nsa_pv(f32x16* o, const f32x16& p0, const f32x16& p1, const LAS unsigned char* vl, int lane) {
    const bf16x8 a0 = p_frag(p0, 0), a1 = p_frag(p0, 1), a2 = p_frag(p1, 0), a3 = p_frag(p1, 1);
#pragma unroll
    for (int d0 = 0; d0 < 2; ++d0) {
        o[d0] = __builtin_amdgcn_mfma_f32_32x32x16_bf16(a0, nsa_vfrag(vl, 0, d0, lane), o[d0], 0, 0, 0);
        o[d0] = __builtin_amdgcn_mfma_f32_32x32x16_bf16(a1, nsa_vfrag(vl, 16, d0, lane), o[d0], 0, 0, 0);
        o[d0] = __builtin_amdgcn_mfma_f32_32x32x16_bf16(a2, nsa_vfrag(vl, 32, d0, lane), o[d0], 0, 0, 0);
        o[d0] = __builtin_amdgcn_mfma_f32_32x32x16_bf16(a3, nsa_vfrag(vl, 48, d0, lane), o[d0], 0, 0, 0); }
}
typedef unsigned u32x2 __attribute__((ext_vector_type(2)));
__device__ __forceinline__ s16x4 nsa_cfrag(float c, int hi) {
    const unsigned ch = f2bf(c); const float rem = c - bf2f((bf16_t)ch); const unsigned cl = (c == -INFINITY) ? 0u : f2bf(rem);
    const unsigned w0 = hi ? 0u : (ch | (cl << 16));
    return __builtin_bit_cast(s16x4, (u32x2){w0, 0u});
}
__device__ __forceinline__ s16x4 nsa_onesfrag() { return __builtin_bit_cast(s16x4, (u32x2){0x3F803F80u, 0x3F803F80u}); }
__device__ __forceinline__ void nsa_qk_frags_c(f32x16& p0, f32x16& p1, const bf16x8* ka, const bf16x8* qr, s16x4 cf) {
    p0 = __builtin_amdgcn_mfma_f32_32x32x8bf16_1k(nsa_onesfrag(), cf, (f32x16){}, 0, 0, 0); p1 = __builtin_amdgcn_mfma_f32_32x32x8bf16_1k(nsa_onesfrag(), cf, (f32x16){}, 0, 0, 0);
#pragma unroll
    for (int ds = 0; ds < 4; ++ds) { p0 = __builtin_amdgcn_mfma_f32_32x32x16_bf16(ka[2 * ds], qr[ds], p0, 0, 0, 0); p1 = __builtin_amdgcn_mfma_f32_32x32x16_bf16(ka[2 * ds + 1], qr[ds], p1, 0, 0, 0); }
}
__device__ __forceinline__ void nsa_qk_c(f32x16& p0, f32x16& p1, const LAS unsigned char* kl, const bf16x8* qr, int r32, int hi, s16x4 cf) {
    p0 = __builtin_amdgcn_mfma_f32_32x32x8bf16_1k(nsa_onesfrag(), cf, (f32x16){}, 0, 0, 0); p1 = __builtin_amdgcn_mfma_f32_32x32x8bf16_1k(nsa_onesfrag(), cf, (f32x16){}, 0, 0, 0);
#pragma unroll
    for (int ds = 0; ds < 4; ++ds) {
        const int co = (((2 * ds + hi) ^ nsa_swz(r32)) << 4);
        const bf16x8 a0 = *(const LAS bf16x8*)(kl + r32 * NK_PITCH + co), a1 = *(const LAS bf16x8*)(kl + (32 + r32) * NK_PITCH + co);
        p0 = __builtin_amdgcn_mfma_f32_32x32x16_bf16(a0, qr[ds], p0, 0, 0, 0); p1 = __builtin_amdgcn_mfma_f32_32x32x16_bf16(a1, qr[ds], p1, 0, 0, 0); }
}
__device__ __forceinline__ float nsa_tile_exp_plain(f32x16& p0, f32x16& p1) {
#pragma unroll
    for (int r = 0; r < 16; ++r) { p0[r] = __builtin_amdgcn_exp2f(p0[r]); p1[r] = __builtin_amdgcn_exp2f(p1[r]); }
    return sum16(p0) + sum16(p1);
}
__device__ __forceinline__ float nsa_tile_exp_tab0(f32x16& p0, f32x16& p1, const LAS float* tab) {
#pragma unroll
    for (int r = 0; r < 16; ++r) { const int kc = (r & 3) + 8 * (r >> 2); p0[r] = __builtin_amdgcn_exp2f(p0[r] + tab[kc]); p1[r] = __builtin_amdgcn_exp2f(p1[r] + tab[kc + 32]); }
    return sum16(p0) + sum16(p1);
}
__device__ __forceinline__ void nsa_tile_exp_only(f32x16& p0, f32x16& p1) {
#pragma unroll
    for (int r = 0; r < 16; ++r) { p0[r] = __builtin_amdgcn_exp2f(p0[r]); p1[r] = __builtin_amdgcn_exp2f(p1[r]); }
}
__device__ __forceinline__ void nsa_tile_exp_tab_only(f32x16& p0, f32x16& p1, const LAS float* tab) {
#pragma unroll
    for (int r = 0; r < 16; ++r) { const int kc = (r & 3) + 8 * (r >> 2); p0[r] = __builtin_amdgcn_exp2f(p0[r] + tab[kc]); p1[r] = __builtin_amdgcn_exp2f(p1[r] + tab[kc + 32]); }
}
__device__ __forceinline__ float nsa_tile_exp_const(f32x16& p0, f32x16& p1, float c) {
#pragma unroll
    for (int r = 0; r < 16; ++r) { p0[r] = __builtin_amdgcn_exp2f(p0[r] + c); p1[r] = __builtin_amdgcn_exp2f(p1[r] + c); }
    return sum16(p0) + sum16(p1);
}
__device__ __forceinline__ float nsa_tile_exp_tab(f32x16& p0, f32x16& p1, const LAS float* tab, float mref) {
#pragma unroll
    for (int r = 0; r < 16; ++r) { const int kc = (r & 3) + 8 * (r >> 2); p0[r] += tab[kc]; p1[r] += tab[kc + 32]; }
#pragma unroll
    for (int r = 0; r < 16; ++r) { p0[r] = __builtin_amdgcn_exp2f(p0[r] - mref); p1[r] = __builtin_amdgcn_exp2f(p1[r] - mref); }
    return sum16(p0) + sum16(p1);
}
__device__ __forceinline__ void nsa_vfrags(bf16x8* vf, const LAS unsigned char* vl, int lane) {
#pragma unroll
    for (int d0 = 0; d0 < 2; ++d0)
#pragma unroll
        for (int k = 0; k < 4; ++k) vf[4 * d0 + k] = nsa_vfrag(vl, 16 * k, d0, lane);
}
__device__ __forceinline__ void nsa_pv_frags(f32x16* o, bf16x8 a0, bf16x8 a1, bf16x8 a2, bf16x8 a3, const bf16x8* vf) {
#pragma unroll
    for (int d0 = 0; d0 < 2; ++d0) {
        o[d0] = __builtin_amdgcn_mfma_f32_32x32x16_bf16(a0, vf[4 * d0 + 0], o[d0], 0, 0, 0);
        o[d0] = __builtin_amdgcn_mfma_f32_32x32x16_bf16(a1, vf[4 * d0 + 1], o[d0], 0, 0, 0);
        o[d0] = __builtin_amdgcn_mfma_f32_32x32x16_bf16(a2, vf[4 * d0 + 2], o[d0], 0, 0, 0);
        o[d0] = __builtin_amdgcn_mfma_f32_32x32x16_bf16(a3, vf[4 * d0 + 3], o[d0], 0, 0, 0); }
}
__device__ __forceinline__ void nsa_emit(bf16_t* dst0, const f32x16* o, float f, bool accumulate, bool dry, LAS float* wsf, int hi, int r32) {
    if (hi == 0) wsf[r32] = f;
    asm volatile("s_waitcnt lgkmcnt(0)" ::: "memory");
    float v0[16], v1[16];
#pragma unroll
    for (int r = 0; r < 16; ++r) { v0[r] = 0.f; v1[r] = 0.f; }
    if (accumulate) {
#pragma unroll
        for (int r = 0; r < 16; ++r) { const int q = crow(r, hi); const bf16_t* src = dst0 + (size_t)(q & 7) * PN_LD + (q >> 3) * 64; v0[r] = bf2f(src[0]); v1[r] = bf2f(src[32]); }
    }
#pragma unroll
    for (int r = 0; r < 16; ++r) { const float a = wsf[crow(r, hi)]; v0[r] += o[0][r] * a; v1[r] += o[1][r] * a; }
    if (!dry) {
#pragma unroll
        for (int r = 0; r < 16; ++r) { const int q = crow(r, hi); bf16_t* dst = dst0 + (size_t)(q & 7) * PN_LD + (q >> 3) * 64; dst[0] = (bf16_t)f2bf(v0[r]); dst[32] = (bf16_t)f2bf(v1[r]); }
    }
    asm volatile("s_waitcnt lgkmcnt(0)" ::: "memory");
}

__device__ __forceinline__ int sum8_dpp(int c) {
    c += __builtin_amdgcn_update_dpp(0, c, 0xB1, 0xF, 0xF, true);
    c += __builtin_amdgcn_update_dpp(0, c, 0x4E, 0xF, 0xF, true);
    c += __builtin_amdgcn_update_dpp(0, c, 0x141, 0xF, 0xF, true);
    return c;
}
__device__ __forceinline__ void nsa_unit(Frame& F, unsigned char* ws, const float* gate_b, int b, int hkv, int qblk, bool dry = false) {
    const int lane = lane_id(), wave = F.wave, tid = wave * 64 + lane, r32 = lane & 31, hi = lane >> 5;
    const int g = r32 >> 3, qi = r32 & 7;
    const int tq = 64 * qblk + 8 * wave + qi;
    bf16_t* PN = (bf16_t*)(ws + OFF_PNSA);
    const bf16_t* KCg = (const bf16_t*)(ws + OFF_KC) + (size_t)(b * 2 + hkv) * 512 * 64; const bf16_t* VCg = (const bf16_t*)(ws + OFF_VC) + (size_t)(b * 2 + hkv) * 512 * 64;
    LAS unsigned char* lds = F.lds;
    LAS float* luts = (LAS float*)(lds + NL_LUTS); LAS float* lutw = (LAS float*)(lds + NL_LUTW); LAS float* negt = (LAS float*)(lds + NL_NEG);
    LAS float* impl = (LAS float*)(lds + NL_IMP); LAS unsigned* selm = (LAS unsigned*)(lds + NL_SELM);
    LAS float* wsf = (LAS float*)(lds + NL_WSF) + wave * 128;
    const float* LUTg = (const float*)(ws + OFF_LUT) + (size_t)(hkv * 4) * 2048;
    __syncthreads();
    { const f32x4* ls4 = (const f32x4*)((const float*)(ws + OFF_LTS) + (size_t)(hkv * 4) * NS_N); const f32x4* lw4 = (const f32x4*)((const float*)(ws + OFF_LTW) + (size_t)(hkv * 4) * NW_N);
      for (int i = tid; i < NS_N; i += NTHREADS) ((LAS f32x4*)luts)[i] = ls4[i];
      for (int i = tid; i < NW_N; i += NTHREADS) ((LAS f32x4*)lutw)[i] = lw4[i]; }
    if (tid < 128) negt[tid] = -INFINITY;
    LAS float* b31t = (LAS float*)(lds + NL_B31);
    if (tid < 256) b31t[tid] = LUTg[(tid >> 6) * 2048 + 1535];
    const float* lutg = LUTg + g * 2048;
    const float b31 = lutg[1535];
    const size_t qoff = ((size_t)b * T_ + tq) * PN_LD;
    bf16x8 qr[4];
#pragma unroll
    for (int ds = 0; ds < 4; ++ds) qr[ds] = *(const bf16x8*)(PN + qoff + (hkv * 4 + g) * 64 + 16 * ds + 8 * hi);
#pragma unroll
    for (int j = 0; j < 3; ++j) { const int gc = (hkv * 4 + g) * 3 + j; const float gt = __builtin_amdgcn_rcpf(1.0f + __expf(-(bf2f(PN[qoff + 1280 + gc]) + gate_b[gc]))); if (hi == 0) wsf[32 + 32 * j + r32] = gt; }
#define NSA_GATE(j_) (wsf[32 + 32 * (j_) + r32])
    bf16_t* const dst0 = PN + ((size_t)b * T_ + 64 * qblk + 8 * wave) * PN_LD + hkv * 256 + r32;
#define NSA_DMA(kp, vp, pitch, tile, slot) do { nsa_dma((kp) + (size_t)(tile) * 64 * (pitch), (pitch), lds + (slot) * NT_SLOT, wave, lane); nsa_dma((vp) + (size_t)(tile) * 64 * (pitch), (pitch), lds + (slot) * NT_SLOT + 8192, wave, lane); } while (0)
#define NSA_SYNC() do { asm volatile("s_waitcnt vmcnt(0)" ::: "memory"); __syncthreads(); } while (0)
    f32x16 p0, p1, o[2];
    const int nct = (4 * qblk + 3 + 63) / 64;
    float mc = 0.f, lc = 0.f;
    for (int i = 0; i < nct; ++i) nsa_dma(KCg + (size_t)i * 64 * 64, 64, lds + i * 8192, wave, lane);
    NSA_SYNC();
    for (int i = 0; i < nct; ++i) {
        const bool farc = (64 * qblk + 8 * wave) - 1024 * i - 1039 >= 1535;
        nsa_qk_c(p0, p1, lds + i * 8192, qr, r32, hi, nsa_cfrag(farc ? b31 - mc : -mc, hi));
        if (!farc) nsa_bias_cmp(p0, p1, luts + g * NS_N, tq - 31 - 1024 * i - 64 * hi);
        const float ts = nsa_tile_exp_plain(p0, p1); lc += ts;
        const float ps = fmaxf(ts, __shfl_xor(ts, 32));
        if (__any(ps > 16384.0f)) { const float d = ps > 16384.0f ? __builtin_amdgcn_logf(ps) : 0.f; lc *= __builtin_amdgcn_exp2f(-d); mc += d; }
    }
    __syncthreads();
    lc += __shfl_xor(lc, 32);
    const float cnorm = lc > 0.f ? -mc - __builtin_amdgcn_logf(lc) : -INFINITY;
    o[0] = (f32x16){}; o[1] = (f32x16){};
    float carry = 0.f;
    NSA_DMA(KCg, VCg, 64, 0, 0);
    NSA_SYNC();
    for (int i = 0; i < nct; ++i) {
        if (i + 1 < nct) NSA_DMA(KCg, VCg, 64, i + 1, (i + 1) & 1);
        const bool farc = (64 * qblk + 8 * wave) - 1024 * i - 1039 >= 1535;
        nsa_qk_c(p0, p1, lds + (i & 1) * NT_SLOT, qr, r32, hi, nsa_cfrag(farc ? b31 + cnorm : cnorm, hi));
        if (!farc) nsa_bias_cmp(p0, p1, luts + g * NS_N, tq - 31 - 1024 * i - 64 * hi);
#pragma unroll
        for (int r = 0; r < 16; ++r) { p0[r] = __builtin_amdgcn_exp2f(p0[r]); p1[r] = __builtin_amdgcn_exp2f(p1[r]); }
        float gs[8], gl[8], rc[8];
#pragma unroll
        for (int k4 = 0; k4 < 4; ++k4) { gs[k4] = (p0[4 * k4] + p0[4 * k4 + 1]) + (p0[4 * k4 + 2] + p0[4 * k4 + 3]); gl[k4] = p0[4 * k4 + 3];
            gs[4 + k4] = (p1[4 * k4] + p1[4 * k4 + 1]) + (p1[4 * k4 + 2] + p1[4 * k4 + 3]); gl[4 + k4] = p1[4 * k4 + 3]; }
#pragma unroll
        for (int k = 0; k < 8; ++k) rc[k] = __shfl_xor(gl[k], 32);
#pragma unroll
        for (int k = 0; k < 8; ++k) { const float prev = hi ? rc[k] : (k == 0 ? carry : rc[k - 1]); float v = gs[k] + prev;
            v += __shfl_xor(v, 8); v += __shfl_xor(v, 16);
            if (g == 0) impl[(8 * wave + qi) * IMP_PITCH + 16 * i + 2 * k + hi] = v; }
        carry = rc[7];
        nsa_pv(o, p0, p1, lds + (i & 1) * NT_SLOT + 8192, lane);
        NSA_SYNC();
    }
    nsa_emit(dst0, o, NSA_GATE(0), false, dry, wsf, hi, r32);
    {
        const int q8 = lane >> 3, jg = lane & 7, qq = 8 * wave + q8, cur = qblk;
        unsigned bits = 0u;
        if (cur >= 16) {
            unsigned key[16];
#pragma unroll
            for (int jj = 0; jj < 16; ++jj) { const int j = 16 * jg + jj; const unsigned kb_ = __builtin_bit_cast(unsigned, impl[qq * IMP_PITCH + j]); key[jj] = (j >= 1 && j <= cur - 2) ? kb_ + 1u : 0u; }
            unsigned Tsel = 0u; bool done = false;
            int bb0 = 30; asm volatile("" : "+s"(bb0));
#pragma unroll 2
            for (int bb = bb0; bb >= 0; --bb) { const unsigned Tt = Tsel | (1u << bb); int c = 0;
#pragma unroll
                for (int jj = 0; jj < 16; ++jj) c += (key[jj] >= Tt) ? 1 : 0;
                c = sum8_dpp(c);
                Tsel = (!done && c >= 13) ? Tt : Tsel;
                done = done || c == 13;
                if (__all(done)) break; }
            int ngt = 0, neq = 0;
#pragma unroll
            for (int jj = 0; jj < 16; ++jj) { ngt += (key[jj] > Tsel) ? 1 : 0; neq += (key[jj] == Tsel) ? 1 : 0; }
            ngt = sum8_dpp(ngt);
            int pre = neq;
            { int t = __shfl_up(pre, 1, 8); if (jg >= 1) pre += t; t = __shfl_up(pre, 2, 8); if (jg >= 2) pre += t; t = __shfl_up(pre, 4, 8); if (jg >= 4) pre += t; }
            int run = pre - neq; const int need = 13 - ngt;
#pragma unroll
            for (int jj = 0; jj < 16; ++jj) { const int j = 16 * jg + jj; bool sel = key[jj] > Tsel;
                if (key[jj] == Tsel && Tsel != 0u) { sel = run < need; ++run; }
                sel = sel || j == 0 || j == cur || j == cur - 1; bits |= sel ? (1u << jj) : 0u; }
        } else {
#pragma unroll
            for (int jj = 0; jj < 16; ++jj) { const int j = 16 * jg + jj; bits |= (j <= cur) ? (1u << jj) : 0u; }
        }
        const unsigned other = (unsigned)__shfl_xor((int)bits, 1);
        if ((jg & 1) == 0) selm[qq * 4 + (jg >> 1)] = bits | (other << 16);
        asm volatile("s_waitcnt lgkmcnt(0)" ::: "memory");
    }
    const LAS unsigned* sm = selm + (8 * wave + qi) * 4;
#define NSA_SB() __builtin_amdgcn_sched_barrier(0)
#define NSA_PAIR(EXPA, EXPB) do { \
            { bf16x8 ka_[8]; nsa_kfrags(ka_, sl_, r32, hi); NSA_SB(); nsa_qk_frags(p0, p1, ka_, qr); } \
            NSA_SB(); \
            nsa_qk(q0, q1, sl_ + NT_SLOT, qr, r32, hi); \
            EXPA; \
            fa0 = p_frag(p0, 0); fa1 = p_frag(p0, 1); fa2 = p_frag(p1, 0); fa3 = p_frag(p1, 1); \
            NSA_SB(); \
            { bf16x8 va_[8]; nsa_vfrags(va_, sl_ + 8192, lane); NSA_SB(); nsa_pv_frags(o, fa0, fa1, fa2, fa3, va_); } \
            EXPB; \
            fa0 = p_frag(q0, 0); fa1 = p_frag(q0, 1); fa2 = p_frag(q1, 0); fa3 = p_frag(q1, 1); \
            NSA_SB(); \
            { bf16x8 vb_[8]; nsa_vfrags(vb_, sl_ + NT_SLOT + 8192, lane); NSA_SB(); nsa_pv_frags(o, fa0, fa1, fa2, fa3, vb_); } \
        } while (0)
#define NSA_PAIR_C(CFA, CFB, EXPA, EXPB) do { \
            { bf16x8 ka_[8]; nsa_kfrags(ka_, sl_, r32, hi); const s16x4 cfa_ = (CFA); NSA_SB(); nsa_qk_frags_c(p0, p1, ka_, qr, cfa_); } \
            NSA_SB(); \
            nsa_qk_c(q0, q1, sl_ + NT_SLOT, qr, r32, hi, (CFB)); \
            EXPA; \
            fa0 = p_frag(p0, 0); fa1 = p_frag(p0, 1); fa2 = p_frag(p1, 0); fa3 = p_frag(p1, 1); \
            NSA_SB(); \
            { bf16x8 va_[8]; nsa_vfrags(va_, sl_ + 8192, lane); NSA_SB(); nsa_pv_frags(o, fa0, fa1, fa2, fa3, va_); } \
            EXPB; \
            fa0 = p_frag(q0, 0); fa1 = p_frag(q0, 1); fa2 = p_frag(q1, 0); fa3 = p_frag(q1, 1); \
            NSA_SB(); \
            { bf16x8 vb_[8]; nsa_vfrags(vb_, sl_ + NT_SLOT + 8192, lane); NSA_SB(); nsa_pv_frags(o, fa0, fa1, fa2, fa3, vb_); } \
            tsa_ = sum16(p0) + sum16(p1); tsb_ = sum16(q0) + sum16(q1);     \
        } while (0)
#define NSA_ITER_HEAD(kp, vp, t0, nt) \
            const int jn_ = (j + 1 < np_) ? j + 1 : j, tb_ = (2 * jn_ + 1 < (nt)) ? 2 * jn_ + 1 : 2 * jn_; \
            NSA_DMA(kp, vp, PN_LD, (t0) + 2 * jn_, 2 * ((j + 1) & 1)); NSA_DMA(kp, vp, PN_LD, (t0) + tb_, 2 * ((j + 1) & 1) + 1);        \
            const LAS unsigned char* sl_ = lds + (j & 1) * 2 * NT_SLOT; \
            f32x16 q0, q1; float tsa_, tsb_; bf16x8 fa0, fa1, fa2, fa3;
#define NSA_ITER_TAIL(mref, psum, lvar) \
            { float ts_ = tsa_ + tsb_; lvar += ts_; psum = fmaxf(ts_, __shfl_xor(ts_, 32)); } \
            NSA_SYNC(); \
            nsa_resc(mref, psum, lvar, o, wsf, hi, r32);
#define NSA_LOOP2(kp, vp, t0, nt, TABF, NFAR, SELBIT, mref, psum, lvar) do { \
        const int np_ = ((nt) + 1) >> 1, nf_ = (NFAR) < np_ ? (NFAR) : np_; \
        __syncthreads();                                                \
        NSA_DMA(kp, vp, PN_LD, (t0), 0); NSA_DMA(kp, vp, PN_LD, (t0) + ((nt) > 1 ? 1 : 0), 1); \
        NSA_SYNC(); \
        int j = 0; \
        for (; j < nf_; ++j) { \
            NSA_ITER_HEAD(kp, vp, t0, nt) \
            float ca_, cb_; { const int i = 2 * j; ca_ = (SELBIT) ? b31 : -INFINITY; } { const int i = 2 * j + 1; cb_ = (SELBIT) ? b31 : -INFINITY; } \
            NSA_PAIR_C(nsa_cfrag(ca_ - mref, hi), nsa_cfrag(cb_ - mref, hi), nsa_tile_exp_only(p0, p1), nsa_tile_exp_only(q0, q1)); \
            NSA_ITER_TAIL(mref, psum, lvar) \
        } \
        for (; j < np_; ++j) { \
            NSA_ITER_HEAD(kp, vp, t0, nt) \
            const s16x4 cfm_ = nsa_cfrag(-mref, hi); \
            NSA_PAIR_C(cfm_, cfm_, { const int i = 2 * j; nsa_tile_exp_tab_only(p0, p1, TABF); }, { const int i = 2 * j + 1; nsa_tile_exp_tab_only(q0, q1, (i < (nt)) ? (TABF) : (const LAS float*)negt); }); \
            NSA_ITER_TAIL(mref, psum, lvar) \
        } } while (0)
    {
        const bf16_t* kp = PN + (size_t)b * T_ * PN_LD + 768 + hkv * 64; const bf16_t* vp = kp + 128;
        float ms = 0.f, mp = 0.f, ls = 0.f; o[0] = (f32x16){}; o[1] = (f32x16){};
        const int nt = qblk + 1;
        const LAS float* lutsg = luts + g * NS_N + (NS_N - 69 - (tq - 4 * hi)); const LAS float* b31g = b31t + g * 64;
        const int dmin0 = 64 * qblk + 8 * wave - 63;
        NSA_LOOP2(kp, vp, 0, nt, (((sm[(i >> 5) & 3] >> (i & 31)) & 1u) ? ((dmin0 - 64 * i >= 1535) ? b31g : lutsg + 64 * i) : (const LAS float*)negt), (dmin0 >= 1599 ? (dmin0 - 1599) / 128 + 1 : 0), ((sm[(i >> 5) & 3] >> (i & 31)) & 1u), ms, mp, ls);
        ls += __shfl_xor(ls, 32);
        nsa_emit(dst0, o, NSA_GATE(1) * __builtin_amdgcn_rcpf(ls), true, dry, wsf, hi, r32);
    }
    {
        const bf16_t* kp = PN + (size_t)b * T_ * PN_LD + 1024 + hkv * 64; const bf16_t* vp = kp + 128;
        float mw = 0.f, mp = 0.f, lw = 0.f; o[0] = (f32x16){}; o[1] = (f32x16){};
        const int first = qblk >= 8 ? qblk - 8 : 0, nt = qblk - first + 1;
        const LAS float* lutwg = lutw + g * NW_N + (NW_N - 69 - (tq - 64 * first - 4 * hi));
        NSA_LOOP2(kp, vp, first, nt, (lutwg + 64 * i), 0, true, mw, mp, lw);
        lw += __shfl_xor(lw, 32);
        nsa_emit(dst0, o, NSA_GATE(2) * __builtin_amdgcn_rcpf(lw), true, dry, wsf, hi, r32);
    }
#undef NSA_LOOP2
#undef NSA_ITER_HEAD
#undef NSA_ITER_TAIL
#undef NSA_PAIR
#undef NSA_PAIR_C
#undef NSA_SB
#undef NSA_DMA
#undef NSA_SYNC
#undef NSA_GATE
}

#define XB_TMO      128
#define XB_XCNT(j)  (256  + 64 * (j))
#define XB_XSUB(j)  (1280 + 64 * (j))
#define XB_XGEN(j)  (2304 + 64 * (j))
#define XB_TOP      3328
#define XB_TOPGEN   3392
#define XCD_BAR_WORDS 3456
#define XB_SPIN_CAP (1u << 18)
__device__ __forceinline__ unsigned xb_ld(unsigned* p)              { return __hip_atomic_load(p, __ATOMIC_RELAXED, __HIP_MEMORY_SCOPE_AGENT); }
__device__ __forceinline__ unsigned xb_add(unsigned* p, unsigned v) { return __hip_atomic_fetch_add(p, v, __ATOMIC_RELAXED, __HIP_MEMORY_SCOPE_AGENT); }
__device__ __forceinline__ unsigned xb_xcc_id() { return (unsigned)__builtin_amdgcn_s_getreg((3 << 11) | 20) & 0xFu; }
#define XB_SPIN(cond, bar) do { unsigned _sp = 0; while (cond) { __builtin_amdgcn_s_sleep(1); \
    if ((++_sp & 255u) == 0u) { if (xb_ld(&(bar)[XB_TMO])) break; if (_sp > XB_SPIN_CAP) { atomicAdd(&(bar)[XB_TMO], 1u); break; } } } } while (0)
struct XcdBarrier { unsigned* bar; unsigned x; volatile LAS unsigned* st; };
__device__ __forceinline__ void xcd_barrier_complete(unsigned* bar, unsigned x, unsigned& nloc, unsigned& nx) {
    const unsigned G = gridDim.x;
    unsigned sum, cnt, mine, sp = 0u;
    for (;;) {
        sum = 0u; cnt = 0u; mine = 0u;
#pragma unroll
        for (unsigned j = 0; j < 16; ++j) { const unsigned c = xb_ld(&bar[XB_XCNT(j)]); sum += c; cnt += (c > 0u) ? 1u : 0u; mine = (j == x) ? c : mine; }
        if (sum == G) break;
        __builtin_amdgcn_s_sleep(1);
        if ((++sp & 255u) == 0u) { if (xb_ld(&bar[XB_TMO])) break; if (sp > XB_SPIN_CAP) { atomicAdd(&bar[XB_TMO], 1u); break; } }
    }
    nloc = mine > 0u ? mine : 1u; nx = cnt > 0u ? cnt : 1u;
}
__device__ __forceinline__ void xcd_barrier(const XcdBarrier& b, bool leader_thread) {
    asm volatile("s_waitcnt vmcnt(0)" ::: "memory");
    __syncthreads();
    if (leader_thread) {
        unsigned* bar = b.bar;
        __builtin_amdgcn_s_waitcnt(0);
        unsigned nloc = b.st[0], nx = b.st[1];
        if (nloc == 0u) { xcd_barrier_complete(bar, b.x, nloc, nx); b.st[0] = nloc; b.st[1] = nx; }
        const unsigned old = xb_add(&bar[XB_XSUB(b.x)], 1u);
        const unsigned gen = old / nloc;
        if (old + 1u == (gen + 1u) * nloc) {
            __builtin_amdgcn_fence(__ATOMIC_RELEASE, "agent");
            asm volatile("s_waitcnt vmcnt(0)" ::: "memory");
            const unsigned og = xb_add(&bar[XB_TOP], 1u);
            const unsigned tg = og / nx;
            if (og + 1u == (tg + 1u) * nx) xb_add(&bar[XB_TOPGEN], 1u);
            else XB_SPIN(xb_ld(&bar[XB_TOPGEN]) == tg, bar);
            __builtin_amdgcn_fence(__ATOMIC_ACQUIRE, "agent");
            xb_add(&bar[XB_XGEN(b.x)], 1u);
            asm volatile("s_waitcnt vmcnt(0)" ::: "memory");
        } else {
            XB_SPIN(xb_ld(&bar[XB_XGEN(b.x)]) == gen, bar);
            __builtin_amdgcn_fence(__ATOMIC_ACQUIRE, "agent");
            asm volatile("s_waitcnt vmcnt(0)" ::: "memory");
        }
    }
    __syncthreads();
}
constexpr size_t OFF_BAR = 256 * 1024;
constexpr size_t OFF_CNT = 320 * 1024;
constexpr size_t OFF_PCNT = 384 * 1024;

__global__ void __launch_bounds__(NTHREADS, 2) hybrid_fwd(Args args) {
    extern __shared__ __attribute__((aligned(16))) unsigned char lds_raw[];
    Frame F;
    F.lds = (LAS unsigned char*)lds_raw;
    F.wave = __builtin_amdgcn_readfirstlane(threadIdx.x >> 6);
    F.G = gridDim.x; F.blk = blockIdx.x;
    XcdBarrier xbar; xbar.bar = (unsigned*)(args.ws + OFF_BAR); xbar.x = xb_xcc_id(); xbar.st = (volatile LAS unsigned*)(F.lds + LDS_CTRL + 1024);
    if (threadIdx.x < 2) xbar.st[threadIdx.x] = 0u;
    if (threadIdx.x == 0) (void)xb_add(&xbar.bar[XB_XCNT(xbar.x)], 1u);
    __syncthreads();
#define IN(k) (true)
#define SEAM(k) xcd_barrier(xbar, F.wave == 0 && lane_id() == 0)
#define WSP(type, off) ((type*)(args.ws + (off)))
#define PHASE_IDS() unsigned char* ws = args.ws; (void)ws; const int lane = lane_id(), tid = F.wave * 64 + lane, gw = F.blk * NWAVES + F.wave, NGW = F.G * NWAVES, gt = F.blk * NTHREADS + tid, NGT = F.G * NTHREADS; (void)gw; (void)NGW; (void)gt; (void)NGT; (void)tid; (void)lane
#define XIN (args.in[0])
#define SS1 WSP(float, OFF_SS1)
#define SS2 WSP(float, OFF_SS2)
#define SS3 WSP(float, OFF_SS3)
#define XN WSP(bf16_t, OFF_XN)
#define XB WSP(bf16_t, OFF_XN)
#define Win_t WSP(bf16_t, OFF_WIN)
#define Wkv_t ((bf16_t*)args.out + (size_t)10 * 1024 * 1024)
#define Wc1k_t WSP(bf16_t, OFF_WC1K)
#define Wc1v_t WSP(bf16_t, OFF_WC1V)
#define Wlora_t WSP(bf16_t, OFF_WLORA)
#define Wout_t ((bf16_t*)args.out)
#define Wq_t ((bf16_t*)args.out + (size_t)1024 * 1024)
#define Wo_t ((bf16_t*)args.out + (size_t)2 * 1024 * 1024)
#define Wgu_t ((bf16_t*)args.out + (size_t)3 * 1024 * 1024)
#define Wd_t WSP(bf16_t, OFF_WD)
#define Hb WSP(bf16_t, OFF_H)
#define MEMN WSP(bf16_t, OFF_MEMN)
#define KVX WSP(bf16_t, OFF_KVX)
#define PNSA WSP(bf16_t, OFF_PNSA)
#define PRW WSP(bf16_t, OFF_R1)
#define LUT WSP(float, OFF_LUT)
#define CBK WSP(float, OFF_CBK)
#define CBPART WSP(float, OFF_CBPART)
#define H1K WSP(bf16_t, OFF_H1K)
#define H1V WSP(bf16_t, OFF_H1V)
#define KC WSP(bf16_t, OFF_KC)

    if (IN(0)) { PHASE_IDS();
        {
          LAS float* scr = (LAS float*)(F.lds + F.wave * 16384);
          for (int it = gw; it < 3088; it += NGW) {
              if (it < 1552) p0_transpose_item(args.in[5], D_, IN_COLS, Win_t, D_, 1, 0, scr, it, lane);
              else if (it < 2576) p0_transpose_item(args.in[30], D_, 2 * D_, Wkv_t, D_, 0, 0, scr, it - 1552, lane);
              else if (it < 2832) p0_transpose_item(args.in[9], 2048, 256, Wc1k_t, 2048, 0, 0, scr, it - 2576, lane);
              else p0_transpose_item(args.in[12], 2048, 256, Wc1v_t, 2048, 0, 0, scr, it - 2832, lane); } }
        for (int i = gt; i < (NIN - IN_COLS) * (D_ / 8); i += NGT) *(u32x4*)(Win_t + (size_t)IN_COLS * D_ + (size_t)i * 8) = (u32x4){0u, 0u, 0u, 0u};
        for (int i = gt; i < 1536 * 32; i += NGT) { const int n = i >> 5, kc = (i & 31) * 8, reg = n >> 9, nn = n & 511; float f[8];
#pragma unroll
            for (int j = 0; j < 8; ++j) { const int k = kc + j; float v = 0.f;
                if (reg == 0 && k < 64) v = args.in[17][(size_t)k * 512 + nn];
                else if (reg == 1 && k >= 64 && k < 128) v = args.in[19][(size_t)(k - 64) * 512 + nn];
                else if (reg == 2 && k >= 128) v = args.in[20][(size_t)(k - 128) * 512 + nn];
                f[j] = v; }
            *(u32x4*)(Wlora_t + (size_t)n * 256 + kc) = pack8(f); }
        for (int m = gw; m < M_; m += 2 * NGW) {
            const int m2 = m + NGW; const bool two = m2 < M_;
            const f32x4* xa = (const f32x4*)(XIN + (size_t)m * D_) + lane; const f32x4* xb = (const f32x4*)(XIN + (size_t)(two ? m2 : m) * D_) + lane;
            f32x4 va[4], vb[4]; float sa = 0.f, sb = 0.f;
#pragma unroll
            for (int j = 0; j < 4; ++j) { va[j] = xa[64 * j]; vb[j] = xb[64 * j]; }
#pragma unroll
            for (int j = 0; j < 4; ++j) { sa += (va[j][0] * va[j][0] + va[j][1] * va[j][1]) + (va[j][2] * va[j][2] + va[j][3] * va[j][3]); sb += (vb[j][0] * vb[j][0] + vb[j][1] * vb[j][1]) + (vb[j][2] * vb[j][2] + vb[j][3] * vb[j][3]); }
#pragma unroll
            for (int o = 1; o < 64; o <<= 1) { sa += __shfl_xor(sa, o); sb += __shfl_xor(sb, o); }
            const float ra = __builtin_amdgcn_rsqf(sa * (1.0f / D_) + RMS_EPS), rb = __builtin_amdgcn_rsqf(sb * (1.0f / D_) + RMS_EPS);
#pragma unroll
            for (int j = 0; j < 4; ++j) { const f32x4 g4 = *((const f32x4*)args.in[4] + lane + 64 * j); const f32x4 ya = va[j] * ra * g4, yb = vb[j] * rb * g4;
                u32x2 w; w.x = pk2(ya[0], ya[1]); w.y = pk2(ya[2], ya[3]); *((u32x2*)(XN + (size_t)m * D_) + lane + 64 * j) = w;
                if (two) { w.x = pk2(yb[0], yb[1]); w.y = pk2(yb[2], yb[3]); *((u32x2*)(XN + (size_t)m2 * D_) + lane + 64 * j) = w; } }
        }
        for (int m = gw; m < 512; m += NGW) rms_row_to_bf16(args.in[1] + (size_t)m * D_, args.in[28], MEMN + (size_t)m * D_, lane);
        for (int i = gt; i < 8 * 2048; i += NGT) { const int h = i >> 11, d = i & 2047; int bk;
            if (d < 16) bk = d; else { bk = 16; const int thr[15] = {22, 30, 40, 54, 73, 99, 134, 182, 246, 332, 450, 609, 825, 1117, 1513};
#pragma unroll
                for (int j = 0; j < 15; ++j) bk += (d >= thr[j]) ? 1 : 0; }
            LUT[i] = args.in[2][bk * 8 + h] * LOG2E; }
        for (int i = gt; i < 8 * (NS_N + NW_N); i += NGT) { const bool isw = i >= 8 * NS_N; const int ii = isw ? i - 8 * NS_N : i, n = isw ? NW_N : NS_N, h = ii / n, dist = (n - 1 - (ii % n)) - 68;
            const int d = dist < 0 ? 0 : (dist < 1535 ? dist : 1535); int bk;
            if (d < 16) bk = d; else { bk = 16; const int thr[15] = {22, 30, 40, 54, 73, 99, 134, 182, 246, 332, 450, 609, 825, 1117, 1513};
#pragma unroll
                for (int j = 0; j < 15; ++j) bk += (d >= thr[j]) ? 1 : 0; }
            const bool valid = isw ? (dist >= 0 && dist < 512) : (dist >= 0);
            (isw ? WSP(float, OFF_LTW) : WSP(float, OFF_LTS))[ii] = valid ? args.in[2][bk * 8 + h] * LOG2E : -INFINITY; }
        for (int i = gt; i < 32 * 512; i += NGT) { const int lc = i >> 9, j = i & 511; const float* pe = (j < 256 ? args.in[7] : args.in[8]) + lc * 64; const float* w1 = (j < 256 ? args.in[9] : args.in[12]) + (size_t)lc * 64 * 256 + (j & 255);
            float s = 0.f;
#pragma unroll 8
            for (int d = 0; d < 64; ++d) s += pe[d] * w1[(size_t)d * 256];
            CBPART[i] = s; }
    }
    SEAM(0);
    if (IN(1)) { PHASE_IDS();
        if (F.blk == 100) { const int j = tid; float s = (j < 256 ? args.in[10] : args.in[13])[j & 255];
            for (int lc = 0; lc < 32; ++lc) s += CBPART[lc * 512 + j];
            CBK[j < 256 ? j : 512 + (j - 256)] = s; }
        { pg8::Gemm g{XN, Win_t, M_, NIN - 256, D_, D_, 128, 0}; pg8::StaticOrder S; S.init(M_, NIN - 256, F.G, F.blk);
          pg8::EpiStore E{PRW, PR_LD, 7, PNSA, PN_LD, 7, 9, QK_C};
          pg8::gemm_phase(F.lds, g, S, E, F.wave); }
    }
    SEAM(1);
    if (IN(2)) { PHASE_IDS();
        bf16_t* R = (bf16_t*)(ws + OFF_R); bf16_t* V = (bf16_t*)(ws + OFF_V); bf16_t* KK = (bf16_t*)(ws + OFF_KK); bf16_t* KP = (bf16_t*)(ws + OFF_KP);
        bf16_t* LA = (bf16_t*)(ws + OFF_LORA_A);
        const float* mu = args.in[15]; const float* k_k = args.in[21];
        for (int m = (F.blk >= 16 ? (F.blk - 16) * NWAVES + F.wave : M_); m < M_; m += (F.G - 16) * NWAVES) {
            const bf16_t* pr = PRW + (size_t)m * PR_LD; const bool hp = (m % T_) != 0;
#pragma unroll
            for (int q = 0; q < 3; ++q) { const int col = q * 512 + 8 * lane;
                const u32x4 cw = *(const u32x4*)(pr + col); u32x4 pw = (u32x4){0u, 0u, 0u, 0u}; if (hp) pw = *(const u32x4*)(pr - PR_LD + col);
                float cf[8], pf[8], val[8]; unpack8(cw, cf); unpack8(pw, pf);
                const f32x4 m0 = *(const f32x4*)(mu + col), m1 = *(const f32x4*)(mu + col + 4);
#pragma unroll
                for (int i = 0; i < 8; ++i) val[i] = cf[i] + (pf[i] - cf[i]) * (i < 4 ? m0[i & 3] : m1[i & 3]);
                const size_t o = (size_t)m * 512 + 8 * lane;
                if (q == 0) *(u32x4*)(R + o) = pack8(val);
                else if (q == 2) *(u32x4*)(V + o) = pack8(val);
                else { *(u32x4*)(KP + o) = pack8(val);
                    const f32x4 k0 = *(const f32x4*)(k_k + 8 * lane), k1 = *(const f32x4*)(k_k + 8 * lane + 4); float kr[8], ss = 0.f;
#pragma unroll
                    for (int i = 0; i < 8; ++i) { kr[i] = val[i] * (i < 4 ? k0[i & 3] : k1[i & 3]); ss += kr[i] * kr[i]; }
                    ss += __shfl_xor(ss, 1); ss += __shfl_xor(ss, 2); ss += __shfl_xor(ss, 4);
                    const float inv = __builtin_amdgcn_rsqf(fmaxf(ss, 1e-24f));
#pragma unroll
                    for (int i = 0; i < 8; ++i) kr[i] *= inv;
                    *(u32x4*)(KK + o) = pack8(kr); }
            }
            { const int col = 1536 + 4 * lane; const u32x2 cw = *(const u32x2*)(pr + col); u32x2 pw = (u32x2){0u, 0u}; if (hp) pw = *(const u32x2*)(pr - PR_LD + col);
              const f32x4 mm = *(const f32x4*)(mu + col); float o4[4];
#pragma unroll
              for (int i = 0; i < 4; ++i) { const unsigned cu = i < 2 ? cw.x : cw.y, pu = i < 2 ? pw.x : pw.y;
                  const float cf = __builtin_bit_cast(float, (i & 1) ? (cu & 0xffff0000u) : (cu << 16)), pf = __builtin_bit_cast(float, (i & 1) ? (pu & 0xffff0000u) : (pu << 16));
                  const float v = cf + (pf - cf) * mm[i];
                  o4[i] = lane < 16 ? (1.0f - 2.0f * __builtin_amdgcn_rcpf(1.0f + __expf(2.0f * v))) : (lane < 32 ? v : __builtin_amdgcn_rcpf(1.0f + __expf(-v))); }
              u32x2 w; w.x = pk2(o4[0], o4[1]); w.y = pk2(o4[2], o4[3]); *(u32x2*)(LA + (size_t)m * 256 + 4 * lane) = w; }
        }
        { pg8::Gemm g{PNSA + 512, Wc1k_t, 2048, 256, 2048, 16 * PN_LD, PN_LD * 2, 1}; pg8::ListOrder S; S.init(2048, 256, 0, F.blk);
          pg8::EpiGelu E{H1K, CBK};
          pg8::gemm_phase(F.lds, g, S, E, F.wave); }
        { pg8::Gemm g{PNSA + 640, Wc1v_t, 2048, 256, 2048, 16 * PN_LD, PN_LD * 2, 1}; pg8::ListOrder S; S.init(2048, 256, 8, F.blk);
          pg8::EpiGelu E{H1V, CBK + 512};
          pg8::gemm_phase(F.lds, g, S, E, F.wave); }
    }
    SEAM(2);
    if (IN(3)) { PHASE_IDS();
        { pg8::Gemm g{(const bf16_t*)(ws + OFF_LORA_A), Wlora_t, M_, 1536, 256, 256, 128, 0}; pg8::StaticOrder S; S.init(M_, 1536, F.G, F.blk);
          pg8::EpiLora E{(float*)(ws + OFF_W), (bf16_t*)(ws + OFF_KP), (const bf16_t*)(ws + OFF_KK), (bf16_t*)(ws + OFF_B), (bf16_t*)(ws + OFF_G), args.in[16], args.in[18], args.in[22]};
          pg8::gemm_phase(F.lds, g, S, E, F.wave);
          }
        { pg8::Gemm g{XN, Win_t + (size_t)(NIN - 256) * D_, M_, 256, D_, D_, 128, 0}; pg8::ListOrder S; S.init(M_, 256, 128, F.blk);
          pg8::EpiStore E{PNSA + 1280, PN_LD, 1000, nullptr, 0, 0, 0, 1.0f};
          pg8::gemm_phase(F.lds, g, S, E, F.wave); }
        {
          LAS float* scr = (LAS float*)(F.lds + F.wave * 16384);
          const int q3 = F.G >> 2, grp3 = F.blk < 2 * q3 ? 0 : (F.blk < 3 * q3 ? 1 : 2);
          const int it0 = grp3 == 0 ? gw : (grp3 == 2 ? 2880 + (F.blk - 3 * q3) * NWAVES + F.wave : 5760), itn = grp3 == 0 ? 2880 : 5760, its = grp3 == 0 ? 2 * q3 * NWAVES : q3 * NWAVES;
          for (int it = it0; it < itn; it += its) {
              if (it < 512) p0_transpose_item(args.in[26], D_, D_, Wout_t, D_, 0, 0, scr, it, lane);
              else if (it < 1024) p0_transpose_item(args.in[29], D_, D_, Wq_t, D_, 0, 0, scr, it - 512, lane);
              else if (it < 1536) p0_transpose_item(args.in[31], D_, D_, Wo_t, D_, 0, 0, scr, it - 1024, lane);
              else if (it < 2944) p0_transpose_item(args.in[33], D_, DFF, Wgu_t, D_, 2, 0, scr, it - 1536, lane);
              else if (it < 4352) p0_transpose_item(args.in[34], D_, DFF, Wgu_t, D_, 3, 0, scr, it - 2944, lane);
              else p0_transpose_item(args.in[35], DFF, D_, Wd_t, DFF, 0, 0, scr, it - 4352, lane); } }
        for (int r = gw; r < 4096; r += NGW) { const int kv = r >> 11, row = r & 2047; const bf16_t* h1 = (kv ? H1V : H1K) + (size_t)row * 256; const float* w2 = args.in[kv ? 14 : 11] + lane;
            float s0 = 0.f, s1 = 0.f;
#pragma unroll 8
            for (int j = 0; j < 256; j += 2) { const unsigned hw = *(const unsigned*)(h1 + j); s0 += __builtin_bit_cast(float, hw << 16) * w2[(size_t)j * 64]; s1 += __builtin_bit_cast(float, hw & 0xffff0000u) * w2[(size_t)(j + 1) * 64]; }
            float s = s0 + s1; if ((row & 511) == 511) s = 0.f;
            (KC + (size_t)kv * 131072)[(size_t)row * 64 + lane] = (bf16_t)f2bf(s); }
    }
    SEAM(3);
    if (IN(4)) { PHASE_IDS();
        rwkv_chunk(F, ws);
    }
    SEAM(4);
    if (IN(5)) { PHASE_IDS();
        if (F.blk < 16) rwkv_combine(F, ws, F.blk);
        { pg8::Gemm g{MEMN, Wkv_t, 512, 2 * D_, D_, D_, 128, 0}; pg8::ListOrder S; S.init(512, 2 * D_, 16, F.blk);
          pg8::EpiStore E{KVX, 2 * D_, 1000, nullptr, 0, 0, 0, 1.0f};
          pg8::gemm_phase(F.lds, g, S, E, F.wave); }
        volatile LAS unsigned* uw = (volatile LAS unsigned*)(F.lds + LDS_CTRL + 1024 + 64);
        for (;;) {
            __syncthreads();
            if (tid == 0) uw[0] = xb_add(WSP(unsigned, OFF_CNT), 1u);
            __syncthreads();
            const unsigned u = uw[0];
            if (u >= 512u) break;
            nsa_unit(F, ws, args.in[6], (int)(u & 1u), (int)((u >> 1) & 1u), 127 - (int)(u >> 2));
        }
    }
    SEAM(5);
    if (IN(6)) { PHASE_IDS();
        for (int task = gw; task < 16 * NC * 4; task += NGW) rwkv_fixup_task(ws, args.in[24], args.in[25], args.in[23], task >> 2, task & 3, lane);
    }
    SEAM(6);
    if (IN(7)) { PHASE_IDS();
        pg8::Gemm g{PNSA, Wout_t, M_, D_, D_, PN_LD, 128, 0}; pg8::StaticOrder S; S.init(M_, D_, F.G, F.blk);
        pg8::EpiResidual<false> E{XIN, nullptr, nullptr, XB, args.in[27], SS1};
        pg8::gemm_phase(F.lds, g, S, E, F.wave);
    }
    SEAM(7);
    if (IN(8)) { PHASE_IDS();
        pg8::Gemm g{XB, Wq_t, M_, D_, D_, D_, 128, 0}; pg8::StaticOrder S; S.init(M_, D_, F.G, F.blk);
        pg8::EpiRowScale E{WSP(bf16_t, OFF_Q2), SS1, 0.0625f * LOG2E};
        pg8::gemm_phase(F.lds, g, S, E, F.wave);
        asm volatile("s_waitcnt vmcnt(0)" ::: "memory");
        __syncthreads();
        asm volatile("buffer_inv sc0\n\ts_waitcnt vmcnt(0)" ::: "memory");
    }
    if (IN(9)) { PHASE_IDS();
        const int c = F.blk, pm = 8 * (c & 7) + ((c >> 3) & 7), pn = c >> 6;
        xattn_unit(F, WSP(bf16_t, OFF_Q2), KVX, WSP(bf16_t, OFF_XO), pm >> 5, pn, pm & 31);
    }
    SEAM(9);
    if (IN(10)) { PHASE_IDS();
        pg8::Gemm g{WSP(bf16_t, OFF_XO), Wo_t, M_, D_, D_, D_, 128, 0}; pg8::StaticOrder S; S.init(M_, D_, F.G, F.blk);
        pg8::EpiResidual<true> E{nullptr, XB, args.in[27], XB, args.in[32], SS2};
        pg8::gemm_phase(F.lds, g, S, E, F.wave);
    }
    SEAM(10);
    if (IN(11)) { PHASE_IDS();
        pg8::Gemm g{XB, Wgu_t, M_, 2 * DFF, D_, D_, 128, 0}; pg8::StaticOrder S; S.init(M_, 2 * DFF, F.G, F.blk);
        pg8::EpiSwiglu E{Hb, SS2};
        pg8::gemm_phase(F.lds, g, S, E, F.wave);
    }
    SEAM(11);
    if (IN(12)) { PHASE_IDS();
        pg8::Gemm g{Hb, Wd_t, M_, D_, DFF, DFF, 128, 0}; pg8::StaticOrder S; S.init(M_, D_, F.G, F.blk);
        pg8::EpiFinalNorm E{XB, args.in[32], args.out, args.in[3], SS3, WSP(unsigned, OFF_PCNT)};
        pg8::gemm_phase(F.lds, g, S, E, F.wave);
    }
#undef IN
#undef SEAM
}

extern "C" void kernel_launch(void* const* d_in, const int* in_sizes, int n_in, void* d_out, int out_size, void* d_ws, size_t ws_size, hipStream_t stream) {
    static int grid = 0;
    if (grid == 0) {
        int dev = 0, cus = 0, per_cu = 0;
        (void)hipGetDevice(&dev);
        (void)hipDeviceGetAttribute(&cus, hipDeviceAttributeMultiprocessorCount, dev);
        (void)hipFuncSetAttribute((const void*)hybrid_fwd, hipFuncAttributeMaxDynamicSharedMemorySize, LDS_BYTES);
        (void)hipOccupancyMaxActiveBlocksPerMultiprocessor(&per_cu, (const void*)hybrid_fwd, NTHREADS, LDS_BYTES);
        if (per_cu < 1) { fprintf(stderr, "kernel_launch: occupancy query reports %d blocks per CU\n", per_cu); per_cu = 1; }
        (void)hipGetLastError();
        grid = cus;
        if (n_in != 36 || ws_size < 256 * MiB) fprintf(stderr, "kernel_launch: unexpected n_in %d / ws %zu\n", n_in, ws_size);
    }
    Args a{};
    for (int i = 0; i < 36; ++i) a.in[i] = (const float*)d_in[i];
    a.out = (float*)d_out; a.ws = (unsigned char*)d_ws; a.ph_lo = 0; a.ph_hi = N_PHASES;
    (void)hipMemsetAsync((char*)d_ws + OFF_BAR, 0, 256 * 1024, stream);
    void* kargs[] = {&a};
    hipError_t e = hipLaunchCooperativeKernel((const void*)hybrid_fwd, dim3(grid), dim3(NTHREADS), kargs, LDS_BYTES, stream);
    if (e != hipSuccess) fprintf(stderr, "cooperative launch failed: %s (grid %d)\n", hipGetErrorString(e), grid);
}
```

```cpp
#include <hip/hip_runtime.h>
#include <hip/hip_cooperative_groups.h>
#include <cstdio>
#include <cstdint>
namespace cg = cooperative_groups;

#define LAS __attribute__((address_space(3)))
#define GAS __attribute__((address_space(1)))
typedef unsigned short bf16_t;
typedef short bf16x8 __attribute__((ext_vector_type(8)));
typedef float f32x4 __attribute__((ext_vector_type(4)));
typedef float f32x2 __attribute__((ext_vector_type(2)));
typedef float f32x16 __attribute__((ext_vector_type(16)));
typedef unsigned u32x4 __attribute__((ext_vector_type(4)));
typedef unsigned u32x2 __attribute__((ext_vector_type(2)));

constexpr int NB = 2, T_ = 8192, M_ = NB * T_, D_ = 1024;
constexpr int NSA_COLS = 1304, RW_COLS = 1792, IN_COLS = 3096;
constexpr int PN_LD = 1536, PR_LD = 1792, NIN = 3328;
constexpr int DFF = 2816;
constexpr float RMS_EPS = 1e-6f;
constexpr float LOG2E = 1.4426950408889634f;
constexpr float QK_C = 0.125f * LOG2E;

constexpr size_t MiB = 1u << 20;
constexpr size_t OFF_LUT = 0;
constexpr size_t OFF_LTS = 512 * 1024, OFF_LTW = 640 * 1024;
constexpr size_t OFF_CBK = 64 * 1024, OFF_CBV = 66 * 1024;
constexpr size_t OFF_CBPART = 128 * 1024;
constexpr size_t OFF_SS1 = 1 * MiB, OFF_SS2 = 2 * MiB, OFF_SS3 = 3 * MiB;
constexpr size_t OFF_MEMN = 4 * MiB;
constexpr size_t OFF_KVX = 5 * MiB;
constexpr size_t OFF_KC = 7 * MiB, OFF_VC = 7 * MiB + 256 * 1024;
constexpr size_t OFF_H1K = 8 * MiB, OFF_H1V = 9 * MiB;
constexpr size_t OFF_WIN = 10 * MiB;
constexpr size_t OFF_WKV = 16 * MiB + 512 * 1024;
constexpr size_t OFF_WC1K = 20 * MiB + 512 * 1024, OFF_WC1V = 21 * MiB + 512 * 1024;
constexpr size_t OFF_WLORA = 22 * MiB + 512 * 1024;
constexpr size_t OFF_SUM = 8 * MiB;
constexpr size_t OFF_XN = 40 * MiB;
constexpr size_t OFF_PNSA = 72 * MiB;
constexpr size_t OFF_R1 = 120 * MiB;
constexpr size_t OFF_RW = 176 * MiB;
constexpr size_t OFF_WD = 168 * MiB;
constexpr size_t OFF_Q2 = 72 * MiB;
constexpr size_t OFF_XO = 176 * MiB;
constexpr size_t OFF_H = 72 * MiB;

__device__ __forceinline__ unsigned f2bf(float f) { unsigned u = __builtin_bit_cast(unsigned, f); return (u + 0x7fffu + ((u >> 16) & 1u)) >> 16; }
__device__ __forceinline__ unsigned pk2(float lo, float hi) { return f2bf(lo) | (f2bf(hi) << 16); }
__device__ __forceinline__ float bf2f(unsigned short b) { return __builtin_bit_cast(float, (unsigned)b << 16); }
__device__ __forceinline__ int lane_id() { int l; asm volatile("v_mbcnt_lo_u32_b32 %0, -1, 0\n\tv_mbcnt_hi_u32_b32 %0, -1, %0" : "=v"(l)); return l; }
__device__ __forceinline__ float wave_sum(float v) {
#pragma unroll
    for (int o = 1; o < 64; o <<= 1) v += __shfl_xor(v, o);
    return v;
}

typedef short s16x4 __attribute__((ext_vector_type(4)));
__device__ __forceinline__ int crow(int r, int hi) { return (r & 3) + 8 * (r >> 2) + 4 * hi; }
__device__ __forceinline__ s16x4 vtr(const LAS unsigned char* p) { return __builtin_bit_cast(s16x4, __builtin_amdgcn_ds_read_tr16_b64_v4i16((LAS s16x4*)p)); }

namespace pg8 {
constexpr int BM = 256, BK = 64, HALF = 128, HTB = HALF * BK * 2, STAGE_BYTES = 8 * HTB, NXCD = 8, WGM = 8;
__host__ __device__ __forceinline__ int lds_byte(int r, int c) { const int st = (r >> 4) * 2 + (c >> 5), rr = r & 15, cc = c & 31, ob = rr * 64 + cc * 2; return st * 1024 + (ob ^ (((ob >> 9) & 1) << 5)); }
__host__ __device__ __forceinline__ void stage_rc(int b, int& R, int& C) { const int st = b / 1024, sb = b % 1024, swz = sb ^ (((sb >> 9) & 1) << 5); R = (st >> 1) * 16 + swz / 64; C = (st & 1) * 32 + (swz % 64) / 2; }
__host__ __device__ __forceinline__ int perm32(int rho) { const int n = rho >> 4, i = rho & 15; return 8 * (i >> 2) + 4 * n + (i & 3); }

struct Unit { int pm, pn; };
struct Gemm { const bf16_t* A; const bf16_t* Bt; int M, N, K; int lda; int kstepA; int amode; };
__device__ __forceinline__ const char* a_tile(const Gemm& g, int pm) {
    if (g.amode == 0) return (const char*)g.A + (size_t)pm * BM * g.lda * 2;
    const int bh = pm >> 1, c0 = (pm & 1) * 256;
    return (const char*)g.A + ((size_t)((bh >> 1) * T_ + 16 * c0) * PN_LD + (bh & 1) * 64) * 2;
}

struct StaticOrder {
    int nM, nN, nwg, G, c;
    __device__ void init(int M, int N, int G_, int c_) { nM = M / BM; nN = N / BM; nwg = nM * nN; G = G_; c = c_; }
    __device__ bool next(int i, Unit& u) const {
        const long L = (long)i * G + c; if (L >= nwg || c < 0) return false;
        int wgid = (int)L; { const int q = nwg / NXCD, r = nwg % NXCD, xcd = wgid % NXCD, off = wgid / NXCD; wgid = (xcd < r ? xcd * (q + 1) : r * (q + 1) + (xcd - r) * q) + off; }
        const int nig = WGM * nN, gid = wgid / nig, fm = gid * WGM, gsz = (nM - fm) < WGM ? (nM - fm) : WGM;
        u.pm = fm + ((wgid % nig) % gsz); u.pn = (wgid % nig) / gsz; return true;
    }
};
struct ListOrder {
    int nN, n, j;
    __device__ void init(int M, int N, int first, int blk) { nN = N / BM; n = (M / BM) * nN; j = blk - first; }
    __device__ bool next(int i, Unit& u) const { if (i != 0 || j < 0 || j >= n) return false; u.pm = j / nN; u.pn = j % nN; return true; }
};

__device__ __forceinline__ unsigned cvt_pk_bf16(float lo, float hi) { unsigned r; asm volatile("v_cvt_pk_bf16_f32 %0, %1, %2" : "=v"(r) : "v"(lo), "v"(hi)); return r; }

template <class Epi, class Sched>
__device__ __forceinline__ void gemm_phase(LAS unsigned char* lds, const Gemm g, const Sched& S, const Epi& E, int wave_id) {
    const int wid = wave_id, lane = lane_id(), tid = wid * 64 + lane, wr = wid >> 2, wc = wid & 3, fr = lane & 15, fq = lane >> 4;
    const int K = g.K, nt = K / BK;
    unsigned voffA[2], voffB[2];
#pragma unroll
    for (int i = 0; i < 2; ++i) { int R, C; stage_rc(tid * 16 + i * 8192, R, C); const int Rb = (R & ~31) + perm32(R & 31);
        voffA[i] = (unsigned)(R * g.lda + C) * 2u; voffB[i] = (unsigned)(Rb * K + C) * 2u; }
    const size_t kstepA = (size_t)g.kstepA, kstepB = (size_t)(BK * 2);
    const size_t hstepA = (size_t)HALF * g.lda * 2, hstepB = (size_t)HALF * K * 2;
    const unsigned ldsw = (unsigned)wid * 1024u;
    const int aoff = lds_byte(wr * 64 + fr, fq * 8), boff = lds_byte(wc * 32 + fr, fq * 8);
#define PG8_SA(b, h) (((b) * 2 + (h)) * HTB)
#define PG8_SB(b, h) ((4 + (b) * 2 + (h)) * HTB)
#define PG8_STAGE(bufoff, gbase, voff) do { _Pragma("unroll") for (int _i = 0; _i < 2; ++_i) \
        __builtin_amdgcn_global_load_lds((const unsigned*)((const char*)(gbase) + (voff)[_i]), (LAS unsigned*)(lds + (bufoff) + ldsw + _i * 8192), 16, 0, 0); } while (0)
#define PG8_LDA(dst, b, h) do { _Pragma("unroll") for (int m = 0; m < 4; ++m) _Pragma("unroll") for (int k = 0; k < 2; ++k) dst[m][k] = *(const LAS bf16x8*)(lds + PG8_SA(b, h) + aoff + m * 2048 + k * 1024); } while (0)
#define PG8_LDB(dst, b, h) do { _Pragma("unroll") for (int n = 0; n < 2; ++n) _Pragma("unroll") for (int k = 0; k < 2; ++k) dst[n][k] = *(const LAS bf16x8*)(lds + PG8_SB(b, h) + boff + n * 2048 + k * 1024); } while (0)
#define PG8_MMA(ai, bj, At, Bt) do { __builtin_amdgcn_s_setprio(1); _Pragma("unroll") for (int m = 0; m < 4; ++m) _Pragma("unroll") for (int n = 0; n < 2; ++n) _Pragma("unroll") for (int k = 0; k < 2; ++k) \
        acc[ai][bj][m][n] = __builtin_amdgcn_mfma_f32_16x16x32_bf16(Bt[n][k], At[m][k], acc[ai][bj][m][n], 0, 0, 0); __builtin_amdgcn_s_setprio(0); } while (0)
#define PG8_WAIT_V(n) asm volatile("s_waitcnt vmcnt(" #n ")" ::: "memory")
#define PG8_WAIT_L(n) asm volatile("s_waitcnt lgkmcnt(" #n ")" ::: "memory")
#define PG8_BAR __builtin_amdgcn_s_barrier()
#define PG8_SCHED __builtin_amdgcn_sched_barrier(0)
    Unit cur, nxt; int ui = 0;
    if (!S.next(0, cur)) return;
    f32x4 acc[2][2][4][2];
#pragma unroll
    for (int a = 0; a < 2; ++a)
#pragma unroll
        for (int b = 0; b < 2; ++b)
#pragma unroll
            for (int m = 0; m < 4; ++m)
#pragma unroll
                for (int n = 0; n < 2; ++n) acc[a][b][m][n] = (f32x4){0.f, 0.f, 0.f, 0.f};
    bf16x8 At[4][2], B0[2][2], B1[2][2];
    const char* cA = a_tile(g, cur.pm); const char* cB = (const char*)g.Bt + (size_t)cur.pn * 2 * hstepB;
    PG8_STAGE(PG8_SB(0, 0), cB, voffB); PG8_STAGE(PG8_SB(0, 1), cB + hstepB, voffB); PG8_STAGE(PG8_SA(0, 0), cA, voffA); PG8_STAGE(PG8_SA(0, 1), cA + hstepA, voffA);
    if (wr == 1) PG8_BAR;
    PG8_WAIT_V(2); PG8_BAR;
    PG8_STAGE(PG8_SB(1, 0), cB + kstepB, voffB); PG8_STAGE(PG8_SA(1, 0), cA + kstepA, voffA); PG8_STAGE(PG8_SB(1, 1), cB + hstepB + kstepB, voffB);
    PG8_WAIT_V(6); PG8_BAR;
    for (;;) {
        const bool has_next = S.next(ui + 1, nxt);
        const char* nA = has_next ? a_tile(g, nxt.pm) : cA; const char* nB = has_next ? (const char*)g.Bt + (size_t)nxt.pn * 2 * hstepB : cB;
        for (int t = 0; t < nt; t += 2) {
            const bool last = (t == nt - 2);
            const char* a1 = cA + (size_t)(t + 1) * kstepA;
            const char* a2 = last ? nA : cA + (size_t)(t + 2) * kstepA; const char* b2 = last ? nB : cB + (size_t)(t + 2) * kstepB;
            const char* a3 = a2 + kstepA; const char* b3 = b2 + kstepB;
            PG8_LDB(B0, 0, 0); PG8_LDB(B1, 0, 1); PG8_SCHED; PG8_LDA(At, 0, 0); PG8_STAGE(PG8_SA(1, 1), a1 + hstepA, voffA);
            PG8_WAIT_V(8); PG8_WAIT_L(0); PG8_BAR; PG8_MMA(0, 0, At, B0); PG8_MMA(0, 1, At, B1); PG8_BAR; PG8_SCHED;
            PG8_LDA(At, 0, 1); PG8_STAGE(PG8_SB(0, 0), b2, voffB); PG8_STAGE(PG8_SB(0, 1), b2 + hstepB, voffB); PG8_STAGE(PG8_SA(0, 0), a2, voffA);
            PG8_WAIT_V(8); PG8_WAIT_L(0); PG8_BAR; PG8_MMA(1, 0, At, B0); PG8_MMA(1, 1, At, B1); PG8_BAR; PG8_SCHED;
            PG8_LDB(B0, 1, 0); PG8_LDB(B1, 1, 1); PG8_SCHED; PG8_LDA(At, 1, 0); PG8_STAGE(PG8_SA(0, 1), a2 + hstepA, voffA);
            PG8_WAIT_V(8); PG8_WAIT_L(0); PG8_BAR; PG8_MMA(0, 0, At, B0); PG8_MMA(0, 1, At, B1); PG8_BAR; PG8_SCHED;
            PG8_LDA(At, 1, 1); PG8_STAGE(PG8_SB(1, 0), b3, voffB); PG8_STAGE(PG8_SB(1, 1), b3 + hstepB, voffB); PG8_STAGE(PG8_SA(1, 0), a3, voffA);
            PG8_WAIT_V(8); PG8_WAIT_L(0); PG8_BAR; PG8_MMA(1, 0, At, B0); PG8_MMA(1, 1, At, B1); PG8_BAR; PG8_SCHED;
        }
        if (wr == 0) PG8_BAR;
        if constexpr (!Epi::AFTER_DRAIN) E(acc, cur, wr, wc, fr, fq);
        if (!has_next) break;
#pragma unroll
        for (int a = 0; a < 2; ++a)
#pragma unroll
            for (int b = 0; b < 2; ++b)
#pragma unroll
                for (int m = 0; m < 4; ++m)
#pragma unroll
                    for (int n = 0; n < 2; ++n) acc[a][b][m][n] = (f32x4){0.f, 0.f, 0.f, 0.f};
        cur = nxt; cA = nA; cB = nB; ++ui;
        if (wr == 1) PG8_BAR;
    }
    PG8_WAIT_V(0);
    PG8_BAR;
    if constexpr (Epi::AFTER_DRAIN) E.fused(acc, cur, wr, wc, fr, fq, lds, wid, lane);
#undef PG8_SA
#undef PG8_SB
#undef PG8_STAGE
#undef PG8_LDA
#undef PG8_LDB
#undef PG8_MMA
#undef PG8_WAIT_V
#undef PG8_WAIT_L
#undef PG8_BAR
#undef PG8_SCHED
}

typedef f32x4 Acc[2][2][4][2];
__device__ __forceinline__ float row_rs(const float* SS, int row) {
    const f32x4* p = (const f32x4*)(SS + (size_t)row * 16);
    const f32x4 a = p[0], b = p[1], c = p[2], d = p[3];
    const float s = ((a[0] + a[1]) + (a[2] + a[3])) + ((b[0] + b[1]) + (b[2] + b[3])) + ((c[0] + c[1]) + (c[2] + c[3])) + ((d[0] + d[1]) + (d[2] + d[3]));
    return __builtin_amdgcn_rsqf(s * (1.0f / D_) + RMS_EPS);
}
struct EpiStore {
    static constexpr bool AFTER_DRAIN = false;
    bf16_t* O0; int ld0; int npn0; bf16_t* O1; int ld1; int sc_lo, sc_hi; float scale;
    __device__ __forceinline__ void operator()(const Acc& acc, const Unit& u, int wr, int wc, int fr, int fq) const {
        bf16_t* base; int ld, colt;
        if (u.pn < npn0) { base = O0; ld = ld0; colt = u.pn * BM; } else { base = O1; ld = ld1; colt = (u.pn - npn0) * BM; }
        const int row0 = u.pm * BM + wr * 64 + fr, col0 = colt + wc * 32 + 8 * fq; const float sc = (u.pn >= sc_lo && u.pn < sc_hi) ? scale : 1.0f;
#pragma unroll
        for (int ai = 0; ai < 2; ++ai)
#pragma unroll
            for (int m = 0; m < 4; ++m) { bf16_t* rowp = base + (size_t)(row0 + ai * HALF + m * 16) * ld + col0;
#pragma unroll
                for (int bj = 0; bj < 2; ++bj) { const f32x4 v0 = acc[ai][bj][m][0] * sc, v1 = acc[ai][bj][m][1] * sc;
                    u32x4 w; w.x = cvt_pk_bf16(v0[0], v0[1]); w.y = cvt_pk_bf16(v0[2], v0[3]); w.z = cvt_pk_bf16(v1[0], v1[1]); w.w = cvt_pk_bf16(v1[2], v1[3]);
                    *(u32x4*)(rowp + bj * HALF) = w; } }
    }
};
__device__ __forceinline__ void load_base8(const float* basef, const bf16_t* baseb, const f32x4& gi0, const f32x4& gi1, bool base_xb, size_t off, f32x4& b0, f32x4& b1) {
    if (!base_xb) { b0 = *(const f32x4*)(basef + off); b1 = *(const f32x4*)(basef + off + 4); }
    else { const u32x4 w = *(const u32x4*)(baseb + off);
        b0 = (f32x4){__builtin_bit_cast(float, w.x << 16), __builtin_bit_cast(float, w.x & 0xffff0000u), __builtin_bit_cast(float, w.y << 16), __builtin_bit_cast(float, w.y & 0xffff0000u)} * gi0;
        b1 = (f32x4){__builtin_bit_cast(float, w.z << 16), __builtin_bit_cast(float, w.z & 0xffff0000u), __builtin_bit_cast(float, w.w << 16), __builtin_bit_cast(float, w.w & 0xffff0000u)} * gi1; }
}
__device__ __forceinline__ f32x4 rcp4(const f32x4 v) { return (f32x4){__builtin_amdgcn_rcpf(v[0]), __builtin_amdgcn_rcpf(v[1]), __builtin_amdgcn_rcpf(v[2]), __builtin_amdgcn_rcpf(v[3])}; }
template <bool BASE_XB> struct EpiResidual {
    static constexpr bool AFTER_DRAIN = false;
    const float* basef; const bf16_t* baseb; const float* gin; bf16_t* XB; const float* gout; float* SS;
    __device__ __forceinline__ void operator()(const Acc& acc, const Unit& u, int wr, int wc, int fr, int fq) const {
        const int row0 = u.pm * BM + wr * 64 + fr, col0 = u.pn * BM + wc * 32 + 8 * fq;
        f32x4 gv[2][2], gi[2][2];
#pragma unroll
        for (int bj = 0; bj < 2; ++bj)
#pragma unroll
            for (int n = 0; n < 2; ++n) { gv[bj][n] = *(const f32x4*)(gout + col0 + bj * HALF + 4 * n); gi[bj][n] = BASE_XB ? rcp4(*(const f32x4*)(gin + col0 + bj * HALF + 4 * n)) : gv[bj][n]; }
#pragma unroll
        for (int ai = 0; ai < 2; ++ai)
#pragma unroll
            for (int m = 0; m < 4; ++m) { const int row = row0 + ai * HALF + m * 16; const size_t off = (size_t)row * D_ + col0; float ss = 0.f;
#pragma unroll
                for (int bj = 0; bj < 2; ++bj) {
                    f32x4 b0, b1; load_base8(basef, baseb, gi[bj][0], gi[bj][1], BASE_XB, off + bj * HALF, b0, b1);
                    const f32x4 x0 = b0 + acc[ai][bj][m][0], x1 = b1 + acc[ai][bj][m][1];
                    ss += (x0[0] * x0[0] + x0[1] * x0[1]) + (x0[2] * x0[2] + x0[3] * x0[3]) + (x1[0] * x1[0] + x1[1] * x1[1]) + (x1[2] * x1[2] + x1[3] * x1[3]);
                    const f32x4 y0 = x0 * gv[bj][0], y1 = x1 * gv[bj][1];
                    u32x4 w; w.x = cvt_pk_bf16(y0[0], y0[1]); w.y = cvt_pk_bf16(y0[2], y0[3]); w.z = cvt_pk_bf16(y1[0], y1[1]); w.w = cvt_pk_bf16(y1[2], y1[3]);
                    *(u32x4*)(XB + off + bj * HALF) = w;
                }
                ss += __shfl_xor(ss, 16); ss += __shfl_xor(ss, 32);
                if (fq == 0) SS[(size_t)row * 16 + u.pn * 4 + wc] = ss;
            }
    }
};
struct EpiSwiglu {
    static constexpr bool AFTER_DRAIN = false;
    bf16_t* H; const float* SS;
    __device__ __forceinline__ void operator()(const Acc& acc, const Unit& u, int wr, int wc, int fr, int fq) const {
        const int row0 = u.pm * BM + wr * 64 + fr, col0 = u.pn * HALF + wc * 32 + 8 * fq;
#pragma unroll
        for (int ai = 0; ai < 2; ++ai)
#pragma unroll
            for (int m = 0; m < 4; ++m) { const int row = row0 + ai * HALF + m * 16; const float rs = row_rs(SS, row);
                float h[8];
#pragma unroll
                for (int n = 0; n < 2; ++n)
#pragma unroll
                    for (int j = 0; j < 4; ++j) { const float gt = acc[ai][0][m][n][j] * rs, up = acc[ai][1][m][n][j] * rs;
                        h[4 * n + j] = gt * __builtin_amdgcn_rcpf(1.0f + __builtin_amdgcn_exp2f(-gt * LOG2E)) * up; }
                u32x4 w; w.x = cvt_pk_bf16(h[0], h[1]); w.y = cvt_pk_bf16(h[2], h[3]); w.z = cvt_pk_bf16(h[4], h[5]); w.w = cvt_pk_bf16(h[6], h[7]);
                *(u32x4*)(H + (size_t)row * DFF + col0) = w; }
    }
};

struct EpiLora {
    static constexpr bool AFTER_DRAIN = false;
    float* W; bf16_t* Kp; const bf16_t* KK; bf16_t* Bv; bf16_t* G; const float* w0; const float* a0; const float* k_a;
    __device__ __forceinline__ void operator()(const Acc& acc, const Unit& u, int wr, int wc, int fr, int fq) const {
        const int region = u.pn >> 1, row0 = u.pm * BM + wr * 64 + fr, c0 = (u.pn & 1) * 256 + wc * 32 + 8 * fq;
#pragma unroll
        for (int ai = 0; ai < 2; ++ai)
#pragma unroll
            for (int m = 0; m < 4; ++m) { const int row = row0 + ai * HALF + m * 16;
#pragma unroll
                for (int bj = 0; bj < 2; ++bj) { const int c = c0 + bj * HALF; const size_t off = (size_t)row * 512 + c;
                    float v[8];
#pragma unroll
                    for (int i = 0; i < 8; ++i) v[i] = acc[ai][bj][m][i >> 2][i & 3];
                    if (region == 0) {
                        float o[8];
#pragma unroll
                        for (int i = 0; i < 8; ++i) { const float z = v[i] + w0[c + i]; const float sg = __builtin_amdgcn_rcpf(1.0f + __expf(-z)); o[i] = -0.6065306597126334f * sg; }
                        *(f32x4*)(W + off) = (f32x4){o[0], o[1], o[2], o[3]}; *(f32x4*)(W + off + 4) = (f32x4){o[4], o[5], o[6], o[7]};
                    } else if (region == 1) {
                        const u32x4 k8 = *(const u32x4*)(Kp + off), q8 = *(const u32x4*)(KK + off);
                        float kn[8], bn[8];
#pragma unroll
                        for (int i = 0; i < 8; ++i) { const float a = __builtin_amdgcn_rcpf(1.0f + __expf(-(v[i] + a0[c + i])));
                            const unsigned kw = k8[i >> 1], qw = q8[i >> 1];
                            const float kf = __builtin_bit_cast(float, (i & 1) ? (kw & 0xffff0000u) : (kw << 16)), qf = __builtin_bit_cast(float, (i & 1) ? (qw & 0xffff0000u) : (qw << 16));
                            kn[i] = kf * (1.0f + (a - 1.0f) * k_a[c + i]); bn[i] = qf * a; }
                        u32x4 w; w.x = cvt_pk_bf16(kn[0], kn[1]); w.y = cvt_pk_bf16(kn[2], kn[3]); w.z = cvt_pk_bf16(kn[4], kn[5]); w.w = cvt_pk_bf16(kn[6], kn[7]);
                        *(u32x4*)(Kp + off) = w;
                        w.x = cvt_pk_bf16(bn[0], bn[1]); w.y = cvt_pk_bf16(bn[2], bn[3]); w.z = cvt_pk_bf16(bn[4], bn[5]); w.w = cvt_pk_bf16(bn[6], bn[7]);
                        *(u32x4*)(Bv + off) = w;
                    } else {
                        u32x4 w; w.x = cvt_pk_bf16(v[0], v[1]); w.y = cvt_pk_bf16(v[2], v[3]); w.z = cvt_pk_bf16(v[4], v[5]); w.w = cvt_pk_bf16(v[6], v[7]);
                        *(u32x4*)(G + off) = w;
                    }
                } }
    }
};
struct EpiGelu {
    static constexpr bool AFTER_DRAIN = false;
    bf16_t* O; const float* cb;
    __device__ __forceinline__ void operator()(const Acc& acc, const Unit& u, int wr, int wc, int fr, int fq) const {
        const int row0 = u.pm * BM + wr * 64 + fr, col0 = u.pn * BM + wc * 32 + 8 * fq;
#pragma unroll
        for (int ai = 0; ai < 2; ++ai)
#pragma unroll
            for (int m = 0; m < 4; ++m) { const int row = row0 + ai * HALF + m * 16;
#pragma unroll
                for (int bj = 0; bj < 2; ++bj) { const int c = col0 + bj * HALF; float o[8];
#pragma unroll
                    for (int i = 0; i < 8; ++i) { const float z = acc[ai][bj][m][i >> 2][i & 3] + cb[c + i];
                        const float t = 0.7978845608028654f * (z + 0.044715f * z * z * z);
                        const float th = 1.0f - 2.0f * __builtin_amdgcn_rcpf(1.0f + __expf(2.0f * t));
                        o[i] = 0.5f * z * (1.0f + th); }
                    u32x4 w; w.x = cvt_pk_bf16(o[0], o[1]); w.y = cvt_pk_bf16(o[2], o[3]); w.z = cvt_pk_bf16(o[4], o[5]); w.w = cvt_pk_bf16(o[6], o[7]);
                    *(u32x4*)(O + (size_t)row * 256 + c) = w; } }
    }
};

struct EpiRowScale {
    static constexpr bool AFTER_DRAIN = false;
    bf16_t* O; const float* SS; float qscale;
    __device__ __forceinline__ void operator()(const Acc& acc, const Unit& u, int wr, int wc, int fr, int fq) const {
        const int row0 = u.pm * BM + wr * 64 + fr, col0 = u.pn * BM + wc * 32 + 8 * fq;
#pragma unroll
        for (int ai = 0; ai < 2; ++ai)
#pragma unroll
            for (int m = 0; m < 4; ++m) { const int row = row0 + ai * HALF + m * 16; const float rs = row_rs(SS, row) * qscale;
#pragma unroll
                for (int bj = 0; bj < 2; ++bj) { const f32x4 v0 = acc[ai][bj][m][0] * rs, v1 = acc[ai][bj][m][1] * rs;
                    u32x4 w; w.x = cvt_pk_bf16(v0[0], v0[1]); w.y = cvt_pk_bf16(v0[2], v0[3]); w.z = cvt_pk_bf16(v1[0], v1[1]); w.w = cvt_pk_bf16(v1[2], v1[3]);
                    *(u32x4*)(O + (size_t)row * D_ + col0 + bj * HALF) = w; } }
    }
};
struct EpiFinalNorm {
    static constexpr bool AFTER_DRAIN = true;
    const bf16_t* baseb; const float* gin; float* out; const float* gain; float* xs; unsigned* cnt;
    __device__ __forceinline__ void fused(Acc& acc, const Unit& u, int wr, int wc, int fr, int fq, LAS unsigned char* lds, int wid, int lane) const {
        LAS float* P = (LAS float*)lds;
        LAS float* S = (LAS float*)(lds + 4096);
        const int row0 = u.pm * BM + wr * 64 + fr, col0 = u.pn * BM + wc * 32 + 8 * fq;
#pragma unroll
        for (int ai = 0; ai < 2; ++ai)
#pragma unroll
            for (int m = 0; m < 4; ++m) { const size_t off = (size_t)(row0 + ai * HALF + m * 16) * D_ + col0; float ss = 0.f;
#pragma unroll
                for (int bj = 0; bj < 2; ++bj) { f32x4 b0, b1; load_base8(nullptr, baseb, rcp4(*(const f32x4*)(gin + col0 + bj * HALF)), rcp4(*(const f32x4*)(gin + col0 + bj * HALF + 4)), true, off + bj * HALF, b0, b1);
                    const f32x4 x0 = b0 + acc[ai][bj][m][0], x1 = b1 + acc[ai][bj][m][1];
                    acc[ai][bj][m][0] = x0; acc[ai][bj][m][1] = x1;
                    ss += (x0[0] * x0[0] + x0[1] * x0[1]) + (x0[2] * x0[2] + x0[3] * x0[3]) + (x1[0] * x1[0] + x1[1] * x1[1]) + (x1[2] * x1[2] + x1[3] * x1[3]); }
                ss += __shfl_xor(ss, 16); ss += __shfl_xor(ss, 32);
                if (fq == 0) P[(ai * HALF + wr * 64 + m * 16 + fr) * 4 + wc] = ss; }
        asm volatile("s_waitcnt lgkmcnt(0)" ::: "memory"); __builtin_amdgcn_s_barrier(); asm volatile("" ::: "memory");
        const int row = wid * 32 + (lane & 31);
        if (lane < 32) { const f32x4 pp = *(const LAS f32x4*)(P + row * 4);
            __hip_atomic_store(xs + (size_t)(u.pm * BM + row) * 4 + u.pn, (pp[0] + pp[1]) + (pp[2] + pp[3]), __ATOMIC_RELAXED, __HIP_MEMORY_SCOPE_AGENT); }
        asm volatile("s_waitcnt vmcnt(0)" ::: "memory");
        if (lane == 0) __hip_atomic_fetch_add(cnt + 64 * u.pm, 1u, __ATOMIC_RELAXED, __HIP_MEMORY_SCOPE_AGENT);
        if (wid == 0) { unsigned sp = 0;
            while ((unsigned)__builtin_amdgcn_readfirstlane(__hip_atomic_load(cnt + 64 * u.pm, __ATOMIC_RELAXED, __HIP_MEMORY_SCOPE_AGENT)) < 32u) { __builtin_amdgcn_s_sleep(2); if (++sp > (1u << 22)) break; }
            __builtin_amdgcn_fence(__ATOMIC_ACQUIRE, "agent"); }
        asm volatile("s_waitcnt vmcnt(0) lgkmcnt(0)" ::: "memory"); __builtin_amdgcn_s_barrier(); asm volatile("" ::: "memory");
        if (lane < 32) { const float* sl = xs + (size_t)(u.pm * BM + row) * 4; float t = 0.f;
#pragma unroll
            for (int k = 0; k < 4; ++k) t += __hip_atomic_load(sl + k, __ATOMIC_RELAXED, __HIP_MEMORY_SCOPE_AGENT);
            S[row] = __builtin_amdgcn_rsqf(t * (1.0f / D_) + RMS_EPS); }
        asm volatile("s_waitcnt lgkmcnt(0)" ::: "memory"); __builtin_amdgcn_s_barrier(); asm volatile("" ::: "memory");
        f32x4 gv[2][2];
#pragma unroll
        for (int bj = 0; bj < 2; ++bj)
#pragma unroll
            for (int n = 0; n < 2; ++n) gv[bj][n] = *(const f32x4*)(gain + col0 + bj * HALF + 4 * n);
#pragma unroll
        for (int ai = 0; ai < 2; ++ai)
#pragma unroll
            for (int m = 0; m < 4; ++m) { const int r = ai * HALF + wr * 64 + m * 16 + fr; const float rs = S[r]; const size_t off = (size_t)(u.pm * BM + r) * D_ + col0;
#pragma unroll
                for (int bj = 0; bj < 2; ++bj) { *(f32x4*)(out + off + bj * HALF) = acc[ai][bj][m][0] * rs * gv[bj][0]; *(f32x4*)(out + off + bj * HALF + 4) = acc[ai][bj][m][1] * rs * gv[bj][1]; } }
    }
};
}

constexpr int NWAVES = 8, NTHREADS = NWAVES * 64;
constexpr int RING_BYTES = 131072, LDS_CTRL = 147456, LDS_BYTES = 151552;
constexpr int N_PHASES = 14;
constexpr int CL = 128, NC = T_ / CL;
constexpr int TS = 8;
constexpr float LNX_EPS = 64e-5f;
constexpr size_t OFF_W = 120 * MiB, OFF_G = 152 * MiB;
constexpr size_t OFF_R = 176 * MiB, OFF_V = 192 * MiB, OFF_KK = 208 * MiB, OFF_KP = 224 * MiB, OFF_B = 240 * MiB;
constexpr size_t OFF_LORA_A = 24 * MiB, OFF_Y = 40 * MiB, OFF_PT = 56 * MiB;

struct Args { const float* in[36]; float* out; unsigned char* ws; int ph_lo, ph_hi; };

struct Frame {
    LAS unsigned char* lds;
    int wave, G, blk;
};

__device__ __forceinline__ int dst_row(int mode, int row_off, int n) {
    if (mode == 0) return row_off + n;
    if (mode == 1) return n < NSA_COLS ? RW_COLS + n : n - NSA_COLS;
    if (mode == 2) return 256 * (n >> 7) + (n & 127);
    return 256 * (n >> 7) + 128 + (n & 127);
}
__device__ __forceinline__ void p0_transpose_item(const float* W, int K, int N, bf16_t* WT, int ldt, int mode, int row_off, LAS float* scr, int item, int lane) {
    const int nblk = (N + 31) / 32, kb = item / nblk, nb = item % nblk, k0 = 64 * kb, n0 = 32 * nb;
    const int nq = n0 + 4 * (lane & 7); f32x4 ld[8];
#pragma unroll
    for (int i = 0; i < 8; ++i) ld[i] = nq < N ? *(const f32x4*)(W + (size_t)(k0 + 8 * i + (lane >> 3)) * N + nq) : (f32x4){0.f, 0.f, 0.f, 0.f};
#pragma unroll
    for (int i = 0; i < 8; ++i) { LAS float* d = scr + (8 * i + (lane >> 3)) * 33 + 4 * (lane & 7); d[0] = ld[i][0]; d[1] = ld[i][1]; d[2] = ld[i][2]; d[3] = ld[i][3]; }
    asm volatile("s_waitcnt lgkmcnt(0)" ::: "memory");
    const int c = lane & 7;
#pragma unroll
    for (int j = 0; j < 4; ++j) { const int n = (lane >> 3) + 8 * j; const LAS float* s = scr + (8 * c) * 33 + n;
        u32x4 o; o.x = pk2(s[0 * 33], s[1 * 33]); o.y = pk2(s[2 * 33], s[3 * 33]); o.z = pk2(s[4 * 33], s[5 * 33]); o.w = pk2(s[6 * 33], s[7 * 33]);
        if (n0 + n < N) *(u32x4*)(WT + (size_t)dst_row(mode, row_off, n0 + n) * ldt + k0 + 8 * c) = o; }
    asm volatile("s_waitcnt lgkmcnt(0)" ::: "memory");
}
__device__ __forceinline__ void rms_row_to_bf16(const float* xrow, const float* gain, bf16_t* orow, int lane) {
    const f32x4* xr = (const f32x4*)xrow + lane; f32x4 v[4]; float s = 0.f;
#pragma unroll
    for (int j = 0; j < 4; ++j) { v[j] = xr[64 * j]; s += (v[j][0] * v[j][0] + v[j][1] * v[j][1]) + (v[j][2] * v[j][2] + v[j][3] * v[j][3]); }
    const float rs = __builtin_amdgcn_rsqf(wave_sum(s) * (1.0f / D_) + RMS_EPS);
#pragma unroll
    for (int j = 0; j < 4; ++j) { const f32x4 g4 = *((const f32x4*)gain + lane + 64 * j); const f32x4 y = v[j] * rs * g4;
        u32x2 w; w.x = pk2(y[0], y[1]); w.y = pk2(y[2], y[3]); *((u32x2*)orow + lane + 64 * j) = w; }
}
__device__ __forceinline__ void unpack8(const u32x4 w, float* f) {
#pragma unroll
    for (int i = 0; i < 4; ++i) { f[2 * i] = __builtin_bit_cast(float, w[i] << 16); f[2 * i + 1] = __builtin_bit_cast(float, w[i] & 0xffff0000u); }
}
__device__ __forceinline__ u32x4 pack8(const float* f) { u32x4 w; w.x = pk2(f[0], f[1]); w.y = pk2(f[2], f[3]); w.z = pk2(f[4], f[5]); w.w = pk2(f[6], f[7]); return w; }

constexpr int RC_PITCH = 144, RC_SLOT = 9216, RC_GROUP = 8 * RC_SLOT;
__device__ __forceinline__ bf16x8 frag_nat(const LAS unsigned char* m, int kb, int col0, int lane) {
    const LAS unsigned char* p = m + (kb + 8 * (lane >> 5) + ((lane & 15) >> 2)) * RC_PITCH + (col0 + 16 * ((lane >> 4) & 1) + 4 * (lane & 3)) * 2;
    const s16x4 lo = vtr(p), hh = vtr(p + 4 * RC_PITCH);
    return (bf16x8){lo[0], lo[1], lo[2], lo[3], hh[0], hh[1], hh[2], hh[3]};
}
__device__ __forceinline__ bf16x8 frag_dir(const LAS unsigned char* m, int row0, int kb, int lane) {
    return *(const LAS bf16x8*)(m + (row0 + (lane & 31)) * RC_PITCH + (kb + 8 * (lane >> 5)) * 2);
}
template <bool TA, bool TB>
__device__ __forceinline__ f32x16 rc_mm(const LAS unsigned char* A, const LAS unsigned char* B, int i0, int j0, f32x16 acc, int lane) {
#pragma unroll
    for (int ks = 0; ks < 4; ++ks) { const bf16x8 a = TA ? frag_nat(A, 16 * ks, i0, lane) : frag_dir(A, i0, 16 * ks, lane), b = TB ? frag_nat(B, 16 * ks, j0, lane) : frag_dir(B, j0, 16 * ks, lane);
        acc = __builtin_amdgcn_mfma_f32_32x32x16_bf16(a, b, acc, 0, 0, 0); }
    return acc;
}
template <bool TA, bool TB>
__device__ __forceinline__ f32x16 rc_mm_k(const LAS unsigned char* A, const LAS unsigned char* B, int i0, int j0, int ks0, f32x16 acc, int lane) {
#pragma unroll
    for (int kk = 0; kk < 2; ++kk) { const int ks = ks0 + kk; const bf16x8 a = TA ? frag_nat(A, 16 * ks, i0, lane) : frag_dir(A, i0, 16 * ks, lane), b = TB ? frag_nat(B, 16 * ks, j0, lane) : frag_dir(B, j0, 16 * ks, lane);
        acc = __builtin_amdgcn_mfma_f32_32x32x16_bf16(a, b, acc, 0, 0, 0); }
    return acc;
}
__device__ __forceinline__ void rc_store(LAS unsigned char* m, int i0, int j0, const f32x16& acc, int lane) {
    const int r32 = lane & 31, hi = lane >> 5;
#pragma unroll
    for (int r = 0; r < 16; ++r) *(LAS bf16_t*)(m + (i0 + crow(r, hi)) * RC_PITCH + (j0 + r32) * 2) = (bf16_t)f2bf(acc[r]);
}
#define RC_BAR() asm volatile("s_waitcnt lgkmcnt(0)\n\ts_barrier" ::: "memory")

__device__ __forceinline__ void rwkv_chunk(Frame& F, unsigned char* ws) {
    const float* LW = (const float*)(ws + OFF_W);
    const bf16_t* R = (const bf16_t*)(ws + OFF_R); const bf16_t* V = (const bf16_t*)(ws + OFF_V); const bf16_t* KK = (const bf16_t*)(ws + OFF_KK);
    const bf16_t* KP = (const bf16_t*)(ws + OFF_KP); const bf16_t* Bv = (const bf16_t*)(ws + OFF_B);
    bf16_t* Y = (bf16_t*)(ws + OFF_Y); bf16_t* PT = (bf16_t*)(ws + OFF_PT); float* SUM = (float*)(ws + OFF_SUM);
    const int lane0 = lane_id(), wave = F.wave;
    const int grp = wave >> 2, tw = wave & 3, i0 = (tw >> 1) * 32, j0 = (tw & 1) * 32;
    int wv_ = wave; asm volatile("" : "+v"(wv_));
    LAS unsigned char* gb = F.lds + (wv_ >> 2) * RC_GROUP;
#define SLOT(i) (gb + (i) * RC_SLOT)
    LAS float* gCl = (LAS float*)(F.lds + LDS_CTRL) + grp * 64;
    LAS float* clf = (LAS float*)SLOT(4);
    for (int hq = 0; hq < 4; ++hq) {
        int lane = lane0; asm volatile("" : "+v"(lane));
        const int r32 = lane & 31, hi = lane >> 5, gtid = tw * 64 + lane;
        const int hc = 4 * F.blk + hq, bh = hc / NC, c = hc % NC, h = bh & 7;
        const size_t m0 = (size_t)(bh >> 3) * T_ + (size_t)c * CL + 64 * grp;
        RC_BAR();
#pragma unroll
        for (int i = 0; i < 4; ++i) { const int t = (gtid >> 4) + 16 * i, c4 = (gtid & 15) * 4; *(LAS f32x4*)(clf + t * 64 + c4) = *(const f32x4*)(LW + (m0 + t) * 512 + h * 64 + c4); }
        RC_BAR();
        if (tw == 0) { float carry = 0.f;
#pragma unroll 1
            for (int hb = 0; hb < 64; hb += 32) { float cv[32];
#pragma unroll
                for (int t = 0; t < 32; ++t) cv[t] = clf[(hb + t) * 64 + lane];
                cv[0] += carry;
#pragma unroll
                for (int t = 1; t < 32; ++t) cv[t] += cv[t - 1];
#pragma unroll
                for (int t = 0; t < 32; ++t) clf[(hb + t) * 64 + lane] = cv[t];
                carry = cv[31]; }
            int z_ = 0; asm volatile("" : "+v"(z_));
            ((LAS float*)(F.lds + LDS_CTRL + z_) + grp * 64)[lane] = __expf(carry); }
        RC_BAR();
        { const int t = gtid >> 2, c0 = (gtid & 3) * 16; const size_t go = (m0 + t) * 512 + h * 64 + c0;
#pragma unroll
          for (int hf = 0; hf < 2; ++hf) { const int cc = c0 + 8 * hf;
              float fk[8], fb[8], fp[8], fr[8]; unpack8(*(const u32x4*)(KK + go + 8 * hf), fk); unpack8(*(const u32x4*)(Bv + go + 8 * hf), fb); unpack8(*(const u32x4*)(KP + go + 8 * hf), fp); unpack8(*(const u32x4*)(R + go + 8 * hf), fr);
              float oa[8], ob[8], ok[8], orr[8];
#pragma unroll
              for (int e = 0; e < 8; ++e) { const float cl = clf[t * 64 + cc + e], clm = t ? clf[(t - 1) * 64 + cc + e] : 0.f;
                  const float ep = __expf(cl), en = __builtin_amdgcn_rcpf(ep);
                  oa[e] = -fk[e] * __expf(clm); ob[e] = fb[e] * en; ok[e] = fp[e] * en; orr[e] = fr[e] * ep; }
              *(LAS u32x4*)(SLOT(0) + t * RC_PITCH + cc * 2) = pack8(oa); *(LAS u32x4*)(SLOT(1) + t * RC_PITCH + cc * 2) = pack8(ob);
              *(LAS u32x4*)(SLOT(2) + t * RC_PITCH + cc * 2) = pack8(ok); *(LAS u32x4*)(SLOT(3) + t * RC_PITCH + cc * 2) = pack8(orr); } }
        RC_BAR();
        f32x16 Tacc;
        { f32x16 lab = rc_mm<false, false>(SLOT(1), SLOT(0), i0, j0, (f32x16){}, lane), lka = rc_mm<false, false>(SLOT(2), SLOT(0), i0, j0, (f32x16){}, lane);
#pragma unroll
          for (int r = 0; r < 16; ++r) { const int sI = i0 + crow(r, hi), tJ = j0 + r32; const bool keep = sI < tJ; lab[r] = keep ? lab[r] : 0.f; lka[r] = keep ? lka[r] : 0.f; Tacc[r] = lab[r] + (sI == tJ ? 1.f : 0.f); }
          rc_store(SLOT(4), i0, j0, lab, lane); rc_store(SLOT(5), i0, j0, lka, lane); rc_store(SLOT(6), i0, j0, Tacc, lane); }
        RC_BAR();
#define RC_DIAG(D) do { _Pragma("unroll 1") for (int itn = 0; itn < 4; ++itn) { \
                LAS unsigned char* Pc = (itn & 1) ? SLOT(7) : SLOT(4); LAS unsigned char* Pn = (itn & 1) ? SLOT(4) : SLOT(7); \
                { const f32x16 pn = rc_mm_k<false, true>(Pc, Pc, (D), (D), (D) / 16, (f32x16){}, lane); rc_store(Pn, (D), (D), pn, lane); } \
                Tacc = rc_mm_k<false, true>(SLOT(6), Pn, (D), (D), (D) / 16, Tacc, lane); \
                rc_store(SLOT(6), (D), (D), Tacc, lane); } } while (0)
        if (tw == 0) RC_DIAG(0); else if (tw == 3) RC_DIAG(32);
#undef RC_DIAG
        RC_BAR();
        if (tw == 1) {
            { const f32x16 xq = rc_mm_k<false, true>(SLOT(4), SLOT(6), 0, 32, 2, (f32x16){}, lane); rc_store(SLOT(7), 0, 32, xq, lane); }
            { const f32x16 t01 = rc_mm_k<false, true>(SLOT(6), SLOT(7), 0, 32, 0, (f32x16){}, lane); rc_store(SLOT(6), 0, 32, t01, lane); }
        }
        RC_BAR();
        { const int t = gtid >> 2, c0 = (gtid & 3) * 16; const size_t go = (m0 + t) * 512 + h * 64 + c0;
          *(LAS u32x4*)(SLOT(7) + t * RC_PITCH + c0 * 2) = *(const u32x4*)(V + go); *(LAS u32x4*)(SLOT(7) + t * RC_PITCH + c0 * 2 + 16) = *(const u32x4*)(V + go + 8); }
        RC_BAR();
        { const f32x16 z = rc_mm<true, true>(SLOT(5), SLOT(7), i0, j0, (f32x16){}, lane); rc_store(SLOT(4), i0, j0, z, lane); }
        RC_BAR();
        { const f32x16 a2 = rc_mm<true, true>(SLOT(6), SLOT(0), i0, j0, (f32x16){}, lane); rc_store(SLOT(5), i0, j0, a2, lane); }
        RC_BAR();
        { const f32x16 w1 = rc_mm<true, true>(SLOT(6), SLOT(4), i0, j0, (f32x16){}, lane); rc_store(SLOT(0), i0, j0, w1, lane); }
        RC_BAR();
        { f32x16 mb = rc_mm<false, false>(SLOT(1), SLOT(3), i0, j0, (f32x16){}, lane), mk = rc_mm<false, false>(SLOT(2), SLOT(3), i0, j0, (f32x16){}, lane);
#pragma unroll
          for (int r = 0; r < 16; ++r) { const bool keep = (i0 + crow(r, hi)) <= (j0 + r32); mb[r] = keep ? mb[r] : 0.f; mk[r] = keep ? mk[r] : 0.f; }
          rc_store(SLOT(4), i0, j0, mb, lane); rc_store(SLOT(6), i0, j0, mk, lane); }
        RC_BAR();
        f32x16 qm = rc_mm<true, true>(SLOT(4), SLOT(5), i0, j0, (f32x16){}, lane);
        f32x16 yl = rc_mm<true, true>(SLOT(6), SLOT(7), i0, j0, rc_mm<true, true>(SLOT(4), SLOT(0), i0, j0, (f32x16){}, lane), lane);
        f32x16 gg = rc_mm<true, true>(SLOT(5), SLOT(1), i0, j0, (f32x16){}, lane);
        f32x16 hh = rc_mm<true, true>(SLOT(7), SLOT(2), i0, j0, rc_mm<true, true>(SLOT(0), SLOT(1), i0, j0, (f32x16){}, lane), lane);
        { const float gc = gCl[j0 + r32];
#pragma unroll
          for (int r = 0; r < 16; ++r) { const int iI = i0 + crow(r, hi), jJ = j0 + r32;
              qm[r] += bf2f(*(const LAS bf16_t*)(SLOT(3) + iI * RC_PITCH + jJ * 2));
              gg[r] = (gg[r] + (iI == jJ ? 1.f : 0.f)) * gc; hh[r] *= gc; } }
        RC_BAR();
        { LAS float* f32m = (LAS float*)(F.lds + (grp ? 34816 : 0));
#pragma unroll
          for (int r = 0; r < 16; ++r) { const int iI = i0 + crow(r, hi), jJ = j0 + r32; f32m[iI * 68 + jJ] = gg[r]; f32m[4352 + iI * 68 + jJ] = hh[r]; }
          if (grp == 0) { rc_store(F.lds + 73728, i0, j0, gg, lane); rc_store(F.lds + 82944, i0, j0, hh, lane);
#pragma unroll
              for (int r = 0; r < 16; ++r) { const size_t o = (m0 + i0 + crow(r, hi)) * 512 + h * 64 + j0 + r32; PT[o] = (bf16_t)f2bf(qm[r]); Y[o] = (bf16_t)f2bf(yl[r]); } }
          else rc_store(F.lds + 92160, i0, j0, qm, lane); }
        RC_BAR();
        if (grp == 1) {
            const f32x16 q2 = rc_mm<false, false>(F.lds + 92160, F.lds + 73728, i0, j0, (f32x16){}, lane);
            yl = rc_mm<false, false>(F.lds + 92160, F.lds + 82944, i0, j0, yl, lane);
#pragma unroll
            for (int r = 0; r < 16; ++r) { const size_t o = (m0 + i0 + crow(r, hi)) * 512 + h * 64 + j0 + r32; PT[o] = (bf16_t)f2bf(q2[r]); Y[o] = (bf16_t)f2bf(yl[r]); }
        }
        {
            const LAS float* Am = (const LAS float*)(F.lds + (grp ? 17408 : 0)); const LAS float* Bm = (const LAS float*)(F.lds + 34816); const LAS float* Hb = (const LAS float*)(F.lds + 52224);
            const int iR = gtid >> 2, jq = (gtid & 3) * 16;
            float acc[16];
#pragma unroll
            for (int e = 0; e < 16; ++e) acc[e] = grp ? Hb[iR * 68 + jq + e] : 0.f;
#pragma unroll 4
            for (int k = 0; k < 64; ++k) { const float a = Am[iR * 68 + k];
#pragma unroll
                for (int q4 = 0; q4 < 4; ++q4) { const f32x4 b4 = *(const LAS f32x4*)(Bm + k * 68 + jq + 4 * q4); acc[4 * q4] += a * b4[0]; acc[4 * q4 + 1] += a * b4[1]; acc[4 * q4 + 2] += a * b4[2]; acc[4 * q4 + 3] += a * b4[3]; } }
            float* dst = SUM + (size_t)hc * 8192 + (grp ? 0 : 4096) + iR * 64 + jq;
#pragma unroll
            for (int q4 = 0; q4 < 4; ++q4) *(f32x4*)(dst + 4 * q4) = (f32x4){acc[4 * q4], acc[4 * q4 + 1], acc[4 * q4 + 2], acc[4 * q4 + 3]};
        }
    }
    RC_BAR();
#undef SLOT
}
#undef RC_BAR

__device__ __forceinline__ void rwkv_combine(Frame& F, unsigned char* ws, int bh) {
    float* SUM = (float*)(ws + OFF_SUM);
    LAS float* Sl = (LAS float*)F.lds;
    LAS float* Pl = (LAS float*)(F.lds + 20480);
    const int tid = F.wave * 64 + lane_id(), v = tid >> 3, kq = tid & 7;
    float cur[8];
#pragma unroll
    for (int i = 0; i < 8; ++i) cur[i] = 0.f;
    for (int c = 0; c < NC; ++c) {
        const size_t hc = (size_t)bh * NC + c;
        const float* pc = SUM + (hc * 2 + 1) * 4096 + tid * 8;
        *(LAS f32x4*)(Pl + tid * 8) = *(const f32x4*)pc; *(LAS f32x4*)(Pl + tid * 8 + 4) = *(const f32x4*)(pc + 4);
#pragma unroll
        for (int i = 0; i < 8; ++i) Sl[v * 65 + 8 * kq + i] = cur[i];
        float* se = SUM + (hc * 2) * 4096 + v * 64 + 8 * kq;
        const f32x4 e0 = *(const f32x4*)se, e1 = *(const f32x4*)(se + 4);
        *(f32x4*)se = (f32x4){cur[0], cur[1], cur[2], cur[3]}; *(f32x4*)(se + 4) = (f32x4){cur[4], cur[5], cur[6], cur[7]};
        __syncthreads();
        float acc[8] = {e0[0], e0[1], e0[2], e0[3], e1[0], e1[1], e1[2], e1[3]};
#pragma unroll 8
        for (int j = 0; j < 64; ++j) { const float s = Sl[v * 65 + j]; const f32x4 p0 = *(const LAS f32x4*)(Pl + j * 64 + 8 * kq), p1 = *(const LAS f32x4*)(Pl + j * 64 + 8 * kq + 4);
            acc[0] += s * p0[0]; acc[1] += s * p0[1]; acc[2] += s * p0[2]; acc[3] += s * p0[3]; acc[4] += s * p1[0]; acc[5] += s * p1[1]; acc[6] += s * p1[2]; acc[7] += s * p1[3]; }
        __syncthreads();
#pragma unroll
        for (int i = 0; i < 8; ++i) cur[i] = acc[i];
    }
}
__device__ __forceinline__ void rwkv_fixup_task(unsigned char* ws, const float* lnx_w, const float* lnx_b, const float* r_k, int hc, int tl, int lane) {
    const bf16_t* R = (const bf16_t*)(ws + OFF_R); const bf16_t* V = (const bf16_t*)(ws + OFF_V); const bf16_t* KP = (const bf16_t*)(ws + OFF_KP);
    const bf16_t* G = (const bf16_t*)(ws + OFF_G); const bf16_t* Y = (const bf16_t*)(ws + OFF_Y); const bf16_t* PT = (const bf16_t*)(ws + OFF_PT);
    const float* S = (const float*)(ws + OFF_SUM) + (size_t)hc * 8192; bf16_t* MIX = (bf16_t*)(ws + OFF_PNSA);
    const int r32 = lane & 31, hi = lane >> 5, bh = hc / NC, c = hc % NC, h = bh & 7;
    const size_t m = (size_t)(bh >> 3) * T_ + (size_t)c * CL + 32 * tl + r32;
    const size_t row = m * 512 + h * 64;
    f32x16 acc[2]; acc[0] = (f32x16){}; acc[1] = (f32x16){};
#pragma unroll
    for (int ks = 0; ks < 4; ++ks) {
        const bf16x8 bfrag = *(const bf16x8*)(PT + row + 16 * ks + 8 * hi);
#pragma unroll
        for (int vt = 0; vt < 2; ++vt) { const float* sp = S + (size_t)(32 * vt + r32) * 64 + 16 * ks + 8 * hi; const f32x4 s0 = *(const f32x4*)sp, s1 = *(const f32x4*)(sp + 4);
            u32x4 w; w.x = pk2(s0[0], s0[1]); w.y = pk2(s0[2], s0[3]); w.z = pk2(s1[0], s1[1]); w.w = pk2(s1[2], s1[3]);
            acc[vt] = __builtin_amdgcn_mfma_f32_32x32x16_bf16(__builtin_bit_cast(bf16x8, w), bfrag, acc[vt], 0, 0, 0); }
    }
    float y[32], s1 = 0.f, rkdot = 0.f;
#pragma unroll
    for (int gq = 0; gq < 8; ++gq) { const int vo = 32 * (gq >> 2) + 8 * (gq & 3) + 4 * hi;
        if (gq == 4) __builtin_amdgcn_sched_barrier(0);
        const u32x2 yw = *(const u32x2*)(Y + row + vo), rw = *(const u32x2*)(R + row + vo), kw = *(const u32x2*)(KP + row + vo); const f32x4 rk4 = *(const f32x4*)(r_k + h * 64 + vo);
#pragma unroll
        for (int j = 0; j < 4; ++j) { const unsigned yu = j < 2 ? yw.x : yw.y, ru = j < 2 ? rw.x : rw.y, ku = j < 2 ? kw.x : kw.y;
            const float yl = __builtin_bit_cast(float, (j & 1) ? (yu & 0xffff0000u) : (yu << 16)), rf = __builtin_bit_cast(float, (j & 1) ? (ru & 0xffff0000u) : (ru << 16)), kf = __builtin_bit_cast(float, (j & 1) ? (ku & 0xffff0000u) : (ku << 16));
            const float yy = acc[gq >> 2][4 * (gq & 3) + j] + yl; y[4 * gq + j] = yy; s1 += yy; rkdot += rf * kf * rk4[j]; } }
    s1 += __shfl_xor(s1, 32); rkdot += __shfl_xor(rkdot, 32);
    const float mean = s1 * (1.0f / 64.0f); float s2 = 0.f;
#pragma unroll
    for (int i = 0; i < 32; ++i) { y[i] -= mean; s2 += y[i] * y[i]; }
    s2 += __shfl_xor(s2, 32);
    const float rstd = __builtin_amdgcn_rsqf(s2 * (1.0f / 64.0f) + LNX_EPS);
#pragma unroll
    for (int gq = 0; gq < 8; ++gq) { const int vo = 32 * (gq >> 2) + 8 * (gq & 3) + 4 * hi;
        const u32x2 vw = *(const u32x2*)(V + row + vo), gw_ = *(const u32x2*)(G + row + vo); const f32x4 lw4 = *(const f32x4*)(lnx_w + h * 64 + vo), lb4 = *(const f32x4*)(lnx_b + h * 64 + vo);
        float o4[4];
#pragma unroll
        for (int j = 0; j < 4; ++j) { const unsigned vu = j < 2 ? vw.x : vw.y, gu = j < 2 ? gw_.x : gw_.y;
            const float vf = __builtin_bit_cast(float, (j & 1) ? (vu & 0xffff0000u) : (vu << 16)), gf = __builtin_bit_cast(float, (j & 1) ? (gu & 0xffff0000u) : (gu << 16));
            o4[j] = (y[4 * gq + j] * rstd * lw4[j] + lb4[j] + rkdot * vf) * gf; }
        u32x2 w; w.x = pk2(o4[0], o4[1]); w.y = pk2(o4[2], o4[3]);
        *(u32x2*)(MIX + m * PN_LD + 512 + h * 64 + vo) = w; }
}

__device__ __forceinline__ bf16x8 v_frag(const LAS unsigned char* vbase, int VP, int kb, int dcol0, int lane) {
    const int hi = lane >> 5;
    const LAS unsigned char* p = vbase + (kb + 4 * hi + ((lane & 15) >> 2)) * VP + (dcol0 + 16 * ((lane >> 4) & 1) + 4 * (lane & 3)) * 2;
    const s16x4 lo = vtr(p), hh = vtr(p + 8 * VP);
    return (bf16x8){lo[0], lo[1], lo[2], lo[3], hh[0], hh[1], hh[2], hh[3]};
}
typedef __bf16 bf16x2_t __attribute__((ext_vector_type(2)));
__device__ __forceinline__ unsigned cvtpk(float lo, float hi) { const f32x2 v = {lo, hi}; return __builtin_bit_cast(unsigned, __builtin_convertvector(v, bf16x2_t)); }
__device__ __forceinline__ bf16x8 p_frag(const f32x16& p, int s) {
    u32x4 w; w.x = cvtpk(p[8 * s + 0], p[8 * s + 1]); w.y = cvtpk(p[8 * s + 2], p[8 * s + 3]); w.z = cvtpk(p[8 * s + 4], p[8 * s + 5]); w.w = cvtpk(p[8 * s + 6], p[8 * s + 7]);
    return __builtin_bit_cast(bf16x8, w);
}
__device__ __forceinline__ float max16(const f32x16& p) { float m = p[0];
#pragma unroll
    for (int r = 1; r < 16; ++r) m = fmaxf(m, p[r]);
    return m; }
__device__ __forceinline__ float sum16(const f32x16& p) { float a = 0.f;
#pragma unroll
    for (int r = 0; r < 16; ++r) a += p[r];
    return a; }

constexpr int XK_PITCH = 528, XV_PITCH = 144;
__device__ __forceinline__ void xattn_unit(Frame& F, const bf16_t* Q2, const bf16_t* KVX, bf16_t* XO, int b, int h4, int qt) {
    const int lane = lane_id(), wave = F.wave, tid = wave * 64 + lane, r32 = lane & 31, hi = lane >> 5;
    LAS unsigned char* kl = F.lds;
    LAS float* wsf = (LAS float*)(F.lds + 40960) + wave * 32;
    const size_t qrow = (size_t)b * T_ + (size_t)qt * 256 + wave * 32 + r32;
    bf16x8 qr[16];
#pragma unroll
    for (int ds = 0; ds < 16; ++ds) qr[ds] = *(const bf16x8*)(Q2 + qrow * D_ + h4 * 256 + 16 * ds + 8 * hi);
    const bf16_t* kg = KVX + (size_t)b * 256 * 2048 + h4 * 256;
    const bf16_t* vg = kg + 1024;
    float mref = 0.f, lrow = 0.f;
    bf16x8 PA[4][4];
    u32x4 pre[4];
#define XA_LOADK(kt_) do { _Pragma("unroll") for (int it = 0; it < 4; ++it) { const int idx = it * 512 + tid, row = idx >> 5, ch = idx & 31; pre[it] = *(const u32x4*)(kg + (size_t)((kt_) * 64 + row) * 2048 + ch * 8); } } while (0)
#define XA_WRITEK() do { _Pragma("unroll") for (int it = 0; it < 4; ++it) { const int idx = it * 512 + tid, row = idx >> 5, ch = idx & 31; *(LAS u32x4*)(kl + row * XK_PITCH + ch * 16) = pre[it]; } } while (0)
#define XA_LOADV(ds_) do { _Pragma("unroll") for (int it = 0; it < 4; ++it) { const int idx = it * 512 + tid, row = idx >> 3, ch = idx & 7; pre[it] = *(const u32x4*)(vg + (size_t)row * 2048 + (ds_) * 64 + ch * 8); } } while (0)
#define XA_WRITEV() do { _Pragma("unroll") for (int it = 0; it < 4; ++it) { const int idx = it * 512 + tid, row = idx >> 3, ch = idx & 7; *(LAS u32x4*)(kl + row * XV_PITCH + ch * 16) = pre[it]; } } while (0)
    __syncthreads();
    XA_LOADK(0); XA_WRITEK();
    __syncthreads();
#pragma unroll
    for (int kt = 0; kt < 4; ++kt) {
        if (kt < 3) XA_LOADK(kt + 1); else XA_LOADV(0);
        f32x16 p0 = {}, p1 = {};
#pragma unroll
        for (int ds = 0; ds < 16; ++ds) {
            const bf16x8 a0 = *(const LAS bf16x8*)(kl + r32 * XK_PITCH + (16 * ds + 8 * hi) * 2), a1 = *(const LAS bf16x8*)(kl + (32 + r32) * XK_PITCH + (16 * ds + 8 * hi) * 2);
            p0 = __builtin_amdgcn_mfma_f32_32x32x16_bf16(a0, qr[ds], p0, 0, 0, 0); p1 = __builtin_amdgcn_mfma_f32_32x32x16_bf16(a1, qr[ds], p1, 0, 0, 0); }
        float tmax = fmaxf(max16(p0), max16(p1)); tmax = fmaxf(tmax, __shfl_xor(tmax, 32));
        if (kt == 0) mref = tmax;
        else if (__any(tmax > mref + 16.0f)) {
            const float mnew = fmaxf(mref, tmax), alpha = __builtin_amdgcn_exp2f(mref - mnew);
            lrow *= alpha; mref = mnew;
#pragma unroll
            for (int kk = 0; kk < 4; ++kk) if (kk < kt) {
#pragma unroll
                for (int ks = 0; ks < 4; ++ks) { float f[8]; unpack8(__builtin_bit_cast(u32x4, PA[kk][ks]), f);
#pragma unroll
                    for (int e = 0; e < 8; ++e) f[e] *= alpha;
                    PA[kk][ks] = __builtin_bit_cast(bf16x8, pack8(f)); } }
        }
#pragma unroll
        for (int r = 0; r < 16; ++r) { p0[r] = __builtin_amdgcn_exp2f(p0[r] - mref); p1[r] = __builtin_amdgcn_exp2f(p1[r] - mref); }
        lrow += sum16(p0) + sum16(p1);
        PA[kt][0] = p_frag(p0, 0); PA[kt][1] = p_frag(p0, 1); PA[kt][2] = p_frag(p1, 0); PA[kt][3] = p_frag(p1, 1);
        __syncthreads();
        if (kt < 3) XA_WRITEK(); else XA_WRITEV();
        __syncthreads();
    }
    lrow += __shfl_xor(lrow, 32);
    if (hi == 0) wsf[r32] = __builtin_amdgcn_rcpf(lrow);
    asm volatile("s_waitcnt lgkmcnt(0)" ::: "memory");
#pragma unroll 1
    for (int dsl = 0; dsl < 4; ++dsl) {
        if (dsl < 3) XA_LOADV(dsl + 1);
        LAS unsigned char* ost = F.lds + 45056 + wave * 4608;
#pragma unroll
        for (int d0 = 0; d0 < 2; ++d0) {
            f32x16 o = {};
#pragma unroll
            for (int kt = 0; kt < 4; ++kt)
#pragma unroll
                for (int ks = 0; ks < 4; ++ks) o = __builtin_amdgcn_mfma_f32_32x32x16_bf16(PA[kt][ks], v_frag(kl, XV_PITCH, kt * 64 + 16 * ks, 32 * d0, lane), o, 0, 0, 0);
#pragma unroll
            for (int r = 0; r < 16; ++r) { const int q = crow(r, hi); *(LAS bf16_t*)(ost + q * 144 + (32 * d0 + r32) * 2) = (bf16_t)f2bf(o[r] * wsf[q]); }
        }
        asm volatile("s_waitcnt lgkmcnt(0)" ::: "memory");
#pragma unroll
        for (int i = 0; i < 4; ++i) { const int row = i * 8 + (lane >> 3), ch = lane & 7; *(u32x4*)(XO + (unsigned)(((b * T_ + qt * 256 + wave * 32 + row) * D_) + h4 * 256 + dsl * 64 + ch * 8)) = *(const LAS u32x4*)(ost + row * 144 + ch * 16); }
        __syncthreads();
        if (dsl < 3) XA_WRITEV();
        __syncthreads();
    }
#undef XA_LOADK
#undef XA_WRITEK
#undef XA_LOADV
#undef XA_WRITEV
}

constexpr int NK_PITCH = 128, NT_SLOT = 16384;
constexpr int NS_N = 2668, NW_N = 644;
constexpr int NL_IMP = 32768, NL_LUTS = 66560, NL_LUTW = 109248, NL_NEG = 119552, NL_SELM = 120064, NL_WSF = 121088, NL_B31 = 125184;
constexpr int IMP_PITCH = 132;

__device__ __forceinline__ void nsa_bias_cmp(f32x16& p0, f32x16& p1, const LAS float* lutsg, int db) {
    const int base = NS_N - 69 - db;
#pragma unroll
    for (int r = 0; r < 16; ++r) { const int kc = (r & 3) + 8 * (r >> 2);
        p0[r] += lutsg[min(base + 16 * kc, NS_N - 1)]; p1[r] += lutsg[min(base + 16 * (kc + 32), NS_N - 1)]; }
}
__device__ __forceinline__ void nsa_bias_tab(f32x16& p0, f32x16& p1, const LAS float* tab) {
#pragma unroll
    for (int r = 0; r < 16; ++r) { const int kc = (r & 3) + 8 * (r >> 2);
        p0[r] += tab[kc]; p1[r] += tab[kc + 32]; }
}
__device__ __forceinline__ void nsa_bias_const(f32x16& p0, f32x16& p1, float rt) {
#pragma unroll
    for (int r = 0; r < 16; ++r) { p0[r] += rt; p1[r] += rt; }
}
__device__ __forceinline__ void nsa_online(f32x16& p0, f32x16& p1, float& mrow, float& lrow, f32x16* o, LAS float* wsf, int hi, int r32) {
    float tmax = fmaxf(max16(p0), max16(p1)); tmax = fmaxf(tmax, __shfl_xor(tmax, 32));
    if (__any(tmax > mrow + 8.0f)) {
        const float mnew = fmaxf(mrow, tmax), msafe = (mnew == -INFINITY) ? 0.f : mnew;
        const float alpha = __builtin_amdgcn_exp2f(mrow - msafe);
        lrow *= alpha;
        if (o != nullptr) {
            if (hi == 0) wsf[r32] = alpha;
            asm volatile("s_waitcnt lgkmcnt(0)" ::: "memory");
#pragma unroll
            for (int r = 0; r < 16; ++r) { const float a = wsf[crow(r, hi)]; o[0][r] *= a; o[1][r] *= a; }
            asm volatile("s_waitcnt lgkmcnt(0)" ::: "memory");
        }
        mrow = mnew;
    }
    const float mref = (mrow == -INFINITY) ? 0.f : mrow;
#pragma unroll
    for (int r = 0; r < 16; ++r) { p0[r] = __builtin_amdgcn_exp2f(p0[r] - mref); p1[r] = __builtin_amdgcn_exp2f(p1[r] - mref); }
    lrow += (sum16(p0) + sum16(p1));
}
__device__ __forceinline__ void nsa_resc(float& mref, float psum, float& lrow, f32x16* o, LAS float* wsf, int hi, int r32) {
    if (__any(psum > 16384.0f)) {
        const float d = psum > 16384.0f ? __builtin_amdgcn_logf(psum) : 0.f, alpha = __builtin_amdgcn_exp2f(-d);
        lrow *= alpha; mref += d;
        if (hi == 0) wsf[r32] = alpha;
        asm volatile("s_waitcnt lgkmcnt(0)" ::: "memory");
#pragma unroll
        for (int r = 0; r < 16; ++r) { const float a = wsf[crow(r, hi)]; o[0][r] *= a; o[1][r] *= a; }
        asm volatile("s_waitcnt lgkmcnt(0)" ::: "memory");
    }
}
__device__ __forceinline__ int nsa_swz(int row) { const int x = (row >> 1) & 7; return ((x & 1) << 2) | (x & 2) | ((x >> 2) & 1); }
__device__ __forceinline__ void nsa_dma(const bf16_t* src, int pitch, LAS unsigned char* dst, int wave, int lane) {
    const int row = 8 * wave + (lane >> 3), c = (lane & 7) ^ nsa_swz(row);
    __builtin_amdgcn_global_load_lds((const unsigned*)(src + (size_t)row * pitch + c * 8), (LAS unsigned*)(dst + wave * 1024), 16, 0, 0);
}
__device__ __forceinline__ void nsa_qk(f32x16& p0, f32x16& p1, const LAS unsigned char* kl, const bf16x8* qr, int r32, int hi) {
    p0 = (f32x16){}; p1 = (f32x16){};
#pragma unroll
    for (int ds = 0; ds < 4; ++ds) {
        const int co = (((2 * ds + hi) ^ nsa_swz(r32)) << 4);
        const bf16x8 a0 = *(const LAS bf16x8*)(kl + r32 * NK_PITCH + co), a1 = *(const LAS bf16x8*)(kl + (32 + r32) * NK_PITCH + co);
        p0 = __builtin_amdgcn_mfma_f32_32x32x16_bf16(a0, qr[ds], p0, 0, 0, 0); p1 = __builtin_amdgcn_mfma_f32_32x32x16_bf16(a1, qr[ds], p1, 0, 0, 0); }
}
__device__ __forceinline__ void nsa_kfrags(bf16x8* ka, const LAS unsigned char* kl, int r32, int hi) {
#pragma unroll
    for (int ds = 0; ds < 4; ++ds) { const int co = (((2 * ds + hi) ^ nsa_swz(r32)) << 4);
        ka[2 * ds] = *(const LAS bf16x8*)(kl + r32 * NK_PITCH + co); ka[2 * ds + 1] = *(const LAS bf16x8*)(kl + (32 + r32) * NK_PITCH + co); }
}
__device__ __forceinline__ void nsa_qk_frags(f32x16& p0, f32x16& p1, const bf16x8* ka, const bf16x8* qr) {
    p0 = (f32x16){}; p1 = (f32x16){};
#pragma unroll
    for (int ds = 0; ds < 4; ++ds) { p0 = __builtin_amdgcn_mfma_f32_32x32x16_bf16(ka[2 * ds], qr[ds], p0, 0, 0, 0); p1 = __builtin_amdgcn_mfma_f32_32x32x16_bf16(ka[2 * ds + 1], qr[ds], p1, 0, 0, 0); }
}
__device__ __forceinline__ bf16x8 nsa_vfrag(const LAS unsigned char* vl, int kb, int d0, int lane) {
    const int hi = lane >> 5, row0 = 4 * hi + ((lane & 15) >> 2), chunk = 4 * d0 + 2 * ((lane >> 4) & 1) + ((lane & 3) >> 1), within = (lane & 1) * 8;
    const LAS unsigned char* pa = vl + (kb + row0) * NK_PITCH + ((chunk ^ nsa_swz(row0)) << 4) + within;
    const LAS unsigned char* pb = vl + (kb + row0 + 8) * NK_PITCH + ((chunk ^ nsa_swz(row0 + 8)) << 4) + within;
    const s16x4 lo = vtr(pa), hh = vtr(pb);
    return (bf16x8){lo[0], lo[1], lo[2], lo[3], hh[0], hh[1], hh[2], hh[3]};
}
__device__ __forceinline__ void nsa_pv(f32x16* o, const f32x16& p0, const f32x16& p1, const LAS unsigned char* vl, int lane) {
    const bf16x8 a0 = p_frag(p0, 0), a1 = p_frag(p0, 1), a2 = p_frag(p1, 0), a3 = p_frag(p1, 1);
#pragma unroll
    for (int d0 = 0; d0 < 2; ++d0) {
        o[d0] = __builtin_amdgcn_mfma_f32_32x32x16_bf16(a0, nsa_vfrag(vl, 0, d0, lane), o[d0], 0, 0, 0);
        o[d0] = __builtin_amdgcn_mfma_f32_32x32x16_bf16(a1, nsa_vfrag(vl, 16, d0, lane), o[d0], 0, 0, 0);
        o[d0] = __builtin_amdgcn_mfma_f32_32x32x16_bf16(a2, nsa_vfrag(vl, 32, d0, lane), o[d0], 0, 0, 0);
        o[d0] = __builtin_amdgcn_mfma_f32_32x32x16_bf16(a3, nsa_vfrag(vl, 48, d0, lane), o[d0], 0, 0, 0); }
}
typedef unsigned u32x2 __attribute__((ext_vector_type(2)));
__device__ __forceinline__ s16x4 nsa_cfrag(float c, int hi) {
    const unsigned ch = f2bf(c); const float rem = c - bf2f((bf16_t)ch); const unsigned cl = (c == -INFINITY) ? 0u : f2bf(rem);
    const unsigned w0 = hi ? 0u : (ch | (cl << 16));
    return __builtin_bit_cast(s16x4, (u32x2){w0, 0u});
}
__device__ __forceinline__ s16x4 nsa_onesfrag() { return __builtin_bit_cast(s16x4, (u32x2){0x3F803F80u, 0x3F803F80u}); }
__device__ __forceinline__ void nsa_qk_frags_c(f32x16& p0, f32x16& p1, const bf16x8* ka, const bf16x8* qr, s16x4 cf) {
    p0 = __builtin_amdgcn_mfma_f32_32x32x8bf16_1k(nsa_onesfrag(), cf, (f32x16){}, 0, 0, 0); p1 = __builtin_amdgcn_mfma_f32_32x32x8bf16_1k(nsa_onesfrag(), cf, (f32x16){}, 0, 0, 0);
#pragma unroll
    for (int ds = 0; ds < 4; ++ds) { p0 = __builtin_amdgcn_mfma_f32_32x32x16_bf16(ka[2 * ds], qr[ds], p0, 0, 0, 0); p1 = __builtin_amdgcn_mfma_f32_32x32x16_bf16(ka[2 * ds + 1], qr[ds], p1, 0, 0, 0); }
}
__device__ __forceinline__ void nsa_qk_c(f32x16& p0, f32x16& p1, const LAS unsigned char* kl, const bf16x8* qr, int r32, int hi, s16x4 cf) {
    p0 = __builtin_amdgcn_mfma_f32_32x32x8bf16_1k(nsa_onesfrag(), cf, (f32x16){}, 0, 0, 0); p1 = __builtin_amdgcn_mfma_f32_32x32x8bf16_1k(nsa_onesfrag(), cf, (f32x16){}, 0, 0, 0);
#pragma unroll
    for (int ds = 0; ds < 4; ++ds) {
        const int co = (((2 * ds + hi) ^ nsa_swz(r32)) << 4);
        const bf16x8 a0 = *(const LAS bf16x8*)(kl + r32 * NK_PITCH + co), a1 = *(const LAS bf16x8*)(kl + (32 + r32) * NK_PITCH + co);
        p0 = __builtin_amdgcn_mfma_f32_32x32x16_bf16(a0, qr[ds], p0, 0, 0, 0); p1 = __builtin_amdgcn_mfma_f32_32x32x16_bf16(a1, qr[ds], p1, 0, 0, 0); }
}
__device__ __forceinline__ float nsa_tile_exp_plain(f32x16& p0, f32x16& p1) {
#pragma unroll
    for (int r = 0; r < 16; ++r) { p0[r] = __builtin_amdgcn_exp2f(p0[r]); p1[r] = __builtin_amdgcn_exp2f(p1[r]); }
    return sum16(p0) + sum16(p1);
}
__device__ __forceinline__ float nsa_tile_exp_tab0(f32x16& p0, f32x16& p1, const LAS float* tab) {
#pragma unroll
    for (int r = 0; r < 16; ++r) { const int kc = (r & 3) + 8 * (r >> 2); p0[r] = __builtin_amdgcn_exp2f(p0[r] + tab[kc]); p1[r] = __builtin_amdgcn_exp2f(p1[r] + tab[kc + 32]); }
    return sum16(p0) + sum16(p1);
}
__device__ __forceinline__ void nsa_tile_exp_only(f32x16& p0, f32x16& p1) {
#pragma unroll
    for (int r = 0; r < 16; ++r) { p0[r] = __builtin_amdgcn_exp2f(p0[r]); p1[r] = __builtin_amdgcn_exp2f(p1[r]); }
}
__device__ __forceinline__ void nsa_tile_exp_tab_only(f32x16& p0, f32x16& p1, const LAS float* tab) {
#pragma unroll
    for (int r = 0; r < 16; ++r) { const int kc = (r & 3) + 8 * (r >> 2); p0[r] = __builtin_amdgcn_exp2f(p0[r] + tab[kc]); p1[r] = __builtin_amdgcn_exp2f(p1[r] + tab[kc + 32]); }
}
__device__ __forceinline__ float nsa_tile_exp_const(f32x16& p0, f32x16& p1, float c) {
#pragma unroll
    for (int r = 0; r < 16; ++r) { p0[r] = __builtin_amdgcn_exp2f(p0[r] + c); p1[r] = __builtin_amdgcn_exp2f(p1[r] + c); }
    return sum16(p0) + sum16(p1);
}
__device__ __forceinline__ float nsa_tile_exp_tab(f32x16& p0, f32x16& p1, const LAS float* tab, float mref) {
#pragma unroll
    for (int r = 0; r < 16; ++r) { const int kc = (r & 3) + 8 * (r >> 2); p0[r] += tab[kc]; p1[r] += tab[kc + 32]; }
#pragma unroll
    for (int r = 0; r < 16; ++r) { p0[r] = __builtin_amdgcn_exp2f(p0[r] - mref); p1[r] = __builtin_amdgcn_exp2f(p1[r] - mref); }
    return sum16(p0) + sum16(p1);
}
__device__ __forceinline__ void nsa_vfrags(bf16x8* vf, const LAS unsigned char* vl, int lane) {
#pragma unroll
    for (int d0 = 0; d0 < 2; ++d0)
#pragma unroll
        for (int k = 0; k < 4; ++k) vf[4 * d0 + k] = nsa_vfrag(vl, 16 * k, d0, lane);
}
__device__ __forceinline__ void nsa_pv_frags(f32x16* o, bf16x8 a0, bf16x8 a1, bf16x8 a2, bf16x8 a3, const bf16x8* vf) {
#pragma unroll
    for (int d0 = 0; d0 < 2; ++d0) {
        o[d0] = __builtin_amdgcn_mfma_f32_32x32x16_bf16(a0, vf[4 * d0 + 0], o[d0], 0, 0, 0);
        o[d0] = __builtin_amdgcn_mfma_f32_32x32x16_bf16(a1, vf[4 * d0 + 1], o[d0], 0, 0, 0);
        o[d0] = __builtin_amdgcn_mfma_f32_32x32x16_bf16(a2, vf[4 * d0 + 2], o[d0], 0, 0, 0);
        o[d0] = __builtin_amdgcn_mfma_f32_32x32x16_bf16(a3, vf[4 * d0 + 3], o[d0], 0, 0, 0); }
}
__device__ __forceinline__ void nsa_emit(bf16_t* dst0, const f32x16* o, float f, bool accumulate, bool dry, LAS float* wsf, int hi, int r32) {
    if (hi == 0) wsf[r32] = f;
    asm volatile("s_waitcnt lgkmcnt(0)" ::: "memory");
    float v0[16], v1[16];
#pragma unroll
    for (int r = 0; r < 16; ++r) { v0[r] = 0.f; v1[r] = 0.f; }
    if (accumulate) {
#pragma unroll
        for (int r = 0; r < 16; ++r) { const int q = crow(r, hi); const bf16_t* src = dst0 + (size_t)(q & 7) * PN_LD + (q >> 3) * 64; v0[r] = bf2f(src[0]); v1[r] = bf2f(src[32]); }
    }
#pragma unroll
    for (int r = 0; r < 16; ++r) { const float a = wsf[crow(r, hi)]; v0[r] += o[0][r] * a; v1[r] += o[1][r] * a; }
    if (!dry) {
#pragma unroll
        for (int r = 0; r < 16; ++r) { const int q = crow(r, hi); bf16_t* dst = dst0 + (size_t)(q & 7) * PN_LD + (q >> 3) * 64; dst[0] = (bf16_t)f2bf(v0[r]); dst[32] = (bf16_t)f2bf(v1[r]); }
    }
    asm volatile("s_waitcnt lgkmcnt(0)" ::: "memory");
}

__device__ __forceinline__ int sum8_dpp(int c) {
    c += __builtin_amdgcn_update_dpp(0, c, 0xB1, 0xF, 0xF, true);
    c += __builtin_amdgcn_update_dpp(0, c, 0x4E, 0xF, 0xF, true);
    c += __builtin_amdgcn_update_dpp(0, c, 0x141, 0xF, 0xF, true);
    return c;
}
__device__ __forceinline__ void nsa_unit(Frame& F, unsigned char* ws, const float* gate_b, int b, int hkv, int qblk, bool dry = false) {
    const int lane = lane_id(), wave = F.wave, tid = wave * 64 + lane, r32 = lane & 31, hi = lane >> 5;
    const int g = r32 >> 3, qi = r32 & 7;
    const int tq = 64 * qblk + 8 * wave + qi;
    bf16_t* PN = (bf16_t*)(ws + OFF_PNSA);
    const bf16_t* KCg = (const bf16_t*)(ws + OFF_KC) + (size_t)(b * 2 + hkv) * 512 * 64; const bf16_t* VCg = (const bf16_t*)(ws + OFF_VC) + (size_t)(b * 2 + hkv) * 512 * 64;
    LAS unsigned char* lds = F.lds;
    LAS float* luts = (LAS float*)(lds + NL_LUTS); LAS float* lutw = (LAS float*)(lds + NL_LUTW); LAS float* negt = (LAS float*)(lds + NL_NEG);
    LAS float* impl = (LAS float*)(lds + NL_IMP); LAS unsigned* selm = (LAS unsigned*)(lds + NL_SELM);
    LAS float* wsf = (LAS float*)(lds + NL_WSF) + wave * 128;
    const float* LUTg = (const float*)(ws + OFF_LUT) + (size_t)(hkv * 4) * 2048;
    __syncthreads();
    { const f32x4* ls4 = (const f32x4*)((const float*)(ws + OFF_LTS) + (size_t)(hkv * 4) * NS_N); const f32x4* lw4 = (const f32x4*)((const float*)(ws + OFF_LTW) + (size_t)(hkv * 4) * NW_N);
      for (int i = tid; i < NS_N; i += NTHREADS) ((LAS f32x4*)luts)[i] = ls4[i];
      for (int i = tid; i < NW_N; i += NTHREADS) ((LAS f32x4*)lutw)[i] = lw4[i]; }
    if (tid < 128) negt[tid] = -INFINITY;
    LAS float* b31t = (LAS float*)(lds + NL_B31);
    if (tid < 256) b31t[tid] = LUTg[(tid >> 6) * 2048 + 1535];
    const float* lutg = LUTg + g * 2048;
    const float b31 = lutg[1535];
    const size_t qoff = ((size_t)b * T_ + tq) * PN_LD;
    bf16x8 qr[4];
#pragma unroll
    for (int ds = 0; ds < 4; ++ds) qr[ds] = *(const bf16x8*)(PN + qoff + (hkv * 4 + g) * 64 + 16 * ds + 8 * hi);
#pragma unroll
    for (int j = 0; j < 3; ++j) { const int gc = (hkv * 4 + g) * 3 + j; const float gt = __builtin_amdgcn_rcpf(1.0f + __expf(-(bf2f(PN[qoff + 1280 + gc]) + gate_b[gc]))); if (hi == 0) wsf[32 + 32 * j + r32] = gt; }
#define NSA_GATE(j_) (wsf[32 + 32 * (j_) + r32])
    bf16_t* const dst0 = PN + ((size_t)b * T_ + 64 * qblk + 8 * wave) * PN_LD + hkv * 256 + r32;
#define NSA_DMA(kp, vp, pitch, tile, slot) do { nsa_dma((kp) + (size_t)(tile) * 64 * (pitch), (pitch), lds + (slot) * NT_SLOT, wave, lane); nsa_dma((vp) + (size_t)(tile) * 64 * (pitch), (pitch), lds + (slot) * NT_SLOT + 8192, wave, lane); } while (0)
#define NSA_SYNC() do { asm volatile("s_waitcnt vmcnt(0)" ::: "memory"); __syncthreads(); } while (0)
    f32x16 p0, p1, o[2];
    const int nct = (4 * qblk + 3 + 63) / 64;
    float mc = 0.f, lc = 0.f;
    for (int i = 0; i < nct; ++i) nsa_dma(KCg + (size_t)i * 64 * 64, 64, lds + i * 8192, wave, lane);
    NSA_SYNC();
    for (int i = 0; i < nct; ++i) {
        const bool farc = (64 * qblk + 8 * wave) - 1024 * i - 1039 >= 1535;
        nsa_qk_c(p0, p1, lds + i * 8192, qr, r32, hi, nsa_cfrag(farc ? b31 - mc : -mc, hi));
        if (!farc) nsa_bias_cmp(p0, p1, luts + g * NS_N, tq - 31 - 1024 * i - 64 * hi);
        const float ts = nsa_tile_exp_plain(p0, p1); lc += ts;
        const float ps = fmaxf(ts, __shfl_xor(ts, 32));
        if (__any(ps > 16384.0f)) { const float d = ps > 16384.0f ? __builtin_amdgcn_logf(ps) : 0.f; lc *= __builtin_amdgcn_exp2f(-d); mc += d; }
    }
    __syncthreads();
    lc += __shfl_xor(lc, 32);
    const float cnorm = lc > 0.f ? -mc - __builtin_amdgcn_logf(lc) : -INFINITY;
    o[0] = (f32x16){}; o[1] = (f32x16){};
    float carry = 0.f;
    NSA_DMA(KCg, VCg, 64, 0, 0);
    NSA_SYNC();
    for (int i = 0; i < nct; ++i) {
        if (i + 1 < nct) NSA_DMA(KCg, VCg, 64, i + 1, (i + 1) & 1);
        const bool farc = (64 * qblk + 8 * wave) - 1024 * i - 1039 >= 1535;
        nsa_qk_c(p0, p1, lds + (i & 1) * NT_SLOT, qr, r32, hi, nsa_cfrag(farc ? b31 + cnorm : cnorm, hi));
        if (!farc) nsa_bias_cmp(p0, p1, luts + g * NS_N, tq - 31 - 1024 * i - 64 * hi);
#pragma unroll
        for (int r = 0; r < 16; ++r) { p0[r] = __builtin_amdgcn_exp2f(p0[r]); p1[r] = __builtin_amdgcn_exp2f(p1[r]); }
        float gs[8], gl[8], rc[8];
#pragma unroll
        for (int k4 = 0; k4 < 4; ++k4) { gs[k4] = (p0[4 * k4] + p0[4 * k4 + 1]) + (p0[4 * k4 + 2] + p0[4 * k4 + 3]); gl[k4] = p0[4 * k4 + 3];
            gs[4 + k4] = (p1[4 * k4] + p1[4 * k4 + 1]) + (p1[4 * k4 + 2] + p1[4 * k4 + 3]); gl[4 + k4] = p1[4 * k4 + 3]; }
#pragma unroll
        for (int k = 0; k < 8; ++k) rc[k] = __shfl_xor(gl[k], 32);
#pragma unroll
        for (int k = 0; k < 8; ++k) { const float prev = hi ? rc[k] : (k == 0 ? carry : rc[k - 1]); float v = gs[k] + prev;
            v += __shfl_xor(v, 8); v += __shfl_xor(v, 16);
            if (g == 0) impl[(8 * wave + qi) * IMP_PITCH + 16 * i + 2 * k + hi] = v; }
        carry = rc[7];
        nsa_pv(o, p0, p1, lds + (i & 1) * NT_SLOT + 8192, lane);
        NSA_SYNC();
    }
    nsa_emit(dst0, o, NSA_GATE(0), false, dry, wsf, hi, r32);
    {
        const int q8 = lane >> 3, jg = lane & 7, qq = 8 * wave + q8, cur = qblk;
        unsigned bits = 0u;
        if (cur >= 16) {
            unsigned key[16];
#pragma unroll
            for (int jj = 0; jj < 16; ++jj) { const int j = 16 * jg + jj; const unsigned kb_ = __builtin_bit_cast(unsigned, impl[qq * IMP_PITCH + j]); key[jj] = (j >= 1 && j <= cur - 2) ? kb_ + 1u : 0u; }
            unsigned Tsel = 0u; bool done = false;
            int bb0 = 30; asm volatile("" : "+s"(bb0));
#pragma unroll 2
            for (int bb = bb0; bb >= 0; --bb) { const unsigned Tt = Tsel | (1u << bb); int c = 0;
#pragma unroll
                for (int jj = 0; jj < 16; ++jj) c += (key[jj] >= Tt) ? 1 : 0;
                c = sum8_dpp(c);
                Tsel = (!done && c >= 13) ? Tt : Tsel;
                done = done || c == 13;
                if (__all(done)) break; }
            int ngt = 0, neq = 0;
#pragma unroll
            for (int jj = 0; jj < 16; ++jj) { ngt += (key[jj] > Tsel) ? 1 : 0; neq += (key[jj] == Tsel) ? 1 : 0; }
            ngt = sum8_dpp(ngt);
            int pre = neq;
            { int t = __shfl_up(pre, 1, 8); if (jg >= 1) pre += t; t = __shfl_up(pre, 2, 8); if (jg >= 2) pre += t; t = __shfl_up(pre, 4, 8); if (jg >= 4) pre += t; }
            int run = pre - neq; const int need = 13 - ngt;
#pragma unroll
            for (int jj = 0; jj < 16; ++jj) { const int j = 16 * jg + jj; bool sel = key[jj] > Tsel;
                if (key[jj] == Tsel && Tsel != 0u) { sel = run < need; ++run; }
                sel = sel || j == 0 || j == cur || j == cur - 1; bits |= sel ? (1u << jj) : 0u; }
        } else {
#pragma unroll
            for (int jj = 0; jj < 16; ++jj) { const int j = 16 * jg + jj; bits |= (j <= cur) ? (1u << jj) : 0u; }
        }
        const unsigned other = (unsigned)__shfl_xor((int)bits, 1);
        if ((jg & 1) == 0) selm[qq * 4 + (jg >> 1)] = bits | (other << 16);
        asm volatile("s_waitcnt lgkmcnt(0)" ::: "memory");
    }
    const LAS unsigned* sm = selm + (8 * wave + qi) * 4;
#define NSA_SB() __builtin_amdgcn_sched_barrier(0)
#define NSA_PAIR(EXPA, EXPB) do { \
            { bf16x8 ka_[8]; nsa_kfrags(ka_, sl_, r32, hi); NSA_SB(); nsa_qk_frags(p0, p1, ka_, qr); } \
            NSA_SB(); \
            nsa_qk(q0, q1, sl_ + NT_SLOT, qr, r32, hi); \
            EXPA; \
            fa0 = p_frag(p0, 0); fa1 = p_frag(p0, 1); fa2 = p_frag(p1, 0); fa3 = p_frag(p1, 1); \
            NSA_SB(); \
            { bf16x8 va_[8]; nsa_vfrags(va_, sl_ + 8192, lane); NSA_SB(); nsa_pv_frags(o, fa0, fa1, fa2, fa3, va_); } \
            EXPB; \
            fa0 = p_frag(q0, 0); fa1 = p_frag(q0, 1); fa2 = p_frag(q1, 0); fa3 = p_frag(q1, 1); \
            NSA_SB(); \
            { bf16x8 vb_[8]; nsa_vfrags(vb_, sl_ + NT_SLOT + 8192, lane); NSA_SB(); nsa_pv_frags(o, fa0, fa1, fa2, fa3, vb_); } \
        } while (0)
#define NSA_PAIR_C(CFA, CFB, EXPA, EXPB) do { \
            { bf16x8 ka_[8]; nsa_kfrags(ka_, sl_, r32, hi); const s16x4 cfa_ = (CFA); NSA_SB(); nsa_qk_frags_c(p0, p1, ka_, qr, cfa_); } \
            NSA_SB(); \
            nsa_qk_c(q0, q1, sl_ + NT_SLOT, qr, r32, hi, (CFB)); \
            EXPA; \
            fa0 = p_frag(p0, 0); fa1 = p_frag(p0, 1); fa2 = p_frag(p1, 0); fa3 = p_frag(p1, 1); \
            NSA_SB(); \
            { bf16x8 va_[8]; nsa_vfrags(va_, sl_ + 8192, lane); NSA_SB(); nsa_pv_frags(o, fa0, fa1, fa2, fa3, va_); } \
            EXPB; \
            fa0 = p_frag(q0, 0); fa1 = p_frag(q0, 1); fa2 = p_frag(q1, 0); fa3 = p_frag(q1, 1); \
            NSA_SB(); \
            { bf16x8 vb_[8]; nsa_vfrags(vb_, sl_ + NT_SLOT + 8192, lane); NSA_SB(); nsa_pv_frags(o, fa0, fa1, fa2, fa3, vb_); } \
            tsa_ = sum16(p0) + sum16(p1); tsb_ = sum16(q0) + sum16(q1);     \
        } while (0)
#define NSA_ITER_HEAD(kp, vp, t0, nt) \
            const int jn_ = (j + 1 < np_) ? j + 1 : j, tb_ = (2 * jn_ + 1 < (nt)) ? 2 * jn_ + 1 : 2 * jn_; \
            NSA_DMA(kp, vp, PN_LD, (t0) + 2 * jn_, 2 * ((j + 1) & 1)); NSA_DMA(kp, vp, PN_LD, (t0) + tb_, 2 * ((j + 1) & 1) + 1);        \
            const LAS unsigned char* sl_ = lds + (j & 1) * 2 * NT_SLOT; \
            f32x16 q0, q1; float tsa_, tsb_; bf16x8 fa0, fa1, fa2, fa3;
#define NSA_ITER_TAIL(mref, psum, lvar) \
            { float ts_ = tsa_ + tsb_; lvar += ts_; psum = fmaxf(ts_, __shfl_xor(ts_, 32)); } \
            NSA_SYNC(); \
            nsa_resc(mref, psum, lvar, o, wsf, hi, r32);
#define NSA_LOOP2(kp, vp, t0, nt, TABF, NFAR, SELBIT, mref, psum, lvar) do { \
        const int np_ = ((nt) + 1) >> 1, nf_ = (NFAR) < np_ ? (NFAR) : np_; \
        __syncthreads();                                                \
        NSA_DMA(kp, vp, PN_LD, (t0), 0); NSA_DMA(kp, vp, PN_LD, (t0) + ((nt) > 1 ? 1 : 0), 1); \
        NSA_SYNC(); \
        int j = 0; \
        for (; j < nf_; ++j) { \
            NSA_ITER_HEAD(kp, vp, t0, nt) \
            float ca_, cb_; { const int i = 2 * j; ca_ = (SELBIT) ? b31 : -INFINITY; } { const int i = 2 * j + 1; cb_ = (SELBIT) ? b31 : -INFINITY; } \
            NSA_PAIR_C(nsa_cfrag(ca_ - mref, hi), nsa_cfrag(cb_ - mref, hi), nsa_tile_exp_only(p0, p1), nsa_tile_exp_only(q0, q1)); \
            NSA_ITER_TAIL(mref, psum, lvar) \
        } \
        for (; j < np_; ++j) { \
            NSA_ITER_HEAD(kp, vp, t0, nt) \
            const s16x4 cfm_ = nsa_cfrag(-mref, hi); \
            NSA_PAIR_C(cfm_, cfm_, { const int i = 2 * j; nsa_tile_exp_tab_only(p0, p1, TABF); }, { const int i = 2 * j + 1; nsa_tile_exp_tab_only(q0, q1, (i < (nt)) ? (TABF) : (const LAS float*)negt); }); \
            NSA_ITER_TAIL(mref, psum, lvar) \
        } } while (0)
    {
        const bf16_t* kp = PN + (size_t)b * T_ * PN_LD + 768 + hkv * 64; const bf16_t* vp = kp + 128;
        float ms = 0.f, mp = 0.f, ls = 0.f; o[0] = (f32x16){}; o[1] = (f32x16){};
        const int nt = qblk + 1;
        const LAS float* lutsg = luts + g * NS_N + (NS_N - 69 - (tq - 4 * hi)); const LAS float* b31g = b31t + g * 64;
        const int dmin0 = 64 * qblk + 8 * wave - 63;
        NSA_LOOP2(kp, vp, 0, nt, (((sm[(i >> 5) & 3] >> (i & 31)) & 1u) ? ((dmin0 - 64 * i >= 1535) ? b31g : lutsg + 64 * i) : (const LAS float*)negt), (dmin0 >= 1599 ? (dmin0 - 1599) / 128 + 1 : 0), ((sm[(i >> 5) & 3] >> (i & 31)) & 1u), ms, mp, ls);
        ls += __shfl_xor(ls, 32);
        nsa_emit(dst0, o, NSA_GATE(1) * __builtin_amdgcn_rcpf(ls), true, dry, wsf, hi, r32);
    }
    {
        const bf16_t* kp = PN + (size_t)b * T_ * PN_LD + 1024 + hkv * 64; const bf16_t* vp = kp + 128;
        float mw = 0.f, mp = 0.f, lw = 0.f; o[0] = (f32x16){}; o[1] = (f32x16){};
        const int first = qblk >= 8 ? qblk - 8 : 0, nt = qblk - first + 1;
        const LAS float* lutwg = lutw + g * NW_N + (NW_N - 69 - (tq - 64 * first - 4 * hi));
        NSA_LOOP2(kp, vp, first, nt, (lutwg + 64 * i), 0, true, mw, mp, lw);
        lw += __shfl_xor(lw, 32);
        nsa_emit(dst0, o, NSA_GATE(2) * __builtin_amdgcn_rcpf(lw), true, dry, wsf, hi, r32);
    }
#undef NSA_LOOP2
#undef NSA_ITER_HEAD
#undef NSA_ITER_TAIL
#undef NSA_PAIR
#undef NSA_PAIR_C
#undef NSA_SB
#undef NSA_DMA
#undef NSA_SYNC
#undef NSA_GATE
}

#define XB_TMO      128
#define XB_XCNT(j)  (256  + 64 * (j))
#define XB_XSUB(j)  (1280 + 64 * (j))
#define XB_XGEN(j)  (2304 + 64 * (j))
#define XB_TOP      3328
#define XB_TOPGEN   3392
#define XCD_BAR_WORDS 3456
#define XB_SPIN_CAP (1u << 18)
__device__ __forceinline__ unsigned xb_ld(unsigned* p)              { return __hip_atomic_load(p, __ATOMIC_RELAXED, __HIP_MEMORY_SCOPE_AGENT); }
__device__ __forceinline__ unsigned xb_add(unsigned* p, unsigned v) { return __hip_atomic_fetch_add(p, v, __ATOMIC_RELAXED, __HIP_MEMORY_SCOPE_AGENT); }
__device__ __forceinline__ unsigned xb_xcc_id() { return (unsigned)__builtin_amdgcn_s_getreg((3 << 11) | 20) & 0xFu; }
#define XB_SPIN(cond, bar) do { unsigned _sp = 0; while (cond) { __builtin_amdgcn_s_sleep(1); \
    if ((++_sp & 255u) == 0u) { if (xb_ld(&(bar)[XB_TMO])) break; if (_sp > XB_SPIN_CAP) { atomicAdd(&(bar)[XB_TMO], 1u); break; } } } } while (0)
struct XcdBarrier { unsigned* bar; unsigned x; volatile LAS unsigned* st; };
__device__ __forceinline__ void xcd_barrier_complete(unsigned* bar, unsigned x, unsigned& nloc, unsigned& nx) {
    const unsigned G = gridDim.x;
    unsigned sum, cnt, mine, sp = 0u;
    for (;;) {
        sum = 0u; cnt = 0u; mine = 0u;
#pragma unroll
        for (unsigned j = 0; j < 16; ++j) { const unsigned c = xb_ld(&bar[XB_XCNT(j)]); sum += c; cnt += (c > 0u) ? 1u : 0u; mine = (j == x) ? c : mine; }
        if (sum == G) break;
        __builtin_amdgcn_s_sleep(1);
        if ((++sp & 255u) == 0u) { if (xb_ld(&bar[XB_TMO])) break; if (sp > XB_SPIN_CAP) { atomicAdd(&bar[XB_TMO], 1u); break; } }
    }
    nloc = mine > 0u ? mine : 1u; nx = cnt > 0u ? cnt : 1u;
}
__device__ __forceinline__ void xcd_barrier(const XcdBarrier& b, bool leader_thread) {
    asm volatile("s_waitcnt vmcnt(0)" ::: "memory");
    __syncthreads();
    if (leader_thread) {
        unsigned* bar = b.bar;
        __builtin_amdgcn_s_waitcnt(0);
        unsigned nloc = b.st[0], nx = b.st[1];
        if (nloc == 0u) { xcd_barrier_complete(bar, b.x, nloc, nx); b.st[0] = nloc; b.st[1] = nx; }
        const unsigned old = xb_add(&bar[XB_XSUB(b.x)], 1u);
        const unsigned gen = old / nloc;
        if (old + 1u == (gen + 1u) * nloc) {
            __builtin_amdgcn_fence(__ATOMIC_RELEASE, "agent");
            asm volatile("s_waitcnt vmcnt(0)" ::: "memory");
            const unsigned og = xb_add(&bar[XB_TOP], 1u);
            const unsigned tg = og / nx;
            if (og + 1u == (tg + 1u) * nx) xb_add(&bar[XB_TOPGEN], 1u);
            else XB_SPIN(xb_ld(&bar[XB_TOPGEN]) == tg, bar);
            __builtin_amdgcn_fence(__ATOMIC_ACQUIRE, "agent");
            xb_add(&bar[XB_XGEN(b.x)], 1u);
            asm volatile("s_waitcnt vmcnt(0)" ::: "memory");
        } else {
            XB_SPIN(xb_ld(&bar[XB_XGEN(b.x)]) == gen, bar);
            __builtin_amdgcn_fence(__ATOMIC_ACQUIRE, "agent");
            asm volatile("s_waitcnt vmcnt(0)" ::: "memory");
        }
    }
    __syncthreads();
}
constexpr size_t OFF_BAR = 256 * 1024;
constexpr size_t OFF_CNT = 320 * 1024;
constexpr size_t OFF_PCNT = 384 * 1024;

__global__ void __launch_bounds__(NTHREADS, 2) hybrid_fwd(Args args) {
    extern __shared__ __attribute__((aligned(16))) unsigned char lds_raw[];
    Frame F;
    F.lds = (LAS unsigned char*)lds_raw;
    F.wave = __builtin_amdgcn_readfirstlane(threadIdx.x >> 6);
    F.G = gridDim.x; F.blk = blockIdx.x;
    XcdBarrier xbar; xbar.bar = (unsigned*)(args.ws + OFF_BAR); xbar.x = xb_xcc_id(); xbar.st = (volatile LAS unsigned*)(F.lds + LDS_CTRL + 1024);
    if (threadIdx.x < 2) xbar.st[threadIdx.x] = 0u;
    if (threadIdx.x == 0) (void)xb_add(&xbar.bar[XB_XCNT(xbar.x)], 1u);
    __syncthreads();
#define IN(k) (true)
#define SEAM(k) xcd_barrier(xbar, F.wave == 0 && lane_id() == 0)
#define WSP(type, off) ((type*)(args.ws + (off)))
#define PHASE_IDS() unsigned char* ws = args.ws; (void)ws; const int lane = lane_id(), tid = F.wave * 64 + lane, gw = F.blk * NWAVES + F.wave, NGW = F.G * NWAVES, gt = F.blk * NTHREADS + tid, NGT = F.G * NTHREADS; (void)gw; (void)NGW; (void)gt; (void)NGT; (void)tid; (void)lane
#define XIN (args.in[0])
#define SS1 WSP(float, OFF_SS1)
#define SS2 WSP(float, OFF_SS2)
#define SS3 WSP(float, OFF_SS3)
#define XN WSP(bf16_t, OFF_XN)
#define XB WSP(bf16_t, OFF_XN)
#define Win_t WSP(bf16_t, OFF_WIN)
#define Wkv_t ((bf16_t*)args.out + (size_t)10 * 1024 * 1024)
#define Wc1k_t WSP(bf16_t, OFF_WC1K)
#define Wc1v_t WSP(bf16_t, OFF_WC1V)
#define Wlora_t WSP(bf16_t, OFF_WLORA)
#define Wout_t ((bf16_t*)args.out)
#define Wq_t ((bf16_t*)args.out + (size_t)1024 * 1024)
#define Wo_t ((bf16_t*)args.out + (size_t)2 * 1024 * 1024)
#define Wgu_t ((bf16_t*)args.out + (size_t)3 * 1024 * 1024)
#define Wd_t WSP(bf16_t, OFF_WD)
#define Hb WSP(bf16_t, OFF_H)
#define MEMN WSP(bf16_t, OFF_MEMN)
#define KVX WSP(bf16_t, OFF_KVX)
#define PNSA WSP(bf16_t, OFF_PNSA)
#define PRW WSP(bf16_t, OFF_R1)
#define LUT WSP(float, OFF_LUT)
#define CBK WSP(float, OFF_CBK)
#define CBPART WSP(float, OFF_CBPART)
#define H1K WSP(bf16_t, OFF_H1K)
#define H1V WSP(bf16_t, OFF_H1V)
#define KC WSP(bf16_t, OFF_KC)

    if (IN(0)) { PHASE_IDS();
        {
          LAS float* scr = (LAS float*)(F.lds + F.wave * 16384);
          for (int it = gw; it < 3088; it += NGW) {
              if (it < 1552) p0_transpose_item(args.in[5], D_, IN_COLS, Win_t, D_, 1, 0, scr, it, lane);
              else if (it < 2576) p0_transpose_item(args.in[30], D_, 2 * D_, Wkv_t, D_, 0, 0, scr, it - 1552, lane);
              else if (it < 2832) p0_transpose_item(args.in[9], 2048, 256, Wc1k_t, 2048, 0, 0, scr, it - 2576, lane);
              else p0_transpose_item(args.in[12], 2048, 256, Wc1v_t, 2048, 0, 0, scr, it - 2832, lane); } }
        for (int i = gt; i < (NIN - IN_COLS) * (D_ / 8); i += NGT) *(u32x4*)(Win_t + (size_t)IN_COLS * D_ + (size_t)i * 8) = (u32x4){0u, 0u, 0u, 0u};
        for (int i = gt; i < 1536 * 32; i += NGT) { const int n = i >> 5, kc = (i & 31) * 8, reg = n >> 9, nn = n & 511; float f[8];
#pragma unroll
            for (int j = 0; j < 8; ++j) { const int k = kc + j; float v = 0.f;
                if (reg == 0 && k < 64) v = args.in[17][(size_t)k * 512 + nn];
                else if (reg == 1 && k >= 64 && k < 128) v = args.in[19][(size_t)(k - 64) * 512 + nn];
                else if (reg == 2 && k >= 128) v = args.in[20][(size_t)(k - 128) * 512 + nn];
                f[j] = v; }
            *(u32x4*)(Wlora_t + (size_t)n * 256 + kc) = pack8(f); }
        for (int m = gw; m < M_; m += 2 * NGW) {
            const int m2 = m + NGW; const bool two = m2 < M_;
            const f32x4* xa = (const f32x4*)(XIN + (size_t)m * D_) + lane; const f32x4* xb = (const f32x4*)(XIN + (size_t)(two ? m2 : m) * D_) + lane;
            f32x4 va[4], vb[4]; float sa = 0.f, sb = 0.f;
#pragma unroll
            for (int j = 0; j < 4; ++j) { va[j] = xa[64 * j]; vb[j] = xb[64 * j]; }
#pragma unroll
            for (int j = 0; j < 4; ++j) { sa += (va[j][0] * va[j][0] + va[j][1] * va[j][1]) + (va[j][2] * va[j][2] + va[j][3] * va[j][3]); sb += (vb[j][0] * vb[j][0] + vb[j][1] * vb[j][1]) + (vb[j][2] * vb[j][2] + vb[j][3] * vb[j][3]); }
#pragma unroll
            for (int o = 1; o < 64; o <<= 1) { sa += __shfl_xor(sa, o); sb += __shfl_xor(sb, o); }
            const float ra = __builtin_amdgcn_rsqf(sa * (1.0f / D_) + RMS_EPS), rb = __builtin_amdgcn_rsqf(sb * (1.0f / D_) + RMS_EPS);
#pragma unroll
            for (int j = 0; j < 4; ++j) { const f32x4 g4 = *((const f32x4*)args.in[4] + lane + 64 * j); const f32x4 ya = va[j] * ra * g4, yb = vb[j] * rb * g4;
                u32x2 w; w.x = pk2(ya[0], ya[1]); w.y = pk2(ya[2], ya[3]); *((u32x2*)(XN + (size_t)m * D_) + lane + 64 * j) = w;
                if (two) { w.x = pk2(yb[0], yb[1]); w.y = pk2(yb[2], yb[3]); *((u32x2*)(XN + (size_t)m2 * D_) + lane + 64 * j) = w; } }
        }
        for (int m = gw; m < 512; m += NGW) rms_row_to_bf16(args.in[1] + (size_t)m * D_, args.in[28], MEMN + (size_t)m * D_, lane);
        for (int i = gt; i < 8 * 2048; i += NGT) { const int h = i >> 11, d = i & 2047; int bk;
            if (d < 16) bk = d; else { bk = 16; const int thr[15] = {22, 30, 40, 54, 73, 99, 134, 182, 246, 332, 450, 609, 825, 1117, 1513};
#pragma unroll
                for (int j = 0; j < 15; ++j) bk += (d >= thr[j]) ? 1 : 0; }
            LUT[i] = args.in[2][bk * 8 + h] * LOG2E; }
        for (int i = gt; i < 8 * (NS_N + NW_N); i += NGT) { const bool isw = i >= 8 * NS_N; const int ii = isw ? i - 8 * NS_N : i, n = isw ? NW_N : NS_N, h = ii / n, dist = (n - 1 - (ii % n)) - 68;
            const int d = dist < 0 ? 0 : (dist < 1535 ? dist : 1535); int bk;
            if (d < 16) bk = d; else { bk = 16; const int thr[15] = {22, 30, 40, 54, 73, 99, 134, 182, 246, 332, 450, 609, 825, 1117, 1513};
#pragma unroll
                for (int j = 0; j < 15; ++j) bk += (d >= thr[j]) ? 1 : 0; }
            const bool valid = isw ? (dist >= 0 && dist < 512) : (dist >= 0);
            (isw ? WSP(float, OFF_LTW) : WSP(float, OFF_LTS))[ii] = valid ? args.in[2][bk * 8 + h] * LOG2E : -INFINITY; }
        for (int i = gt; i < 32 * 512; i += NGT) { const int lc = i >> 9, j = i & 511; const float* pe = (j < 256 ? args.in[7] : args.in[8]) + lc * 64; const float* w1 = (j < 256 ? args.in[9] : args.in[12]) + (size_t)lc * 64 * 256 + (j & 255);
            float s = 0.f;
#pragma unroll 8
            for (int d = 0; d < 64; ++d) s += pe[d] * w1[(size_t)d * 256];
            CBPART[i] = s; }
    }
    SEAM(0);
    if (IN(1)) { PHASE_IDS();
        if (F.blk == 100) { const int j = tid; float s = (j < 256 ? args.in[10] : args.in[13])[j & 255];
            for (int lc = 0; lc < 32; ++lc) s += CBPART[lc * 512 + j];
            CBK[j < 256 ? j : 512 + (j - 256)] = s; }
        { pg8::Gemm g{XN, Win_t, M_, NIN - 256, D_, D_, 128, 0}; pg8::StaticOrder S; S.init(M_, NIN - 256, F.G, F.blk);
          pg8::EpiStore E{PRW, PR_LD, 7, PNSA, PN_LD, 7, 9, QK_C};
          pg8::gemm_phase(F.lds, g, S, E, F.wave); }
    }
    SEAM(1);
    if (IN(2)) { PHASE_IDS();
        bf16_t* R = (bf16_t*)(ws + OFF_R); bf16_t* V = (bf16_t*)(ws + OFF_V); bf16_t* KK = (bf16_t*)(ws + OFF_KK); bf16_t* KP = (bf16_t*)(ws + OFF_KP);
        bf16_t* LA = (bf16_t*)(ws + OFF_LORA_A);
        const float* mu = args.in[15]; const float* k_k = args.in[21];
        for (int m = (F.blk >= 16 ? (F.blk - 16) * NWAVES + F.wave : M_); m < M_; m += (F.G - 16) * NWAVES) {
            const bf16_t* pr = PRW + (size_t)m * PR_LD; const bool hp = (m % T_) != 0;
#pragma unroll
            for (int q = 0; q < 3; ++q) { const int col = q * 512 + 8 * lane;
                const u32x4 cw = *(const u32x4*)(pr + col); u32x4 pw = (u32x4){0u, 0u, 0u, 0u}; if (hp) pw = *(const u32x4*)(pr - PR_LD + col);
                float cf[8], pf[8], val[8]; unpack8(cw, cf); unpack8(pw, pf);
                const f32x4 m0 = *(const f32x4*)(mu + col), m1 = *(const f32x4*)(mu + col + 4);
#pragma unroll
                for (int i = 0; i < 8; ++i) val[i] = cf[i] + (pf[i] - cf[i]) * (i < 4 ? m0[i & 3] : m1[i & 3]);
                const size_t o = (size_t)m * 512 + 8 * lane;
                if (q == 0) *(u32x4*)(R + o) = pack8(val);
                else if (q == 2) *(u32x4*)(V + o) = pack8(val);
                else { *(u32x4*)(KP + o) = pack8(val);
                    const f32x4 k0 = *(const f32x4*)(k_k + 8 * lane), k1 = *(const f32x4*)(k_k + 8 * lane + 4); float kr[8], ss = 0.f;
#pragma unroll
                    for (int i = 0; i < 8; ++i) { kr[i] = val[i] * (i < 4 ? k0[i & 3] : k1[i & 3]); ss += kr[i] * kr[i]; }
                    ss += __shfl_xor(ss, 1); ss += __shfl_xor(ss, 2); ss += __shfl_xor(ss, 4);
                    const float inv = __builtin_amdgcn_rsqf(fmaxf(ss, 1e-24f));
#pragma unroll
                    for (int i = 0; i < 8; ++i) kr[i] *= inv;
                    *(u32x4*)(KK + o) = pack8(kr); }
            }
            { const int col = 1536 + 4 * lane; const u32x2 cw = *(const u32x2*)(pr + col); u32x2 pw = (u32x2){0u, 0u}; if (hp) pw = *(const u32x2*)(pr - PR_LD + col);
              const f32x4 mm = *(const f32x4*)(mu + col); float o4[4];
#pragma unroll
              for (int i = 0; i < 4; ++i) { const unsigned cu = i < 2 ? cw.x : cw.y, pu = i < 2 ? pw.x : pw.y;
                  const float cf = __builtin_bit_cast(float, (i & 1) ? (cu & 0xffff0000u) : (cu << 16)), pf = __builtin_bit_cast(float, (i & 1) ? (pu & 0xffff0000u) : (pu << 16));
                  const float v = cf + (pf - cf) * mm[i];
                  o4[i] = lane < 16 ? (1.0f - 2.0f * __builtin_amdgcn_rcpf(1.0f + __expf(2.0f * v))) : (lane < 32 ? v : __builtin_amdgcn_rcpf(1.0f + __expf(-v))); }
              u32x2 w; w.x = pk2(o4[0], o4[1]); w.y = pk2(o4[2], o4[3]); *(u32x2*)(LA + (size_t)m * 256 + 4 * lane) = w; }
        }
        { pg8::Gemm g{PNSA + 512, Wc1k_t, 2048, 256, 2048, 16 * PN_LD, PN_LD * 2, 1}; pg8::ListOrder S; S.init(2048, 256, 0, F.blk);
          pg8::EpiGelu E{H1K, CBK};
          pg8::gemm_phase(F.lds, g, S, E, F.wave); }
        { pg8::Gemm g{PNSA + 640, Wc1v_t, 2048, 256, 2048, 16 * PN_LD, PN_LD * 2, 1}; pg8::ListOrder S; S.init(2048, 256, 8, F.blk);
          pg8::EpiGelu E{H1V, CBK + 512};
          pg8::gemm_phase(F.lds, g, S, E, F.wave); }
    }
    SEAM(2);
    if (IN(3)) { PHASE_IDS();
        { pg8::Gemm g{(const bf16_t*)(ws + OFF_LORA_A), Wlora_t, M_, 1536, 256, 256, 128, 0}; pg8::StaticOrder S; S.init(M_, 1536, F.G, F.blk);
          pg8::EpiLora E{(float*)(ws + OFF_W), (bf16_t*)(ws + OFF_KP), (const bf16_t*)(ws + OFF_KK), (bf16_t*)(ws + OFF_B), (bf16_t*)(ws + OFF_G), args.in[16], args.in[18], args.in[22]};
          pg8::gemm_phase(F.lds, g, S, E, F.wave);
          }
        { pg8::Gemm g{XN, Win_t + (size_t)(NIN - 256) * D_, M_, 256, D_, D_, 128, 0}; pg8::ListOrder S; S.init(M_, 256, 128, F.blk);
          pg8::EpiStore E{PNSA + 1280, PN_LD, 1000, nullptr, 0, 0, 0, 1.0f};
          pg8::gemm_phase(F.lds, g, S, E, F.wave); }
        {
          LAS float* scr = (LAS float*)(F.lds + F.wave * 16384);
          const int q3 = F.G >> 2, grp3 = F.blk < 2 * q3 ? 0 : (F.blk < 3 * q3 ? 1 : 2);
          const int it0 = grp3 == 0 ? gw : (grp3 == 2 ? 2880 + (F.blk - 3 * q3) * NWAVES + F.wave : 5760), itn = grp3 == 0 ? 2880 : 5760, its = grp3 == 0 ? 2 * q3 * NWAVES : q3 * NWAVES;
          for (int it = it0; it < itn; it += its) {
              if (it < 512) p0_transpose_item(args.in[26], D_, D_, Wout_t, D_, 0, 0, scr, it, lane);
              else if (it < 1024) p0_transpose_item(args.in[29], D_, D_, Wq_t, D_, 0, 0, scr, it - 512, lane);
              else if (it < 1536) p0_transpose_item(args.in[31], D_, D_, Wo_t, D_, 0, 0, scr, it - 1024, lane);
              else if (it < 2944) p0_transpose_item(args.in[33], D_, DFF, Wgu_t, D_, 2, 0, scr, it - 1536, lane);
              else if (it < 4352) p0_transpose_item(args.in[34], D_, DFF, Wgu_t, D_, 3, 0, scr, it - 2944, lane);
              else p0_transpose_item(args.in[35], DFF, D_, Wd_t, DFF, 0, 0, scr, it - 4352, lane); } }
        for (int r = gw; r < 4096; r += NGW) { const int kv = r >> 11, row = r & 2047; const bf16_t* h1 = (kv ? H1V : H1K) + (size_t)row * 256; const float* w2 = args.in[kv ? 14 : 11] + lane;
            float s0 = 0.f, s1 = 0.f;
#pragma unroll 8
            for (int j = 0; j < 256; j += 2) { const unsigned hw = *(const unsigned*)(h1 + j); s0 += __builtin_bit_cast(float, hw << 16) * w2[(size_t)j * 64]; s1 += __builtin_bit_cast(float, hw & 0xffff0000u) * w2[(size_t)(j + 1) * 64]; }
            float s = s0 + s1; if ((row & 511) == 511) s = 0.f;
            (KC + (size_t)kv * 131072)[(size_t)row * 64 + lane] = (bf16_t)f2bf(s); }
    }
    SEAM(3);
    if (IN(4)) { PHASE_IDS();
        rwkv_chunk(F, ws);
    }
    SEAM(4);
    if (IN(5)) { PHASE_IDS();
        if (F.blk < 16) rwkv_combine(F, ws, F.blk);
        { pg8::Gemm g{MEMN, Wkv_t, 512, 2 * D_, D_, D_, 128, 0}; pg8::ListOrder S; S.init(512, 2 * D_, 16, F.blk);
          pg8::EpiStore E{KVX, 2 * D_, 1000, nullptr, 0, 0, 0, 1.0f};
          pg8::gemm_phase(F.lds, g, S, E, F.wave); }
        volatile LAS unsigned* uw = (volatile LAS unsigned*)(F.lds + LDS_CTRL + 1024 + 64);
        for (;;) {
            __syncthreads();
            if (tid == 0) uw[0] = xb_add(WSP(unsigned, OFF_CNT), 1u);
            __syncthreads();
            const unsigned u = uw[0];
            if (u >= 512u) break;
            nsa_unit(F, ws, args.in[6], (int)(u & 1u), (int)((u >> 1) & 1u), 127 - (int)(u >> 2));
        }
    }
    SEAM(5);
    if (IN(6)) { PHASE_IDS();
        for (int task = gw; task < 16 * NC * 4; task += NGW) rwkv_fixup_task(ws, args.in[24], args.in[25], args.in[23], task >> 2, task & 3, lane);
    }
    SEAM(6);
    if (IN(7)) { PHASE_IDS();
        pg8::Gemm g{PNSA, Wout_t, M_, D_, D_, PN_LD, 128, 0}; pg8::StaticOrder S; S.init(M_, D_, F.G, F.blk);
        pg8::EpiResidual<false> E{XIN, nullptr, nullptr, XB, args.in[27], SS1};
        pg8::gemm_phase(F.lds, g, S, E, F.wave);
    }
    SEAM(7);
    if (IN(8)) { PHASE_IDS();
        pg8::Gemm g{XB, Wq_t, M_, D_, D_, D_, 128, 0}; pg8::StaticOrder S; S.init(M_, D_, F.G, F.blk);
        pg8::EpiRowScale E{WSP(bf16_t, OFF_Q2), SS1, 0.0625f * LOG2E};
        pg8::gemm_phase(F.lds, g, S, E, F.wave);
        asm volatile("s_waitcnt vmcnt(0)" ::: "memory");
        __syncthreads();
        asm volatile("buffer_inv sc0\n\ts_waitcnt vmcnt(0)" ::: "memory");
    }
    if (IN(9)) { PHASE_IDS();
        const int c = F.blk, pm = 8 * (c & 7) + ((c >> 3) & 7), pn = c >> 6;
        xattn_unit(F, WSP(bf16_t, OFF_Q2), KVX, WSP(bf16_t, OFF_XO), pm >> 5, pn, pm & 31);
    }
    SEAM(9);
    if (IN(10)) { PHASE_IDS();
        pg8::Gemm g{WSP(bf16_t, OFF_XO), Wo_t, M_, D_, D_, D_, 128, 0}; pg8::StaticOrder S; S.init(M_, D_, F.G, F.blk);
        pg8::EpiResidual<true> E{nullptr, XB, args.in[27], XB, args.in[32], SS2};
        pg8::gemm_phase(F.lds, g, S, E, F.wave);
    }
    SEAM(10);
    if (IN(11)) { PHASE_IDS();
        pg8::Gemm g{XB, Wgu_t, M_, 2 * DFF, D_, D_, 128, 0}; pg8::StaticOrder S; S.init(M_, 2 * DFF, F.G, F.blk);
        pg8::EpiSwiglu E{Hb, SS2};
        pg8::gemm_phase(F.lds, g, S, E, F.wave);
    }
    SEAM(11);
    if (IN(12)) { PHASE_IDS();
        pg8::Gemm g{Hb, Wd_t, M_, D_, DFF, DFF, 128, 0}; pg8::StaticOrder S; S.init(M_, D_, F.G, F.blk);
        pg8::EpiFinalNorm E{XB, args.in[32], args.out, args.in[3], SS3, WSP(unsigned, OFF_PCNT)};
        pg8::gemm_phase(F.lds, g, S, E, F.wave);
    }
#undef IN
#undef SEAM
}

extern "C" void kernel_launch(void* const* d_in, const int* in_sizes, int n_in, void* d_out, int out_size, void* d_ws, size_t ws_size, hipStream_t stream) {
    static int grid = 0;
    if (grid == 0) {
        int dev = 0, cus = 0, per_cu = 0;
        (void)hipGetDevice(&dev);
        (void)hipDeviceGetAttribute(&cus, hipDeviceAttributeMultiprocessorCount, dev);
        (void)hipFuncSetAttribute((const void*)hybrid_fwd, hipFuncAttributeMaxDynamicSharedMemorySize, LDS_BYTES);
        (void)hipOccupancyMaxActiveBlocksPerMultiprocessor(&per_cu, (const void*)hybrid_fwd, NTHREADS, LDS_BYTES);
        if (per_cu < 1) { fprintf(stderr, "kernel_launch: occupancy query reports %d blocks per CU\n", per_cu); per_cu = 1; }
        (void)hipGetLastError();
        grid = cus;
        if (n_in != 36 || ws_size < 256 * MiB) fprintf(stderr, "kernel_launch: unexpected n_in %d / ws %zu\n", n_in, ws_size);
    }
    Args a{};
    for (int i = 0; i < 36; ++i) a.in[i] = (const float*)d_in[i];
    a.out = (float*)d_out; a.ws = (unsigned char*)d_ws; a.ph_lo = 0; a.ph_hi = N_PHASES;
    (void)hipMemsetAsync((char*)d_ws + OFF_BAR, 0, 256 * 1024, stream);
    void* kargs[] = {&a};
    hipError_t e = hipLaunchCooperativeKernel((const void*)hybrid_fwd, dim3(grid), dim3(NTHREADS), kargs, LDS_BYTES, stream);
    if (e != hipSuccess) fprintf(stderr, "cooperative launch failed: %s (grid %d)\n", hipGetErrorString(e), grid);
}
```

```cpp
#include <hip/hip_runtime.h>
#include <hip/hip_cooperative_groups.h>
#include <cstdio>
#include <cstdint>
namespace cg = cooperative_groups;

#define LAS __attribute__((address_space(3)))
#define GAS __attribute__((address_space(1)))
typedef unsigned short bf16_t;
typedef short bf16x8 __attribute__((ext_vector_type(8)));
typedef float f32x4 __attribute__((ext_vector_type(4)));
typedef float f32x2 __attribute__((ext_vector_type(2)));
typedef float f32x16 __attribute__((ext_vector_type(16)));
typedef unsigned u32x4 __attribute__((ext_vector_type(4)));
typedef unsigned u32x2 __attribute__((ext_vector_type(2)));

constexpr int NB = 2, T_ = 8192, M_ = NB * T_, D_ = 1024;
constexpr int NSA_COLS = 1304, RW_COLS = 1792, IN_COLS = 3096;
constexpr int PN_LD = 1536, PR_LD = 1792, NIN = 3328;
constexpr int DFF = 2816;
constexpr float RMS_EPS = 1e-6f;
constexpr float LOG2E = 1.4426950408889634f;
constexpr float QK_C = 0.125f * LOG2E;

constexpr size_t MiB = 1u << 20;
constexpr size_t OFF_LUT = 0;
constexpr size_t OFF_LTS = 512 * 1024, OFF_LTW = 640 * 1024;
constexpr size_t OFF_CBK = 64 * 1024, OFF_CBV = 66 * 1024;
constexpr size_t OFF_CBPART = 128 * 1024;
constexpr size_t OFF_SS1 = 1 * MiB, OFF_SS2 = 2 * MiB, OFF_SS3 = 3 * MiB;
constexpr size_t OFF_MEMN = 4 * MiB;
constexpr size_t OFF_KVX = 5 * MiB;
constexpr size_t OFF_KC = 7 * MiB, OFF_VC = 7 * MiB + 256 * 1024;
constexpr size_t OFF_H1K = 8 * MiB, OFF_H1V = 9 * MiB;
constexpr size_t OFF_WIN = 10 * MiB;
constexpr size_t OFF_WKV = 16 * MiB + 512 * 1024;
constexpr size_t OFF_WC1K = 20 * MiB + 512 * 1024, OFF_WC1V = 21 * MiB + 512 * 1024;
constexpr size_t OFF_WLORA = 22 * MiB + 512 * 1024;
constexpr size_t OFF_SUM = 8 * MiB;
constexpr size_t OFF_XN = 40 * MiB;
constexpr size_t OFF_PNSA = 72 * MiB;
constexpr size_t OFF_R1 = 120 * MiB;
constexpr size_t OFF_RW = 176 * MiB;
constexpr size_t OFF_WD = 168 * MiB;
constexpr size_t OFF_Q2 = 72 * MiB;
constexpr size_t OFF_XO = 176 * MiB;
constexpr size_t OFF_H = 72 * MiB;

__device__ __forceinline__ unsigned f2bf(float f) { unsigned u = __builtin_bit_cast(unsigned, f); return (u + 0x7fffu + ((u >> 16) & 1u)) >> 16; }
__device__ __forceinline__ unsigned pk2(float lo, float hi) { return f2bf(lo) | (f2bf(hi) << 16); }
__device__ __forceinline__ float bf2f(unsigned short b) { return __builtin_bit_cast(float, (unsigned)b << 16); }
__device__ __forceinline__ int lane_id() { int l; asm volatile("v_mbcnt_lo_u32_b32 %0, -1, 0\n\tv_mbcnt_hi_u32_b32 %0, -1, %0" : "=v"(l)); return l; }
__device__ __forceinline__ float wave_sum(float v) {
#pragma unroll
    for (int o = 1; o < 64; o <<= 1) v += __shfl_xor(v, o);
    return v;
}

typedef short s16x4 __attribute__((ext_vector_type(4)));
__device__ __forceinline__ int crow(int r, int hi) { return (r & 3) + 8 * (r >> 2) + 4 * hi; }
__device__ __forceinline__ s16x4 vtr(const LAS unsigned char* p) { return __builtin_bit_cast(s16x4, __builtin_amdgcn_ds_read_tr16_b64_v4i16((LAS s16x4*)p)); }

namespace pg8 {
constexpr int BM = 256, BK = 64, HALF = 128, HTB = HALF * BK * 2, STAGE_BYTES = 8 * HTB, NXCD = 8, WGM = 8;
__host__ __device__ __forceinline__ int lds_byte(int r, int c) { const int st = (r >> 4) * 2 + (c >> 5), rr = r & 15, cc = c & 31, ob = rr * 64 + cc * 2; return st * 1024 + (ob ^ (((ob >> 9) & 1) << 5)); }
__host__ __device__ __forceinline__ void stage_rc(int b, int& R, int& C) { const int st = b / 1024, sb = b % 1024, swz = sb ^ (((sb >> 9) & 1) << 5); R = (st >> 1) * 16 + swz / 64; C = (st & 1) * 32 + (swz % 64) / 2; }
__host__ __device__ __forceinline__ int perm32(int rho) { const int n = rho >> 4, i = rho & 15; return 8 * (i >> 2) + 4 * n + (i & 3); }

struct Unit { int pm, pn; };
struct Gemm { const bf16_t* A; const bf16_t* Bt; int M, N, K; int lda; int kstepA; int amode; };
__device__ __forceinline__ const char* a_tile(const Gemm& g, int pm) {
    if (g.amode == 0) return (const char*)g.A + (size_t)pm * BM * g.lda * 2;
    const int bh = pm >> 1, c0 = (pm & 1) * 256;
    return (const char*)g.A + ((size_t)((bh >> 1) * T_ + 16 * c0) * PN_LD + (bh & 1) * 64) * 2;
}

struct StaticOrder {
    int nM, nN, nwg, G, c;
    __device__ void init(int M, int N, int G_, int c_) { nM = M / BM; nN = N / BM; nwg = nM * nN; G = G_; c = c_; }
    __device__ bool next(int i, Unit& u) const {
        const long L = (long)i * G + c; if (L >= nwg || c < 0) return false;
        int wgid = (int)L; { const int q = nwg / NXCD, r = nwg % NXCD, xcd = wgid % NXCD, off = wgid / NXCD; wgid = (xcd < r ? xcd * (q + 1) : r * (q + 1) + (xcd - r) * q) + off; }
        const int nig = WGM * nN, gid = wgid / nig, fm = gid * WGM, gsz = (nM - fm) < WGM ? (nM - fm) : WGM;
        u.pm = fm + ((wgid % nig) % gsz); u.pn = (wgid % nig) / gsz; return true;
    }
};
struct ListOrder {
    int nN, n, j;
    __device__ void init(int M, int N, int first, int blk) { nN = N / BM; n = (M / BM) * nN; j = blk - first; }
    __device__ bool next(int i, Unit& u) const { if (i != 0 || j < 0 || j >= n) return false; u.pm = j / nN; u.pn = j % nN; return true; }
};

__device__ __forceinline__ unsigned cvt_pk_bf16(float lo, float hi) { unsigned r; asm volatile("v_cvt_pk_bf16_f32 %0, %1, %2" : "=v"(r) : "v"(lo), "v"(hi)); return r; }

template <class Epi, class Sched>
__device__ __forceinline__ void gemm_phase(LAS unsigned char* lds, const Gemm g, const Sched& S, const Epi& E, int wave_id) {
    const int wid = wave_id, lane = lane_id(), tid = wid * 64 + lane, wr = wid >> 2, wc = wid & 3, fr = lane & 15, fq = lane >> 4;
    const int K = g.K, nt = K / BK;
    unsigned voffA[2], voffB[2];
#pragma unroll
    for (int i = 0; i < 2; ++i) { int R, C; stage_rc(tid * 16 + i * 8192, R, C); const int Rb = (R & ~31) + perm32(R & 31);
        voffA[i] = (unsigned)(R * g.lda + C) * 2u; voffB[i] = (unsigned)(Rb * K + C) * 2u; }
    const size_t kstepA = (size_t)g.kstepA, kstepB = (size_t)(BK * 2);
    const size_t hstepA = (size_t)HALF * g.lda * 2, hstepB = (size_t)HALF * K * 2;
    const unsigned ldsw = (unsigned)wid * 1024u;
    const int aoff = lds_byte(wr * 64 + fr, fq * 8), boff = lds_byte(wc * 32 + fr, fq * 8);
#define PG8_SA(b, h) (((b) * 2 + (h)) * HTB)
#define PG8_SB(b, h) ((4 + (b) * 2 + (h)) * HTB)
#define PG8_STAGE(bufoff, gbase, voff) do { _Pragma("unroll") for (int _i = 0; _i < 2; ++_i) \
        __builtin_amdgcn_global_load_lds((const unsigned*)((const char*)(gbase) + (voff)[_i]), (LAS unsigned*)(lds + (bufoff) + ldsw + _i * 8192), 16, 0, 0); } while (0)
#define PG8_LDA(dst, b, h) do { _Pragma("unroll") for (int m = 0; m < 4; ++m) _Pragma("unroll") for (int k = 0; k < 2; ++k) dst[m][k] = *(const LAS bf16x8*)(lds + PG8_SA(b, h) + aoff + m * 2048 + k * 1024); } while (0)
#define PG8_LDB(dst, b, h) do { _Pragma("unroll") for (int n = 0; n < 2; ++n) _Pragma("unroll") for (int k = 0; k < 2; ++k) dst[n][k] = *(const LAS bf16x8*)(lds + PG8_SB(b, h) + boff + n * 2048 + k * 1024); } while (0)
#define PG8_MMA(ai, bj, At, Bt) do { __builtin_amdgcn_s_setprio(1); _Pragma("unroll") for (int m = 0; m < 4; ++m) _Pragma("unroll") for (int n = 0; n < 2; ++n) _Pragma("unroll") for (int k = 0; k < 2; ++k) \
        acc[ai][bj][m][n] = __builtin_amdgcn_mfma_f32_16x16x32_bf16(Bt[n][k], At[m][k], acc[ai][bj][m][n], 0, 0, 0); __builtin_amdgcn_s_setprio(0); } while (0)
#define PG8_WAIT_V(n) asm volatile("s_waitcnt vmcnt(" #n ")" ::: "memory")
#define PG8_WAIT_L(n) asm volatile("s_waitcnt lgkmcnt(" #n ")" ::: "memory")
#define PG8_BAR __builtin_amdgcn_s_barrier()
#define PG8_SCHED __builtin_amdgcn_sched_barrier(0)
    Unit cur, nxt; int ui = 0;
    if (!S.next(0, cur)) return;
    f32x4 acc[2][2][4][2];
#pragma unroll
    for (int a = 0; a < 2; ++a)
#pragma unroll
        for (int b = 0; b < 2; ++b)
#pragma unroll
            for (int m = 0; m < 4; ++m)
#pragma unroll
                for (int n = 0; n < 2; ++n) acc[a][b][m][n] = (f32x4){0.f, 0.f, 0.f, 0.f};
    bf16x8 At[4][2], B0[2][2], B1[2][2];
    const char* cA = a_tile(g, cur.pm); const char* cB = (const char*)g.Bt + (size_t)cur.pn * 2 * hstepB;
    PG8_STAGE(PG8_SB(0, 0), cB, voffB); PG8_STAGE(PG8_SB(0, 1), cB + hstepB, voffB); PG8_STAGE(PG8_SA(0, 0), cA, voffA); PG8_STAGE(PG8_SA(0, 1), cA + hstepA, voffA);
    if (wr == 1) PG8_BAR;
    PG8_WAIT_V(2); PG8_BAR;
    PG8_STAGE(PG8_SB(1, 0), cB + kstepB, voffB); PG8_STAGE(PG8_SA(1, 0), cA + kstepA, voffA); PG8_STAGE(PG8_SB(1, 1), cB + hstepB + kstepB, voffB);
    PG8_WAIT_V(6); PG8_BAR;
    for (;;) {
        const bool has_next = S.next(ui + 1, nxt);
        const char* nA = has_next ? a_tile(g, nxt.pm) : cA; const char* nB = has_next ? (const char*)g.Bt + (size_t)nxt.pn * 2 * hstepB : cB;
        for (int t = 0; t < nt; t += 2) {
            const bool last = (t == nt - 2);
            const char* a1 = cA + (size_t)(t + 1) * kstepA;
            const char* a2 = last ? nA : cA + (size_t)(t + 2) * kstepA; const char* b2 = last ? nB : cB + (size_t)(t + 2) * kstepB;
            const char* a3 = a2 + kstepA; const char* b3 = b2 + kstepB;
            PG8_LDB(B0, 0, 0); PG8_LDB(B1, 0, 1); PG8_SCHED; PG8_LDA(At, 0, 0); PG8_STAGE(PG8_SA(1, 1), a1 + hstepA, voffA);
            PG8_WAIT_V(8); PG8_WAIT_L(0); PG8_BAR; PG8_MMA(0, 0, At, B0); PG8_MMA(0, 1, At, B1); PG8_BAR; PG8_SCHED;
            PG8_LDA(At, 0, 1); PG8_STAGE(PG8_SB(0, 0), b2, voffB); PG8_STAGE(PG8_SB(0, 1), b2 + hstepB, voffB); PG8_STAGE(PG8_SA(0, 0), a2, voffA);
            PG8_WAIT_V(8); PG8_WAIT_L(0); PG8_BAR; PG8_MMA(1, 0, At, B0); PG8_MMA(1, 1, At, B1); PG8_BAR; PG8_SCHED;
            PG8_LDB(B0, 1, 0); PG8_LDB(B1, 1, 1); PG8_SCHED; PG8_LDA(At, 1, 0); PG8_STAGE(PG8_SA(0, 1), a2 + hstepA, voffA);
            PG8_WAIT_V(8); PG8_WAIT_L(0); PG8_BAR; PG8_MMA(0, 0, At, B0); PG8_MMA(0, 1, At, B1); PG8_BAR; PG8_SCHED;
            PG8_LDA(At, 1, 1); PG8_STAGE(PG8_SB(1, 0), b3, voffB); PG8_STAGE(PG8_SB(1, 1), b3 + hstepB, voffB); PG8_STAGE(PG8_SA(1, 0), a3, voffA);
            PG8_WAIT_V(8); PG8_WAIT_L(0); PG8_BAR; PG8_MMA(1, 0, At, B0); PG8_MMA(1, 1, At, B1); PG8_BAR; PG8_SCHED;
        }
        if (wr == 0) PG8_BAR;
        if constexpr (!Epi::AFTER_DRAIN) E(acc, cur, wr, wc, fr, fq);
        if (!has_next) break;
#pragma unroll
        for (int a = 0; a < 2; ++a)
#pragma unroll
            for (int b = 0; b < 2; ++b)
#pragma unroll
                for (int m = 0; m < 4; ++m)
#pragma unroll
                    for (int n = 0; n < 2; ++n) acc[a][b][m][n] = (f32x4){0.f, 0.f, 0.f, 0.f};
        cur = nxt; cA = nA; cB = nB; ++ui;
        if (wr == 1) PG8_BAR;
    }
    PG8_WAIT_V(0);
    PG8_BAR;
    if constexpr (Epi::AFTER_DRAIN) E.fused(acc, cur, wr, wc, fr, fq, lds, wid, lane);
#undef PG8_SA
#undef PG8_SB
#undef PG8_STAGE
#undef PG8_LDA
#undef PG8_LDB
#undef PG8_MMA
#undef PG8_WAIT_V
#undef PG8_WAIT_L
#undef PG8_BAR
#undef PG8_SCHED
}

typedef f32x4 Acc[2][2][4][2];
__device__ __forceinline__ float row_rs(const float* SS, int row) {
    const f32x4* p = (const f32x4*)(SS + (size_t)row * 16);
    const f32x4 a = p[0], b = p[1], c = p[2], d = p[3];
    const float s = ((a[0] + a[1]) + (a[2] + a[3])) + ((b[0] + b[1]) + (b[2] + b[3])) + ((c[0] + c[1]) + (c[2] + c[3])) + ((d[0] + d[1]) + (d[2] + d[3]));
    return __builtin_amdgcn_rsqf(s * (1.0f / D_) + RMS_EPS);
}
struct EpiStore {
    static constexpr bool AFTER_DRAIN = false;
    bf16_t* O0; int ld0; int npn0; bf16_t* O1; int ld1; int sc_lo, sc_hi; float scale;
    __device__ __forceinline__ void operator()(const Acc& acc, const Unit& u, int wr, int wc, int fr, int fq) const {
        bf16_t* base; int ld, colt;
        if (u.pn < npn0) { base = O0; ld = ld0; colt = u.pn * BM; } else { base = O1; ld = ld1; colt = (u.pn - npn0) * BM; }
        const int row0 = u.pm * BM + wr * 64 + fr, col0 = colt + wc * 32 + 8 * fq; const float sc = (u.pn >= sc_lo && u.pn < sc_hi) ? scale : 1.0f;
#pragma unroll
        for (int ai = 0; ai < 2; ++ai)
#pragma unroll
            for (int m = 0; m < 4; ++m) { bf16_t* rowp = base + (size_t)(row0 + ai * HALF + m * 16) * ld + col0;
#pragma unroll
                for (int bj = 0; bj < 2; ++bj) { const f32x4 v0 = acc[ai][bj][m][0] * sc, v1 = acc[ai][bj][m][1] * sc;
                    u32x4 w; w.x = cvt_pk_bf16(v0[0], v0[1]); w.y = cvt_pk_bf16(v0[2], v0[3]); w.z = cvt_pk_bf16(v1[0], v1[1]); w.w = cvt_pk_bf16(v1[2], v1[3]);
                    *(u32x4*)(rowp + bj * HALF) = w; } }
    }
};
__device__ __forceinline__ void load_base8(const float* basef, const bf16_t* baseb, const f32x4& gi0, const f32x4& gi1, bool base_xb, size_t off, f32x4& b0, f32x4& b1) {
    if (!base_xb) { b0 = *(const f32x4*)(basef + off); b1 = *(const f32x4*)(basef + off + 4); }
    else { const u32x4 w = *(const u32x4*)(baseb + off);
        b0 = (f32x4){__builtin_bit_cast(float, w.x << 16), __builtin_bit_cast(float, w.x & 0xffff0000u), __builtin_bit_cast(float, w.y << 16), __builtin_bit_cast(float, w.y & 0xffff0000u)} * gi0;
        b1 = (f32x4){__builtin_bit_cast(float, w.z << 16), __builtin_bit_cast(float, w.z & 0xffff0000u), __builtin_bit_cast(float, w.w << 16), __builtin_bit_cast(float, w.w & 0xffff0000u)} * gi1; }
}
__device__ __forceinline__ f32x4 rcp4(const f32x4 v) { return (f32x4){__builtin_amdgcn_rcpf(v[0]), __builtin_amdgcn_rcpf(v[1]), __builtin_amdgcn_rcpf(v[2]), __builtin_amdgcn_rcpf(v[3])}; }
template <bool BASE_XB> struct EpiResidual {
    static constexpr bool AFTER_DRAIN = false;
    const float* basef; const bf16_t* baseb; const float* gin; bf16_t* XB; const float* gout; float* SS;
    __device__ __forceinline__ void operator()(const Acc& acc, const Unit& u, int wr, int wc, int fr, int fq) const {
        const int row0 = u.pm * BM + wr * 64 + fr, col0 = u.pn * BM + wc * 32 + 8 * fq;
        f32x4 gv[2][2], gi[2][2];
#pragma unroll
        for (int bj = 0; bj < 2; ++bj)
#pragma unroll
            for (int n = 0; n < 2; ++n) { gv[bj][n] = *(const f32x4*)(gout + col0 + bj * HALF + 4 * n); gi[bj][n] = BASE_XB ? rcp4(*(const f32x4*)(gin + col0 + bj * HALF + 4 * n)) : gv[bj][n]; }
#pragma unroll
        for (int ai = 0; ai < 2; ++ai)
#pragma unroll
            for (int m = 0; m < 4; ++m) { const int row = row0 + ai * HALF + m * 16; const size_t off = (size_t)row * D_ + col0; float ss = 0.f;
#pragma unroll
                for (int bj = 0; bj < 2; ++bj) {
                    f32x4 b0, b1; load_base8(basef, baseb, gi[bj][0], gi[bj][1], BASE_XB, off + bj * HALF, b0, b1);
                    const f32x4 x0 = b0 + acc[ai][bj][m][0], x1 = b1 + acc[ai][bj][m][1];
                    ss += (x0[0] * x0[0] + x0[1] * x0[1]) + (x0[2] * x0[2] + x0[3] * x0[3]) + (x1[0] * x1[0] + x1[1] * x1[1]) + (x1[2] * x1[2] + x1[3] * x1[3]);
                    const f32x4 y0 = x0 * gv[bj][0], y1 = x1 * gv[bj][1];
                    u32x4 w; w.x = cvt_pk_bf16(y0[0], y0[1]); w.y = cvt_pk_bf16(y0[2], y0[3]); w.z = cvt_pk_bf16(y1[0], y1[1]); w.w = cvt_pk_bf16(y1[2], y1[3]);
                    *(u32x4*)(XB + off + bj * HALF) = w;
                }
                ss += __shfl_xor(ss, 16); ss += __shfl_xor(ss, 32);
                if (fq == 0) SS[(size_t)row * 16 + u.pn * 4 + wc] = ss;
            }
    }
};
struct EpiSwiglu {
    static constexpr bool AFTER_DRAIN = false;
    bf16_t* H; const float* SS;
    __device__ __forceinline__ void operator()(const Acc& acc, const Unit& u, int wr, int wc, int fr, int fq) const {
        const int row0 = u.pm * BM + wr * 64 + fr, col0 = u.pn * HALF + wc * 32 + 8 * fq;
#pragma unroll
        for (int ai = 0; ai < 2; ++ai)
#pragma unroll
            for (int m = 0; m < 4; ++m) { const int row = row0 + ai * HALF + m * 16; const float rs = row_rs(SS, row);
                float h[8];
#pragma unroll
                for (int n = 0; n < 2; ++n)
#pragma unroll
                    for (int j = 0; j < 4; ++j) { const float gt = acc[ai][0][m][n][j] * rs, up = acc[ai][1][m][n][j] * rs;
                        h[4 * n + j] = gt * __builtin_amdgcn_rcpf(1.0f + __builtin_amdgcn_exp2f(-gt * LOG2E)) * up; }
                u32x4 w; w.x = cvt_pk_bf16(h[0], h[1]); w.y = cvt_pk_bf16(h[2], h[3]); w.z = cvt_pk_bf16(h[4], h[5]); w.w = cvt_pk_bf16(h[6], h[7]);
                *(u32x4*)(H + (size_t)row * DFF + col0) = w; }
    }
};

struct EpiLora {
    static constexpr bool AFTER_DRAIN = false;
    float* W; bf16_t* Kp; const bf16_t* KK; bf16_t* Bv; bf16_t* G; const float* w0; const float* a0; const float* k_a;
    __device__ __forceinline__ void operator()(const Acc& acc, const Unit& u, int wr, int wc, int fr, int fq) const {
        const int region = u.pn >> 1, row0 = u.pm * BM + wr * 64 + fr, c0 = (u.pn & 1) * 256 + wc * 32 + 8 * fq;
#pragma unroll
        for (int ai = 0; ai < 2; ++ai)
#pragma unroll
            for (int m = 0; m < 4; ++m) { const int row = row0 + ai * HALF + m * 16;
#pragma unroll
                for (int bj = 0; bj < 2; ++bj) { const int c = c0 + bj * HALF; const size_t off = (size_t)row * 512 + c;
                    float v[8];
#pragma unroll
                    for (int i = 0; i < 8; ++i) v[i] = acc[ai][bj][m][i >> 2][i & 3];
                    if (region == 0) {
                        float o[8];
#pragma unroll
                        for (int i = 0; i < 8; ++i) { const float z = v[i] + w0[c + i]; const float sg = __builtin_amdgcn_rcpf(1.0f + __expf(-z)); o[i] = -0.6065306597126334f * sg; }
                        *(f32x4*)(W + off) = (f32x4){o[0], o[1], o[2], o[3]}; *(f32x4*)(W + off + 4) = (f32x4){o[4], o[5], o[6], o[7]};
                    } else if (region == 1) {
                        const u32x4 k8 = *(const u32x4*)(Kp + off), q8 = *(const u32x4*)(KK + off);
                        float kn[8], bn[8];
#pragma unroll
                        for (int i = 0; i < 8; ++i) { const float a = __builtin_amdgcn_rcpf(1.0f + __expf(-(v[i] + a0[c + i])));
                            const unsigned kw = k8[i >> 1], qw = q8[i >> 1];
                            const float kf = __builtin_bit_cast(float, (i & 1) ? (kw & 0xffff0000u) : (kw << 16)), qf = __builtin_bit_cast(float, (i & 1) ? (qw & 0xffff0000u) : (qw << 16));
                            kn[i] = kf * (1.0f + (a - 1.0f) * k_a[c + i]); bn[i] = qf * a; }
                        u32x4 w; w.x = cvt_pk_bf16(kn[0], kn[1]); w.y = cvt_pk_bf16(kn[2], kn[3]); w.z = cvt_pk_bf16(kn[4], kn[5]); w.w = cvt_pk_bf16(kn[6], kn[7]);
                        *(u32x4*)(Kp + off) = w;
                        w.x = cvt_pk_bf16(bn[0], bn[1]); w.y = cvt_pk_bf16(bn[2], bn[3]); w.z = cvt_pk_bf16(bn[4], bn[5]); w.w = cvt_pk_bf16(bn[6], bn[7]);
                        *(u32x4*)(Bv + off) = w;
                    } else {
                        u32x4 w; w.x = cvt_pk_bf16(v[0], v[1]); w.y = cvt_pk_bf16(v[2], v[3]); w.z = cvt_pk_bf16(v[4], v[5]); w.w = cvt_pk_bf16(v[6], v[7]);
                        *(u32x4*)(G + off) = w;
                    }
                } }
    }
};
struct EpiGelu {
    static constexpr bool AFTER_DRAIN = false;
    bf16_t* O; const float* cb;
    __device__ __forceinline__ void operator()(const Acc& acc, const Unit& u, int wr, int wc, int fr, int fq) const {
        const int row0 = u.pm * BM + wr * 64 + fr, col0 = u.pn * BM + wc * 32 + 8 * fq;
#pragma unroll
        for (int ai = 0; ai < 2; ++ai)
#pragma unroll
            for (int m = 0; m < 4; ++m) { const int row = row0 + ai * HALF + m * 16;
#pragma unroll
                for (int bj = 0; bj < 2; ++bj) { const int c = col0 + bj * HALF; float o[8];
#pragma unroll
                    for (int i = 0; i < 8; ++i) { const float z = acc[ai][bj][m][i >> 2][i & 3] + cb[c + i];
                        const float t = 0.7978845608028654f * (z + 0.044715f * z * z * z);
                        const float th = 1.0f - 2.0f * __builtin_amdgcn_rcpf(1.0f + __expf(2.0f * t));
                        o[i] = 0.5f * z * (1.0f + th); }
                    u32x4 w; w.x = cvt_pk_bf16(o[0], o[1]); w.y = cvt_pk_bf16(o[2], o[3]); w.z = cvt_pk_bf16(o[4], o[5]); w.w = cvt_pk_bf16(o[6], o[7]);
                    *(u32x4*)(O + (size_t)row * 256 + c) = w; } }
    }
};

struct EpiRowScale {
    static constexpr bool AFTER_DRAIN = false;
    bf16_t* O; const float* SS; float qscale;
    __device__ __forceinline__ void operator()(const Acc& acc, const Unit& u, int wr, int wc, int fr, int fq) const {
        const int row0 = u.pm * BM + wr * 64 + fr, col0 = u.pn * BM + wc * 32 + 8 * fq;
#pragma unroll
        for (int ai = 0; ai < 2; ++ai)
#pragma unroll
            for (int m = 0; m < 4; ++m) { const int row = row0 + ai * HALF + m * 16; const float rs = row_rs(SS, row) * qscale;
#pragma unroll
                for (int bj = 0; bj < 2; ++bj) { const f32x4 v0 = acc[ai][bj][m][0] * rs, v1 = acc[ai][bj][m][1] * rs;
                    u32x4 w; w.x = cvt_pk_bf16(v0[0], v0[1]); w.y = cvt_pk_bf16(v0[2], v0[3]); w.z = cvt_pk_bf16(v1[0], v1[1]); w.w = cvt_pk_bf16(v1[2], v1[3]);
                    *(u32x4*)(O + (size_t)row * D_ + col0 + bj * HALF) = w; } }
    }
};
struct EpiFinalNorm {
    static constexpr bool AFTER_DRAIN = true;
    const bf16_t* baseb; const float* gin; float* out; const float* gain; float* xs; unsigned* cnt;
    __device__ __forceinline__ void fused(Acc& acc, const Unit& u, int wr, int wc, int fr, int fq, LAS unsigned char* lds, int wid, int lane) const {
        LAS float* P = (LAS float*)lds;
        LAS float* S = (LAS float*)(lds + 4096);
        const int row0 = u.pm * BM + wr * 64 + fr, col0 = u.pn * BM + wc * 32 + 8 * fq;
#pragma unroll
        for (int ai = 0; ai < 2; ++ai)
#pragma unroll
            for (int m = 0; m < 4; ++m) { const size_t off = (size_t)(row0 + ai * HALF + m * 16) * D_ + col0; float ss = 0.f;
#pragma unroll
                for (int bj = 0; bj < 2; ++bj) { f32x4 b0, b1; load_base8(nullptr, baseb, rcp4(*(const f32x4*)(gin + col0 + bj * HALF)), rcp4(*(const f32x4*)(gin + col0 + bj * HALF + 4)), true, off + bj * HALF, b0, b1);
                    const f32x4 x0 = b0 + acc[ai][bj][m][0], x1 = b1 + acc[ai][bj][m][1];
                    acc[ai][bj][m][0] = x0; acc[ai][bj][m][1] = x1;
                    ss += (x0[0] * x0[0] + x0[1] * x0[1]) + (x0[2] * x0[2] + x0[3] * x0[3]) + (x1[0] * x1[0] + x1[1] * x1[1]) + (x1[2] * x1[2] + x1[3] * x1[3]); }
                ss += __shfl_xor(ss, 16); ss += __shfl_xor(ss, 32);
                if (fq == 0) P[(ai * HALF + wr * 64 + m * 16 + fr) * 4 + wc] = ss; }
        asm volatile("s_waitcnt lgkmcnt(0)" ::: "memory"); __builtin_amdgcn_s_barrier(); asm volatile("" ::: "memory");
        const int row = wid * 32 + (lane & 31);
        if (lane < 32) { const f32x4 pp = *(const LAS f32x4*)(P + row * 4);
            __hip_atomic_store(xs + (size_t)(u.pm * BM + row) * 4 + u.pn, (pp[0] + pp[1]) + (pp[2] + pp[3]), __ATOMIC_RELAXED, __HIP_MEMORY_SCOPE_AGENT); }
        asm volatile("s_waitcnt vmcnt(0)" ::: "memory");
        if (lane == 0) __hip_atomic_fetch_add(cnt + 64 * u.pm, 1u, __ATOMIC_RELAXED, __HIP_MEMORY_SCOPE_AGENT);
        if (wid == 0) { unsigned sp = 0;
            while ((unsigned)__builtin_amdgcn_readfirstlane(__hip_atomic_load(cnt + 64 * u.pm, __ATOMIC_RELAXED, __HIP_MEMORY_SCOPE_AGENT)) < 32u) { __builtin_amdgcn_s_sleep(2); if (++sp > (1u << 22)) break; }
            __builtin_amdgcn_fence(__ATOMIC_ACQUIRE, "agent"); }
        asm volatile("s_waitcnt vmcnt(0) lgkmcnt(0)" ::: "memory"); __builtin_amdgcn_s_barrier(); asm volatile("" ::: "memory");
        if (lane < 32) { const float* sl = xs + (size_t)(u.pm * BM + row) * 4; float t = 0.f;
#pragma unroll
            for (int k = 0; k < 4; ++k) t += __hip_atomic_load(sl + k, __ATOMIC_RELAXED, __HIP_MEMORY_SCOPE_AGENT);
            S[row] = __builtin_amdgcn_rsqf(t * (1.0f / D_) + RMS_EPS); }
        asm volatile("s_waitcnt lgkmcnt(0)" ::: "memory"); __builtin_amdgcn_s_barrier(); asm volatile("" ::: "memory");
        f32x4 gv[2][2];
#pragma unroll
        for (int bj = 0; bj < 2; ++bj)
#pragma unroll
            for (int n = 0; n < 2; ++n) gv[bj][n] = *(const f32x4*)(gain + col0 + bj * HALF + 4 * n);
#pragma unroll
        for (int ai = 0; ai < 2; ++ai)
#pragma unroll
            for (int m = 0; m < 4; ++m) { const int r = ai * HALF + wr * 64 + m * 16 + fr; const float rs = S[r]; const size_t off = (size_t)(u.pm * BM + r) * D_ + col0;
#pragma unroll
                for (int bj = 0; bj < 2; ++bj) { *(f32x4*)(out + off + bj * HALF) = acc[ai][bj][m][0] * rs * gv[bj][0]; *(f32x4*)(out + off + bj * HALF + 4) = acc[ai][bj][m][1] * rs * gv[bj][1]; } }
    }
};
}

constexpr int NWAVES = 8, NTHREADS = NWAVES * 64;
constexpr int RING_BYTES = 131072, LDS_CTRL = 147456, LDS_BYTES = 151552;
constexpr int N_PHASES = 14;
constexpr int CL = 128, NC = T_ / CL;
constexpr int TS = 8;
constexpr float LNX_EPS = 64e-5f;
constexpr size_t OFF_W = 120 * MiB, OFF_G = 152 * MiB;
constexpr size_t OFF_R = 176 * MiB, OFF_V = 192 * MiB, OFF_KK = 208 * MiB, OFF_KP = 224 * MiB, OFF_B = 240 * MiB;
constexpr size_t OFF_LORA_A = 24 * MiB, OFF_Y = 40 * MiB, OFF_PT = 56 * MiB;

struct Args { const float* in[36]; float* out; unsigned char* ws; int ph_lo, ph_hi; };

struct Frame {
    LAS unsigned char* lds;
    int wave, G, blk;
};

__device__ __forceinline__ int dst_row(int mode, int row_off, int n) {
    if (mode == 0) return row_off + n;
    if (mode == 1) return n < NSA_COLS ? RW_COLS + n : n - NSA_COLS;
    if (mode == 2) return 256 * (n >> 7) + (n & 127);
    return 256 * (n >> 7) + 128 + (n & 127);
}
__device__ __forceinline__ void p0_transpose_item(const float* W, int K, int N, bf16_t* WT, int ldt, int mode, int row_off, LAS float* scr, int item, int lane) {
    const int nblk = (N + 31) / 32, kb = item / nblk, nb = item % nblk, k0 = 64 * kb, n0 = 32 * nb;
    const int nq = n0 + 4 * (lane & 7); f32x4 ld[8];
#pragma unroll
    for (int i = 0; i < 8; ++i) ld[i] = nq < N ? *(const f32x4*)(W + (size_t)(k0 + 8 * i + (lane >> 3)) * N + nq) : (f32x4){0.f, 0.f, 0.f, 0.f};
#pragma unroll
    for (int i = 0; i < 8; ++i) { LAS float* d = scr + (8 * i + (lane >> 3)) * 33 + 4 * (lane & 7); d[0] = ld[i][0]; d[1] = ld[i][1]; d[2] = ld[i][2]; d[3] = ld[i][3]; }
    asm volatile("s_waitcnt lgkmcnt(0)" ::: "memory");
    const int c = lane & 7;
#pragma unroll
    for (int j = 0; j < 4; ++j) { const int n = (lane >> 3) + 8 * j; const LAS float* s = scr + (8 * c) * 33 + n;
        u32x4 o; o.x = pk2(s[0 * 33], s[1 * 33]); o.y = pk2(s[2 * 33], s[3 * 33]); o.z = pk2(s[4 * 33], s[5 * 33]); o.w = pk2(s[6 * 33], s[7 * 33]);
        if (n0 + n < N) *(u32x4*)(WT + (size_t)dst_row(mode, row_off, n0 + n) * ldt + k0 + 8 * c) = o; }
    asm volatile("s_waitcnt lgkmcnt(0)" ::: "memory");
}
__device__ __forceinline__ void rms_row_to_bf16(const float* xrow, const float* gain, bf16_t* orow, int lane) {
    const f32x4* xr = (const f32x4*)xrow + lane; f32x4 v[4]; float s = 0.f;
#pragma unroll
    for (int j = 0; j < 4; ++j) { v[j] = xr[64 * j]; s += (v[j][0] * v[j][0] + v[j][1] * v[j][1]) + (v[j][2] * v[j][2] + v[j][3] * v[j][3]); }
    const float rs = __builtin_amdgcn_rsqf(wave_sum(s) * (1.0f / D_) + RMS_EPS);
#pragma unroll
    for (int j = 0; j < 4; ++j) { const f32x4 g4 = *((const f32x4*)gain + lane + 64 * j); const f32x4 y = v[j] * rs * g4;
        u32x2 w; w.x = pk2(y[0], y[1]); w.y = pk2(y[2], y[3]); *((u32x2*)orow + lane + 64 * j) = w; }
}
__device__ __forceinline__ void unpack8(const u32x4 w, float* f) {
#pragma unroll
    for (int i = 0; i < 4; ++i) { f[2 * i] = __builtin_bit_cast(float, w[i] << 16); f[2 * i + 1] = __builtin_bit_cast(float, w[i] & 0xffff0000u); }
}
__device__ __forceinline__ u32x4 pack8(const float* f) { u32x4 w; w.x = pk2(f[0], f[1]); w.y = pk2(f[2], f[3]); w.z = pk2(f[4], f[5]); w.w = pk2(f[6], f[7]); return w; }

constexpr int RC_PITCH = 144, RC_SLOT = 9216, RC_GROUP = 8 * RC_SLOT;
__device__ __forceinline__ bf16x8 frag_nat(const LAS unsigned char* m, int kb, int col0, int lane) {
    const LAS unsigned char* p = m + (kb + 8 * (lane >> 5) + ((lane & 15) >> 2)) * RC_PITCH + (col0 + 16 * ((lane >> 4) & 1) + 4 * (lane & 3)) * 2;
    const s16x4 lo = vtr(p), hh = vtr(p + 4 * RC_PITCH);
    return (bf16x8){lo[0], lo[1], lo[2], lo[3], hh[0], hh[1], hh[2], hh[3]};
}
__device__ __forceinline__ bf16x8 frag_dir(const LAS unsigned char* m, int row0, int kb, int lane) {
    return *(const LAS bf16x8*)(m + (row0 + (lane & 31)) * RC_PITCH + (kb + 8 * (lane >> 5)) * 2);
}
template <bool TA, bool TB>
__device__ __forceinline__ f32x16 rc_mm(const LAS unsigned char* A, const LAS unsigned char* B, int i0, int j0, f32x16 acc, int lane) {
#pragma unroll
    for (int ks = 0; ks < 4; ++ks) { const bf16x8 a = TA ? frag_nat(A, 16 * ks, i0, lane) : frag_dir(A, i0, 16 * ks, lane), b = TB ? frag_nat(B, 16 * ks, j0, lane) : frag_dir(B, j0, 16 * ks, lane);
        acc = __builtin_amdgcn_mfma_f32_32x32x16_bf16(a, b, acc, 0, 0, 0); }
    return acc;
}
template <bool TA, bool TB>
__device__ __forceinline__ f32x16 rc_mm_k(const LAS unsigned char* A, const LAS unsigned char* B, int i0, int j0, int ks0, f32x16 acc, int lane) {
#pragma unroll
    for (int kk = 0; kk < 2; ++kk) { const int ks = ks0 + kk; const bf16x8 a = TA ? frag_nat(A, 16 * ks, i0, lane) : frag_dir(A, i0, 16 * ks, lane), b = TB ? frag_nat(B, 16 * ks, j0, lane) : frag_dir(B, j0, 16 * ks, lane);
        acc = __builtin_amdgcn_mfma_f32_32x32x16_bf16(a, b, acc, 0, 0, 0); }
    return acc;
}
__device__ __forceinline__ void rc_store(LAS unsigned char* m, int i0, int j0, const f32x16& acc, int lane) {
    const int r32 = lane & 31, hi = lane >> 5;
#pragma unroll
    for (int r = 0; r < 16; ++r) *(LAS bf16_t*)(m + (i0 + crow(r, hi)) * RC_PITCH + (j0 + r32) * 2) = (bf16_t)f2bf(acc[r]);
}
#define RC_BAR() asm volatile("s_waitcnt lgkmcnt(0)\n\ts_barrier" ::: "memory")

__device__ __forceinline__ void rwkv_chunk(Frame& F, unsigned char* ws) {
    const float* LW = (const float*)(ws + OFF_W);
    const bf16_t* R = (const bf16_t*)(ws + OFF_R); const bf16_t* V = (const bf16_t*)(ws + OFF_V); const bf16_t* KK = (const bf16_t*)(ws + OFF_KK);
    const bf16_t* KP = (const bf16_t*)(ws + OFF_KP); const bf16_t* Bv = (const bf16_t*)(ws + OFF_B);
    bf16_t* Y = (bf16_t*)(ws + OFF_Y); bf16_t* PT = (bf16_t*)(ws + OFF_PT); float* SUM = (float*)(ws + OFF_SUM);
    const int lane0 = lane_id(), wave = F.wave;
    const int grp = wave >> 2, tw = wave & 3, i0 = (tw >> 1) * 32, j0 = (tw & 1) * 32;
    int wv_ = wave; asm volatile("" : "+v"(wv_));
    LAS unsigned char* gb = F.lds + (wv_ >> 2) * RC_GROUP;
#define SLOT(i) (gb + (i) * RC_SLOT)
    LAS float* gCl = (LAS float*)(F.lds + LDS_CTRL) + grp * 64;
    LAS float* clf = (LAS float*)SLOT(4);
    for (int hq = 0; hq < 4; ++hq) {
        int lane = lane0; asm volatile("" : "+v"(lane));
        const int r32 = lane & 31, hi = lane >> 5, gtid = tw * 64 + lane;
        const int hc = 4 * F.blk + hq, bh = hc / NC, c = hc % NC, h = bh & 7;
        const size_t m0 = (size_t)(bh >> 3) * T_ + (size_t)c * CL + 64 * grp;
        RC_BAR();
#pragma unroll
        for (int i = 0; i < 4; ++i) { const int t = (gtid >> 4) + 16 * i, c4 = (gtid & 15) * 4; *(LAS f32x4*)(clf + t * 64 + c4) = *(const f32x4*)(LW + (m0 + t) * 512 + h * 64 + c4); }
        RC_BAR();
        if (tw == 0) { float carry = 0.f;
#pragma unroll 1
            for (int hb = 0; hb < 64; hb += 32) { float cv[32];
#pragma unroll
                for (int t = 0; t < 32; ++t) cv[t] = clf[(hb + t) * 64 + lane];
                cv[0] += carry;
#pragma unroll
                for (int t = 1; t < 32; ++t) cv[t] += cv[t - 1];
#pragma unroll
                for (int t = 0; t < 32; ++t) clf[(hb + t) * 64 + lane] = cv[t];
                carry = cv[31]; }
            int z_ = 0; asm volatile("" : "+v"(z_));
            ((LAS float*)(F.lds + LDS_CTRL + z_) + grp * 64)[lane] = __expf(carry); }
        RC_BAR();
        { const int t = gtid >> 2, c0 = (gtid & 3) * 16; const size_t go = (m0 + t) * 512 + h * 64 + c0;
#pragma unroll
          for (int hf = 0; hf < 2; ++hf) { const int cc = c0 + 8 * hf;
              float fk[8], fb[8], fp[8], fr[8]; unpack8(*(const u32x4*)(KK + go + 8 * hf), fk); unpack8(*(const u32x4*)(Bv + go + 8 * hf), fb); unpack8(*(const u32x4*)(KP + go + 8 * hf), fp); unpack8(*(const u32x4*)(R + go + 8 * hf), fr);
              float oa[8], ob[8], ok[8], orr[8];
#pragma unroll
              for (int e = 0; e < 8; ++e) { const float cl = clf[t * 64 + cc + e], clm = t ? clf[(t - 1) * 64 + cc + e] : 0.f;
                  const float ep = __expf(cl), en = __builtin_amdgcn_rcpf(ep);
                  oa[e] = -fk[e] * __expf(clm); ob[e] = fb[e] * en; ok[e] = fp[e] * en; orr[e] = fr[e] * ep; }
              *(LAS u32x4*)(SLOT(0) + t * RC_PITCH + cc * 2) = pack8(oa); *(LAS u32x4*)(SLOT(1) + t * RC_PITCH + cc * 2) = pack8(ob);
              *(LAS u32x4*)(SLOT(2) + t * RC_PITCH + cc * 2) = pack8(ok); *(LAS u32x4*)(SLOT(3) + t * RC_PITCH + cc * 2) = pack8(orr); } }
        RC_BAR();
        f32x16 Tacc;
        { f32x16 lab = rc_mm<false, false>(SLOT(1), SLOT(0), i0, j0, (f32x16){}, lane), lka = rc_mm<false, false>(SLOT(2), SLOT(0), i0, j0, (f32x16){}, lane);
#pragma unroll
          for (int r = 0; r < 16; ++r) { const int sI = i0 + crow(r, hi), tJ = j0 + r32; const bool keep = sI < tJ; lab[r] = keep ? lab[r] : 0.f; lka[r] = keep ? lka[r] : 0.f; Tacc[r] = lab[r] + (sI == tJ ? 1.f : 0.f); }
          rc_store(SLOT(4), i0, j0, lab, lane); rc_store(SLOT(5), i0, j0, lka, lane); rc_store(SLOT(6), i0, j0, Tacc, lane); }
        RC_BAR();
#define RC_DIAG(D) do { _Pragma("unroll 1") for (int itn = 0; itn < 4; ++itn) { \
                LAS unsigned char* Pc = (itn & 1) ? SLOT(7) : SLOT(4); LAS unsigned char* Pn = (itn & 1) ? SLOT(4) : SLOT(7); \
                { const f32x16 pn = rc_mm_k<false, true>(Pc, Pc, (D), (D), (D) / 16, (f32x16){}, lane); rc_store(Pn, (D), (D), pn, lane); } \
                Tacc = rc_mm_k<false, true>(SLOT(6), Pn, (D), (D), (D) / 16, Tacc, lane); \
                rc_store(SLOT(6), (D), (D), Tacc, lane); } } while (0)
        if (tw == 0) RC_DIAG(0); else if (tw == 3) RC_DIAG(32);
#undef RC_DIAG
        RC_BAR();
        if (tw == 1) {
            { const f32x16 xq = rc_mm_k<false, true>(SLOT(4), SLOT(6), 0, 32, 2, (f32x16){}, lane); rc_store(SLOT(7), 0, 32, xq, lane); }
            { const f32x16 t01 = rc_mm_k<false, true>(SLOT(6), SLOT(7), 0, 32, 0, (f32x16){}, lane); rc_store(SLOT(6), 0, 32, t01, lane); }
        }
        RC_BAR();
        { const int t = gtid >> 2, c0 = (gtid & 3) * 16; const size_t go = (m0 + t) * 512 + h * 64 + c0;
          *(LAS u32x4*)(SLOT(7) + t * RC_PITCH + c0 * 2) = *(const u32x4*)(V + go); *(LAS u32x4*)(SLOT(7) + t * RC_PITCH + c0 * 2 + 16) = *(const u32x4*)(V + go + 8); }
        RC_BAR();
        { const f32x16 z = rc_mm<true, true>(SLOT(5), SLOT(7), i0, j0, (f32x16){}, lane); rc_store(SLOT(4), i0, j0, z, lane); }
        RC_BAR();
        { const f32x16 a2 = rc_mm<true, true>(SLOT(6), SLOT(0), i0, j0, (f32x16){}, lane); rc_store(SLOT(5), i0, j0, a2, lane); }
        RC_BAR();
        { const f32x16 w1 = rc_mm<true, true>(SLOT(6), SLOT(4), i0, j0, (f32x16){}, lane); rc_store(SLOT(0), i0, j0, w1, lane); }
        RC_BAR();
        { f32x16 mb = rc_mm<false, false>(SLOT(1), SLOT(3), i0, j0, (f32x16){}, lane), mk = rc_mm<false, false>(SLOT(2), SLOT(3), i0, j0, (f32x16){}, lane);
#pragma unroll
          for (int r = 0; r < 16; ++r) { const bool keep = (i0 + crow(r, hi)) <= (j0 + r32); mb[r] = keep ? mb[r] : 0.f; mk[r] = keep ? mk[r] : 0.f; }
          rc_store(SLOT(4), i0, j0, mb, lane); rc_store(SLOT(6), i0, j0, mk, lane); }
        RC_BAR();
        f32x16 qm = rc_mm<true, true>(SLOT(4), SLOT(5), i0, j0, (f32x16){}, lane);
        f32x16 yl = rc_mm<true, true>(SLOT(6), SLOT(7), i0, j0, rc_mm<true, true>(SLOT(4), SLOT(0), i0, j0, (f32x16){}, lane), lane);
        f32x16 gg = rc_mm<true, true>(SLOT(5), SLOT(1), i0, j0, (f32x16){}, lane);
        f32x16 hh = rc_mm<true, true>(SLOT(7), SLOT(2), i0, j0, rc_mm<true, true>(SLOT(0), SLOT(1), i0, j0, (f32x16){}, lane), lane);
        { const float gc = gCl[j0 + r32];
#pragma unroll
          for (int r = 0; r < 16; ++r) { const int iI = i0 + crow(r, hi), jJ = j0 + r32;
              qm[r] += bf2f(*(const LAS bf16_t*)(SLOT(3) + iI * RC_PITCH + jJ * 2));
              gg[r] = (gg[r] + (iI == jJ ? 1.f : 0.f)) * gc; hh[r] *= gc; } }
        RC_BAR();
        { LAS float* f32m = (LAS float*)(F.lds + (grp ? 34816 : 0));
#pragma unroll
          for (int r = 0; r < 16; ++r) { const int iI = i0 + crow(r, hi), jJ = j0 + r32; f32m[iI * 68 + jJ] = gg[r]; f32m[4352 + iI * 68 + jJ] = hh[r]; }
          if (grp == 0) { rc_store(F.lds + 73728, i0, j0, gg, lane); rc_store(F.lds + 82944, i0, j0, hh, lane);
#pragma unroll
              for (int r = 0; r < 16; ++r) { const size_t o = (m0 + i0 + crow(r, hi)) * 512 + h * 64 + j0 + r32; PT[o] = (bf16_t)f2bf(qm[r]); Y[o] = (bf16_t)f2bf(yl[r]); } }
          else rc_store(F.lds + 92160, i0, j0, qm, lane); }
        RC_BAR();
        if (grp == 1) {
            const f32x16 q2 = rc_mm<false, false>(F.lds + 92160, F.lds + 73728, i0, j0, (f32x16){}, lane);
            yl = rc_mm<false, false>(F.lds + 92160, F.lds + 82944, i0, j0, yl, lane);
#pragma unroll
            for (int r = 0; r < 16; ++r) { const size_t o = (m0 + i0 + crow(r, hi)) * 512 + h * 64 + j0 + r32; PT[o] = (bf16_t)f2bf(q2[r]); Y[o] = (bf16_t)f2bf(yl[r]); }
        }
        {
            const LAS float* Am = (const LAS float*)(F.lds + (grp ? 17408 : 0)); const LAS float* Bm = (const LAS float*)(F.lds + 34816); const LAS float* Hb = (const LAS float*)(F.lds + 52224);
            f32x16 acc;
#pragma unroll
            for (int r = 0; r < 16; ++r) acc[r] = grp ? Hb[(i0 + crow(r, hi)) * 68 + j0 + r32] : 0.f;
            const LAS float* ap = Am + (i0 + r32) * 68 + hi; const LAS float* bp = Bm + hi * 68 + j0 + r32;
#pragma unroll 8
            for (int k4 = 0; k4 < 16; ++k4) { const f32x4 a4 = *(const LAS f32x4*)(ap - hi + 4 * k4);
                const float b0 = bp[(4 * k4) * 68], b1 = bp[(4 * k4 + 2) * 68];
                acc = __builtin_amdgcn_mfma_f32_32x32x2f32(hi ? a4[1] : a4[0], b0, acc, 0, 0, 0);
                acc = __builtin_amdgcn_mfma_f32_32x32x2f32(hi ? a4[3] : a4[2], b1, acc, 0, 0, 0); }
            float* dst = SUM + (size_t)hc * 8192 + (grp ? 0 : 4096) + j0 + r32;
#pragma unroll
            for (int r = 0; r < 16; ++r) dst[(i0 + crow(r, hi)) * 64] = acc[r];
        }
    }
    RC_BAR();
#undef SLOT
}
#undef RC_BAR

__device__ __forceinline__ void rwkv_combine(Frame& F, unsigned char* ws, int bh) {
    float* SUM = (float*)(ws + OFF_SUM);
    LAS float* Sl = (LAS float*)F.lds;
    LAS float* Pl = (LAS float*)(F.lds + 20480);
    const int tid = F.wave * 64 + lane_id(), v = tid >> 3, kq = tid & 7;
    float cur[8];
#pragma unroll
    for (int i = 0; i < 8; ++i) cur[i] = 0.f;
    for (int c = 0; c < NC; ++c) {
        const size_t hc = (size_t)bh * NC + c;
        const float* pc = SUM + (hc * 2 + 1) * 4096 + tid * 8;
        *(LAS f32x4*)(Pl + tid * 8) = *(const f32x4*)pc; *(LAS f32x4*)(Pl + tid * 8 + 4) = *(const f32x4*)(pc + 4);
#pragma unroll
        for (int i = 0; i < 8; ++i) Sl[v * 65 + 8 * kq + i] = cur[i];
        float* se = SUM + (hc * 2) * 4096 + v * 64 + 8 * kq;
        const f32x4 e0 = *(const f32x4*)se, e1 = *(const f32x4*)(se + 4);
        *(f32x4*)se = (f32x4){cur[0], cur[1], cur[2], cur[3]}; *(f32x4*)(se + 4) = (f32x4){cur[4], cur[5], cur[6], cur[7]};
        __syncthreads();
        float acc[8] = {e0[0], e0[1], e0[2], e0[3], e1[0], e1[1], e1[2], e1[3]};
#pragma unroll 8
        for (int j = 0; j < 64; ++j) { const float s = Sl[v * 65 + j]; const f32x4 p0 = *(const LAS f32x4*)(Pl + j * 64 + 8 * kq), p1 = *(const LAS f32x4*)(Pl + j * 64 + 8 * kq + 4);
            acc[0] += s * p0[0]; acc[1] += s * p0[1]; acc[2] += s * p0[2]; acc[3] += s * p0[3]; acc[4] += s * p1[0]; acc[5] += s * p1[1]; acc[6] += s * p1[2]; acc[7] += s * p1[3]; }
        __syncthreads();
#pragma unroll
        for (int i = 0; i < 8; ++i) cur[i] = acc[i];
    }
}
__device__ __forceinline__ void rwkv_fixup_task(unsigned char* ws, const float* lnx_w, const float* lnx_b, const float* r_k, int hc, int tl, int lane) {
    const bf16_t* R = (const bf16_t*)(ws + OFF_R); const bf16_t* V = (const bf16_t*)(ws + OFF_V); const bf16_t* KP = (const bf16_t*)(ws + OFF_KP);
    const bf16_t* G = (const bf16_t*)(ws + OFF_G); const bf16_t* Y = (const bf16_t*)(ws + OFF_Y); const bf16_t* PT = (const bf16_t*)(ws + OFF_PT);
    const float* S = (const float*)(ws + OFF_SUM) + (size_t)hc * 8192; bf16_t* MIX = (bf16_t*)(ws + OFF_PNSA);
    const int r32 = lane & 31, hi = lane >> 5, bh = hc / NC, c = hc % NC, h = bh & 7;
    const size_t m = (size_t)(bh >> 3) * T_ + (size_t)c * CL + 32 * tl + r32;
    const size_t row = m * 512 + h * 64;
    f32x16 acc[2]; acc[0] = (f32x16){}; acc[1] = (f32x16){};
#pragma unroll
    for (int ks = 0; ks < 4; ++ks) {
        const bf16x8 bfrag = *(const bf16x8*)(PT + row + 16 * ks + 8 * hi);
#pragma unroll
        for (int vt = 0; vt < 2; ++vt) { const float* sp = S + (size_t)(32 * vt + r32) * 64 + 16 * ks + 8 * hi; const f32x4 s0 = *(const f32x4*)sp, s1 = *(const f32x4*)(sp + 4);
            u32x4 w; w.x = pk2(s0[0], s0[1]); w.y = pk2(s0[2], s0[3]); w.z = pk2(s1[0], s1[1]); w.w = pk2(s1[2], s1[3]);
            acc[vt] = __builtin_amdgcn_mfma_f32_32x32x16_bf16(__builtin_bit_cast(bf16x8, w), bfrag, acc[vt], 0, 0, 0); }
    }
    float y[32], s1 = 0.f, rkdot = 0.f;
#pragma unroll
    for (int gq = 0; gq < 8; ++gq) { const int vo = 32 * (gq >> 2) + 8 * (gq & 3) + 4 * hi;
        if (gq == 4) __builtin_amdgcn_sched_barrier(0);
        const u32x2 yw = *(const u32x2*)(Y + row + vo), rw = *(const u32x2*)(R + row + vo), kw = *(const u32x2*)(KP + row + vo); const f32x4 rk4 = *(const f32x4*)(r_k + h * 64 + vo);
#pragma unroll
        for (int j = 0; j < 4; ++j) { const unsigned yu = j < 2 ? yw.x : yw.y, ru = j < 2 ? rw.x : rw.y, ku = j < 2 ? kw.x : kw.y;
            const float yl = __builtin_bit_cast(float, (j & 1) ? (yu & 0xffff0000u) : (yu << 16)), rf = __builtin_bit_cast(float, (j & 1) ? (ru & 0xffff0000u) : (ru << 16)), kf = __builtin_bit_cast(float, (j & 1) ? (ku & 0xffff0000u) : (ku << 16));
            const float yy = acc[gq >> 2][4 * (gq & 3) + j] + yl; y[4 * gq + j] = yy; s1 += yy; rkdot += rf * kf * rk4[j]; } }
    s1 += __shfl_xor(s1, 32); rkdot += __shfl_xor(rkdot, 32);
    const float mean = s1 * (1.0f / 64.0f); float s2 = 0.f;
#pragma unroll
    for (int i = 0; i < 32; ++i) { y[i] -= mean; s2 += y[i] * y[i]; }
    s2 += __shfl_xor(s2, 32);
    const float rstd = __builtin_amdgcn_rsqf(s2 * (1.0f / 64.0f) + LNX_EPS);
#pragma unroll
    for (int gq = 0; gq < 8; ++gq) { const int vo = 32 * (gq >> 2) + 8 * (gq & 3) + 4 * hi;
        const u32x2 vw = *(const u32x2*)(V + row + vo), gw_ = *(const u32x2*)(G + row + vo); const f32x4 lw4 = *(const f32x4*)(lnx_w + h * 64 + vo), lb4 = *(const f32x4*)(lnx_b + h * 64 + vo);
        float o4[4];
#pragma unroll
        for (int j = 0; j < 4; ++j) { const unsigned vu = j < 2 ? vw.x : vw.y, gu = j < 2 ? gw_.x : gw_.y;
            const float vf = __builtin_bit_cast(float, (j & 1) ? (vu & 0xffff0000u) : (vu << 16)), gf = __builtin_bit_cast(float, (j & 1) ? (gu & 0xffff0000u) : (gu << 16));
            o4[j] = (y[4 * gq + j] * rstd * lw4[j] + lb4[j] + rkdot * vf) * gf; }
        u32x2 w; w.x = pk2(o4[0], o4[1]); w.y = pk2(o4[2], o4[3]);
        *(u32x2*)(MIX + m * PN_LD + 512 + h * 64 + vo) = w; }
}

__device__ __forceinline__ bf16x8 v_frag(const LAS unsigned char* vbase, int VP, int kb, int dcol0, int lane) {
    const int hi = lane >> 5;
    const LAS unsigned char* p = vbase + (kb + 4 * hi + ((lane & 15) >> 2)) * VP + (dcol0 + 16 * ((lane >> 4) & 1) + 4 * (lane & 3)) * 2;
    const s16x4 lo = vtr(p), hh = vtr(p + 8 * VP);
    return (bf16x8){lo[0], lo[1], lo[2], lo[3], hh[0], hh[1], hh[2], hh[3]};
}
typedef __bf16 bf16x2_t __attribute__((ext_vector_type(2)));
__device__ __forceinline__ unsigned cvtpk(float lo, float hi) { const f32x2 v = {lo, hi}; return __builtin_bit_cast(unsigned, __builtin_convertvector(v, bf16x2_t)); }
__device__ __forceinline__ bf16x8 p_frag(const f32x16& p, int s) {
    u32x4 w; w.x = cvtpk(p[8 * s + 0], p[8 * s + 1]); w.y = cvtpk(p[8 * s + 2], p[8 * s + 3]); w.z = cvtpk(p[8 * s + 4], p[8 * s + 5]); w.w = cvtpk(p[8 * s + 6], p[8 * s + 7]);
    return __builtin_bit_cast(bf16x8, w);
}
__device__ __forceinline__ float max16(const f32x16& p) { float m = p[0];
#pragma unroll
    for (int r = 1; r < 16; ++r) m = fmaxf(m, p[r]);
    return m; }
__device__ __forceinline__ float sum16(const f32x16& p) { float a = 0.f;
#pragma unroll
    for (int r = 0; r < 16; ++r) a += p[r];
    return a; }

constexpr int XK_PITCH = 528, XV_PITCH = 144;
__device__ __forceinline__ void xattn_unit(Frame& F, const bf16_t* Q2, const bf16_t* KVX, bf16_t* XO, int b, int h4, int qt) {
    const int lane = lane_id(), wave = F.wave, tid = wave * 64 + lane, r32 = lane & 31, hi = lane >> 5;
    LAS unsigned char* kl = F.lds;
    LAS float* wsf = (LAS float*)(F.lds + 40960) + wave * 32;
    const size_t qrow = (size_t)b * T_ + (size_t)qt * 256 + wave * 32 + r32;
    bf16x8 qr[16];
#pragma unroll
    for (int ds = 0; ds < 16; ++ds) qr[ds] = *(const bf16x8*)(Q2 + qrow * D_ + h4 * 256 + 16 * ds + 8 * hi);
    const bf16_t* kg = KVX + (size_t)b * 256 * 2048 + h4 * 256;
    const bf16_t* vg = kg + 1024;
    float mref = 0.f, lrow = 0.f;
    bf16x8 PA[4][4];
    u32x4 pre[4];
#define XA_LOADK(kt_) do { _Pragma("unroll") for (int it = 0; it < 4; ++it) { const int idx = it * 512 + tid, row = idx >> 5, ch = idx & 31; pre[it] = *(const u32x4*)(kg + (size_t)((kt_) * 64 + row) * 2048 + ch * 8); } } while (0)
#define XA_WRITEK() do { _Pragma("unroll") for (int it = 0; it < 4; ++it) { const int idx = it * 512 + tid, row = idx >> 5, ch = idx & 31; *(LAS u32x4*)(kl + row * XK_PITCH + ch * 16) = pre[it]; } } while (0)
#define XA_LOADV(ds_) do { _Pragma("unroll") for (int it = 0; it < 4; ++it) { const int idx = it * 512 + tid, row = idx >> 3, ch = idx & 7; pre[it] = *(const u32x4*)(vg + (size_t)row * 2048 + (ds_) * 64 + ch * 8); } } while (0)
#define XA_WRITEV() do { _Pragma("unroll") for (int it = 0; it < 4; ++it) { const int idx = it * 512 + tid, row = idx >> 3, ch = idx & 7; *(LAS u32x4*)(kl + row * XV_PITCH + ch * 16) = pre[it]; } } while (0)
    __syncthreads();
    XA_LOADK(0); XA_WRITEK();
    __syncthreads();
#pragma unroll
    for (int kt = 0; kt < 4; ++kt) {
        if (kt < 3) XA_LOADK(kt + 1); else XA_LOADV(0);
        f32x16 p0 = {}, p1 = {};
#pragma unroll
        for (int ds = 0; ds < 16; ++ds) {
            const bf16x8 a0 = *(const LAS bf16x8*)(kl + r32 * XK_PITCH + (16 * ds + 8 * hi) * 2), a1 = *(const LAS bf16x8*)(kl + (32 + r32) * XK_PITCH + (16 * ds + 8 * hi) * 2);
            p0 = __builtin_amdgcn_mfma_f32_32x32x16_bf16(a0, qr[ds], p0, 0, 0, 0); p1 = __builtin_amdgcn_mfma_f32_32x32x16_bf16(a1, qr[ds], p1, 0, 0, 0); }
        float tmax = fmaxf(max16(p0), max16(p1)); tmax = fmaxf(tmax, __shfl_xor(tmax, 32));
        if (kt == 0) mref = tmax;
        else if (__any(tmax > mref + 16.0f)) {
            const float mnew = fmaxf(mref, tmax), alpha = __builtin_amdgcn_exp2f(mref - mnew);
            lrow *= alpha; mref = mnew;
#pragma unroll
            for (int kk = 0; kk < 4; ++kk) if (kk < kt) {
#pragma unroll
                for (int ks = 0; ks < 4; ++ks) { float f[8]; unpack8(__builtin_bit_cast(u32x4, PA[kk][ks]), f);
#pragma unroll
                    for (int e = 0; e < 8; ++e) f[e] *= alpha;
                    PA[kk][ks] = __builtin_bit_cast(bf16x8, pack8(f)); } }
        }
#pragma unroll
        for (int r = 0; r < 16; ++r) { p0[r] = __builtin_amdgcn_exp2f(p0[r] - mref); p1[r] = __builtin_amdgcn_exp2f(p1[r] - mref); }
        lrow += sum16(p0) + sum16(p1);
        PA[kt][0] = p_frag(p0, 0); PA[kt][1] = p_frag(p0, 1); PA[kt][2] = p_frag(p1, 0); PA[kt][3] = p_frag(p1, 1);
        __syncthreads();
        if (kt < 3) XA_WRITEK(); else XA_WRITEV();
        __syncthreads();
    }
    lrow += __shfl_xor(lrow, 32);
    if (hi == 0) wsf[r32] = __builtin_amdgcn_rcpf(lrow);
    asm volatile("s_waitcnt lgkmcnt(0)" ::: "memory");
#pragma unroll 1
    for (int dsl = 0; dsl < 4; ++dsl) {
        if (dsl < 3) XA_LOADV(dsl + 1);
        LAS unsigned char* ost = F.lds + 45056 + wave * 4608;
#pragma unroll
        for (int d0 = 0; d0 < 2; ++d0) {
            f32x16 o = {};
#pragma unroll
            for (int kt = 0; kt < 4; ++kt)
#pragma unroll
                for (int ks = 0; ks < 4; ++ks) o = __builtin_amdgcn_mfma_f32_32x32x16_bf16(PA[kt][ks], v_frag(kl, XV_PITCH, kt * 64 + 16 * ks, 32 * d0, lane), o, 0, 0, 0);
#pragma unroll
            for (int r = 0; r < 16; ++r) { const int q = crow(r, hi); *(LAS bf16_t*)(ost + q * 144 + (32 * d0 + r32) * 2) = (bf16_t)f2bf(o[r] * wsf[q]); }
        }
        asm volatile("s_waitcnt lgkmcnt(0)" ::: "memory");
#pragma unroll
        for (int i = 0; i < 4; ++i) { const int row = i * 8 + (lane >> 3), ch = lane & 7; *(u32x4*)(XO + (unsigned)(((b * T_ + qt * 256 + wave * 32 + row) * D_) + h4 * 256 + dsl * 64 + ch * 8)) = *(const LAS u32x4*)(ost + row * 144 + ch * 16); }
        __syncthreads();
        if (dsl < 3) XA_WRITEV();
        __syncthreads();
    }
#undef XA_LOADK
#undef XA_WRITEK
#undef XA_LOADV
#undef XA_WRITEV
}

constexpr int NK_PITCH = 128, NT_SLOT = 16384;
constexpr int NS_N = 2668, NW_N = 644;
constexpr int NL_IMP = 32768, NL_LUTS = 66560, NL_LUTW = 109248, NL_NEG = 119552, NL_SELM = 120064, NL_WSF = 121088, NL_B31 = 125184;
constexpr int IMP_PITCH = 132;

__device__ __forceinline__ void nsa_bias_cmp(f32x16& p0, f32x16& p1, const LAS float* lutsg, int db) {
    const int base = NS_N - 69 - db;
#pragma unroll
    for (int r = 0; r < 16; ++r) { const int kc = (r & 3) + 8 * (r >> 2);
        p0[r] += lutsg[min(base + 16 * kc, NS_N - 1)]; p1[r] += lutsg[min(base + 16 * (kc + 32), NS_N - 1)]; }
}
__device__ __forceinline__ void nsa_bias_tab(f32x16& p0, f32x16& p1, const LAS float* tab) {
#pragma unroll
    for (int r = 0; r < 16; ++r) { const int kc = (r & 3) + 8 * (r >> 2);
        p0[r] += tab[kc]; p1[r] += tab[kc + 32]; }
}
__device__ __forceinline__ void nsa_bias_const(f32x16& p0, f32x16& p1, float rt) {
#pragma unroll
    for (int r = 0; r < 16; ++r) { p0[r] += rt; p1[r] += rt; }
}
__device__ __forceinline__ void nsa_online(f32x16& p0, f32x16& p1, float& mrow, float& lrow, f32x16* o, LAS float* wsf, int hi, int r32) {
    float tmax = fmaxf(max16(p0), max16(p1)); tmax = fmaxf(tmax, __shfl_xor(tmax, 32));
    if (__any(tmax > mrow + 8.0f)) {
        const float mnew = fmaxf(mrow, tmax), msafe = (mnew == -INFINITY) ? 0.f : mnew;
        const float alpha = __builtin_amdgcn_exp2f(mrow - msafe);
        lrow *= alpha;
        if (o != nullptr) {
            if (hi == 0) wsf[r32] = alpha;
            asm volatile("s_waitcnt lgkmcnt(0)" ::: "memory");
#pragma unroll
            for (int r = 0; r < 16; ++r) { const float a = wsf[crow(r, hi)]; o[0][r] *= a; o[1][r] *= a; }
            asm volatile("s_waitcnt lgkmcnt(0)" ::: "memory");
        }
        mrow = mnew;
    }
    const float mref = (mrow == -INFINITY) ? 0.f : mrow;
#pragma unroll
    for (int r = 0; r < 16; ++r) { p0[r] = __builtin_amdgcn_exp2f(p0[r] - mref); p1[r] = __builtin_amdgcn_exp2f(p1[r] - mref); }
    lrow += (sum16(p0) + sum16(p1));
}
__device__ __forceinline__ void nsa_resc(float& mref, float psum, float& lrow, f32x16* o, LAS float* wsf, int hi, int r32) {
    if (__any(psum > 16384.0f)) {
        const float d = psum > 16384.0f ? __builtin_amdgcn_logf(psum) : 0.f, alpha = __builtin_amdgcn_exp2f(-d);
        lrow *= alpha; mref += d;
        if (hi == 0) wsf[r32] = alpha;
        asm volatile("s_waitcnt lgkmcnt(0)" ::: "memory");
#pragma unroll
        for (int r = 0; r < 16; ++r) { const float a = wsf[crow(r, hi)]; o[0][r] *= a; o[1][r] *= a; }
        asm volatile("s_waitcnt lgkmcnt(0)" ::: "memory");
    }
}
__device__ __forceinline__ int nsa_swz(int row) { const int x = (row >> 1) & 7; return ((x & 1) << 2) | (x & 2) | ((x >> 2) & 1); }
__device__ __forceinline__ void nsa_dma(const bf16_t* src, int pitch, LAS unsigned char* dst, int wave, int lane) {
    const int row = 8 * wave + (lane >> 3), c = (lane & 7) ^ nsa_swz(row);
    __builtin_amdgcn_global_load_lds((const unsigned*)(src + (size_t)row * pitch + c * 8), (LAS unsigned*)(dst + wave * 1024), 16, 0, 0);
}
__device__ __forceinline__ void nsa_qk(f32x16& p0, f32x16& p1, const LAS unsigned char* kl, const bf16x8* qr, int r32, int hi) {
    p0 = (f32x16){}; p1 = (f32x16){};
#pragma unroll
    for (int ds = 0; ds < 4; ++ds) {
        const int co = (((2 * ds + hi) ^ nsa_swz(r32)) << 4);
        const bf16x8 a0 = *(const LAS bf16x8*)(kl + r32 * NK_PITCH + co), a1 = *(const LAS bf16x8*)(kl + (32 + r32) * NK_PITCH + co);
        p0 = __builtin_amdgcn_mfma_f32_32x32x16_bf16(a0, qr[ds], p0, 0, 0, 0); p1 = __builtin_amdgcn_mfma_f32_32x32x16_bf16(a1, qr[ds], p1, 0, 0, 0); }
}
__device__ __forceinline__ void nsa_kfrags(bf16x8* ka, const LAS unsigned char* kl, int r32, int hi) {
#pragma unroll
    for (int ds = 0; ds < 4; ++ds) { const int co = (((2 * ds + hi) ^ nsa_swz(r32)) << 4);
        ka[2 * ds] = *(const LAS bf16x8*)(kl + r32 * NK_PITCH + co); ka[2 * ds + 1] = *(const LAS bf16x8*)(kl + (32 + r32) * NK_PITCH + co); }
}
__device__ __forceinline__ void nsa_qk_frags(f32x16& p0, f32x16& p1, const bf16x8* ka, const bf16x8* qr) {
    p0 = (f32x16){}; p1 = (f32x16){};
#pragma unroll
    for (int ds = 0; ds < 4; ++ds) { p0 = __builtin_amdgcn_mfma_f32_32x32x16_bf16(ka[2 * ds], qr[ds], p0, 0, 0, 0); p1 = __builtin_amdgcn_mfma_f32_32x32x16_bf16(ka[2 * ds + 1], qr[ds], p1, 0, 0, 0); }
}
__device__ __forceinline__ bf16x8 nsa_vfrag(const LAS unsigned char* vl, int kb, int d0, int lane) {
    const int hi = lane >> 5, row0 = 4 * hi + ((lane & 15) >> 2), chunk = 4 * d0 + 2 * ((lane >> 4) & 1) + ((lane & 3) >> 1), within = (lane & 1) * 8;
    const LAS unsigned char* pa = vl + (kb + row0) * NK_PITCH + ((chunk ^ nsa_swz(row0)) << 4) + within;
    const LAS unsigned char* pb = vl + (kb + row0 + 8) * NK_PITCH + ((chunk ^ nsa_swz(row0 + 8)) << 4) + within;
    const s16x4 lo = vtr(pa), hh = vtr(pb);
    return (bf16x8){lo[0], lo[1], lo[2], lo[3], hh[0], hh[1], hh[2], hh[3]};
}
__device__ __forceinline__ void nsa_pv(f32x16* o, const f32x16& p0, const f32x16& p1, const LAS unsigned char* vl, int lane) {
    const bf16x8 a0 = p_frag(p0, 0), a1 = p_frag(p0, 1), a2 = p_frag(p1, 0), a3 = p_frag(p1, 1);
#pragma unroll
    for (int d0 = 0; d0 < 2; ++d0) {
        o[d0] = __builtin_amdgcn_mfma_f32_32x32x16_bf16(a0, nsa_vfrag(vl, 0, d0, lane), o[d0], 0, 0, 0);
        o[d0] = __builtin_amdgcn_mfma_f32_32x32x16_bf16(a1, nsa_vfrag(vl, 16, d0, lane), o[d0], 0, 0, 0);
        o[d0] = __builtin_amdgcn_mfma_f32_32x32x16_bf16(a2, nsa_vfrag(vl, 32, d0, lane), o[d0], 0, 0, 0);
        o[d0] = __builtin_amdgcn_mfma_f32_32x32x16_bf16(a3, nsa_vfrag(vl, 48, d0, lane), o[d0], 0, 0, 0); }
}
typedef unsigned u32x2 __attribute__((ext_vector_type(2)));
__device__ __forceinline__ s16x4 nsa_cfrag(float c, int hi) {
    const unsigned ch = f2bf(c); const float rem = c - bf2f((bf16_t)ch); const unsigned cl = (c == -INFINITY) ? 0u : f2bf(rem);
    const unsigned w0 = hi ? 0u : (ch | (cl << 16));
    return __builtin_bit_cast(s16x4, (u32x2){w0, 0u});
}
__device__ __forceinline__ s16x4 nsa_onesfrag() { return __builtin_bit_cast(s16x4, (u32x2){0x3F803F80u, 0x3F803F80u}); }
__device__ __forceinline__ void nsa_qk_frags_c(f32x16& p0, f32x16& p1, const bf16x8* ka, const bf16x8* qr, s16x4 cf) {
    p0 = __builtin_amdgcn_mfma_f32_32x32x8bf16_1k(nsa_onesfrag(), cf, (f32x16){}, 0, 0, 0); p1 = __builtin_amdgcn_mfma_f32_32x32x8bf16_1k(nsa_onesfrag(), cf, (f32x16){}, 0, 0, 0);
#pragma unroll
    for (int ds = 0; ds < 4; ++ds) { p0 = __builtin_amdgcn_mfma_f32_32x32x16_bf16(ka[2 * ds], qr[ds], p0, 0, 0, 0); p1 = __builtin_amdgcn_mfma_f32_32x32x16_bf16(ka[2 * ds + 1], qr[ds], p1, 0, 0, 0); }
}
__device__ __forceinline__ void nsa_qk_c(f32x16& p0, f32x16& p1, const LAS unsigned char* kl, const bf16x8* qr, int r32, int hi, s16x4 cf) {
    p0 = __builtin_amdgcn_mfma_f32_32x32x8bf16_1k(nsa_onesfrag(), cf, (f32x16){}, 0, 0, 0); p1 = __builtin_amdgcn_mfma_f32_32x32x8bf16_1k(nsa_onesfrag(), cf, (f32x16){}, 0, 0, 0);
#pragma unroll
    for (int ds = 0; ds < 4; ++ds) {
        const int co = (((2 * ds + hi) ^ nsa_swz(r32)) << 4);
        const bf16x8 a0 = *(const LAS bf16x8*)(kl + r32 * NK_PITCH + co), a1 = *(const LAS bf16x8*)(kl + (32 + r32) * NK_PITCH + co);
        p0 = __builtin_amdgcn_mfma_f32_32x32x16_bf16(a0, qr[ds], p0, 0, 0, 0); p1 = __builtin_amdgcn_mfma_f32_32x32x16_bf16(a1, qr[ds], p1, 0, 0, 0); }
}
__device__ __forceinline__ float nsa_tile_exp_plain(f32x16& p0, f32x16& p1) {
#pragma unroll
    for (int r = 0; r < 16; ++r) { p0[r] = __builtin_amdgcn_exp2f(p0[r]); p1[r] = __builtin_amdgcn_exp2f(p1[r]); }
    return sum16(p0) + sum16(p1);
}
__device__ __forceinline__ float nsa_tile_exp_tab0(f32x16& p0, f32x16& p1, const LAS float* tab) {
#pragma unroll
    for (int r = 0; r < 16; ++r) { const int kc = (r & 3) + 8 * (r >> 2); p0[r] = __builtin_amdgcn_exp2f(p0[r] + tab[kc]); p1[r] = __builtin_amdgcn_exp2f(p1[r] + tab[kc + 32]); }
    return sum16(p0) + sum16(p1);
}
__device__ __forceinline__ void nsa_tile_exp_only(f32x16& p0, f32x16& p1) {
#pragma unroll
    for (int r = 0; r < 16; ++r) { p0[r] = __builtin_amdgcn_exp2f(p0[r]); p1[r] = __builtin_amdgcn_exp2f(p1[r]); }
}
__device__ __forceinline__ void nsa_tile_exp_tab_only(f32x16& p0, f32x16& p1, const LAS float* tab) {
#pragma unroll
    for (int r = 0; r < 16; ++r) { const int kc = (r & 3) + 8 * (r >> 2); p0[r] = __builtin_amdgcn_exp2f(p0[r] + tab[kc]); p1[r] = __builtin_amdgcn_exp2f(p1[r] + tab[kc + 32]); }
}
__device__ __forceinline__ float nsa_tile_exp_const(f32x16& p0, f32x16& p1, float c) {
#pragma unroll
    for (int r = 0; r < 16; ++r) { p0[r] = __builtin_amdgcn_exp2f(p0[r] + c); p1[r] = __builtin_amdgcn_exp2f(p1[r] + c); }
    return sum16(p0) + sum16(p1);
}
__device__ __forceinline__ float nsa_tile_exp_tab(f32x16& p0, f32x16& p1, const LAS float* tab, float mref) {
#pragma unroll
    for (int r = 0; r < 16; ++r) { const int kc = (r & 3) + 8 * (r >> 2); p0[r] += tab[kc]; p1[r] += tab[kc + 32]; }
#pragma unroll
    for (int r = 0; r < 16; ++r) { p0[r] = __builtin_amdgcn_exp2f(p0[r] - mref); p1[r] = __builtin_amdgcn_exp2f(p1[r] - mref); }
    return sum16(p0) + sum16(p1);
}
__device__ __forceinline__ void nsa_vfrags(bf16x8* vf, const LAS unsigned char* vl, int lane) {
#pragma unroll
    for (int d0 = 0; d0 < 2; ++d0)
#pragma unroll
        for (int k = 0; k < 4; ++k) vf[4 * d0 + k] = nsa_vfrag(vl, 16 * k, d0, lane);
}
__device__ __forceinline__ void nsa_pv_frags(f32x16* o, bf16x8 a0, bf16x8 a1, bf16x8 a2, bf16x8 a3, const bf16x8* vf) {
#pragma unroll
    for (int d0 = 0; d0 < 2; ++d0) {
        o[d0] = __builtin_amdgcn_mfma_f32_32x32x16_bf16(a0, vf[4 * d0 + 0], o[d0], 0, 0, 0);
        o[d0] = __builtin_amdgcn_mfma_f32_32x32x16_bf16(a1, vf[4 * d0 + 1], o[d0], 0, 0, 0);
        o[d0] = __builtin_amdgcn_mfma_f32_32x32x16_bf16(a2, vf[4 * d0 + 2], o[d0], 0, 0, 0);
        o[d0] = __builtin_amdgcn_mfma_f32_32x32x16_bf16(a3, vf[4 * d0 + 3], o[d0], 0, 0, 0); }
}
__device__ __forceinline__ void nsa_emit(bf16_t* dst0, const f32x16* o, float f, bool accumulate, bool dry, LAS float* wsf, int hi, int r32) {
    if (hi == 0) wsf[r32] = f;
    asm volatile("s_waitcnt lgkmcnt(0)" ::: "memory");
    float v0[16], v1[16];
#pragma unroll
    for (int r = 0; r < 16; ++r) { v0[r] = 0.f; v1[r] = 0.f; }
    if (accumulate) {
#pragma unroll
        for (int r = 0; r < 16; ++r) { const int q = crow(r, hi); const bf16_t* src = dst0 + (size_t)(q & 7) * PN_LD + (q >> 3) * 64; v0[r] = bf2f(src[0]); v1[r] = bf2f(src[32]); }
    }
#pragma unroll
    for (int r = 0; r < 16; ++r) { const float a = wsf[crow(r, hi)]; v0[r] += o[0][r] * a; v1[r] += o[1][r] * a; }
    if (!dry) {
#pragma unroll
        for (int r = 0; r < 16; ++r) { const int q = crow(r, hi); bf16_t* dst = dst0 + (size_t)(q & 7) * PN_LD + (q >> 3) * 64; dst[0] = (bf16_t)f2bf(v0[r]); dst[32] = (bf16_t)f2bf(v1[r]); }
    }
    asm volatile("s_waitcnt lgkmcnt(0)" ::: "memory");
}

__device__ __forceinline__ int sum8_dpp(int c) {
    c += __builtin_amdgcn_update_dpp(0, c, 0xB1, 0xF, 0xF, true);
    c += __builtin_amdgcn_update_dpp(0, c, 0x4E, 0xF, 0xF, true);
    c += __builtin_amdgcn_update_dpp(0, c, 0x141, 0xF, 0xF, true);
    return c;
}
__device__ __forceinline__ void nsa_unit(Frame& F, unsigned char* ws, const float* gate_b, int b, int hkv, int qblk, bool dry = false) {
    const int lane = lane_id(), wave = F.wave, tid = wave * 64 + lane, r32 = lane & 31, hi = lane >> 5;
    const int g = r32 >> 3, qi = r32 & 7;
    const int tq = 64 * qblk + 8 * wave + qi;
    bf16_t* PN = (bf16_t*)(ws + OFF_PNSA);
    const bf16_t* KCg = (const bf16_t*)(ws + OFF_KC) + (size_t)(b * 2 + hkv) * 512 * 64; const bf16_t* VCg = (const bf16_t*)(ws + OFF_VC) + (size_t)(b * 2 + hkv) * 512 * 64;
    LAS unsigned char* lds = F.lds;
    LAS float* luts = (LAS float*)(lds + NL_LUTS); LAS float* lutw = (LAS float*)(lds + NL_LUTW); LAS float* negt = (LAS float*)(lds + NL_NEG);
    LAS float* impl = (LAS float*)(lds + NL_IMP); LAS unsigned* selm = (LAS unsigned*)(lds + NL_SELM);
    LAS float* wsf = (LAS float*)(lds + NL_WSF) + wave * 128;
    const float* LUTg = (const float*)(ws + OFF_LUT) + (size_t)(hkv * 4) * 2048;
    __syncthreads();
    { const f32x4* ls4 = (const f32x4*)((const float*)(ws + OFF_LTS) + (size_t)(hkv * 4) * NS_N); const f32x4* lw4 = (const f32x4*)((const float*)(ws + OFF_LTW) + (size_t)(hkv * 4) * NW_N);
      for (int i = tid; i < NS_N; i += NTHREADS) ((LAS f32x4*)luts)[i] = ls4[i];
      for (int i = tid; i < NW_N; i += NTHREADS) ((LAS f32x4*)lutw)[i] = lw4[i]; }
    if (tid < 128) negt[tid] = -INFINITY;
    LAS float* b31t = (LAS float*)(lds + NL_B31);
    if (tid < 256) b31t[tid] = LUTg[(tid >> 6) * 2048 + 1535];
    const float* lutg = LUTg + g * 2048;
    const float b31 = lutg[1535];
    const size_t qoff = ((size_t)b * T_ + tq) * PN_LD;
    bf16x8 qr[4];
#pragma unroll
    for (int ds = 0; ds < 4; ++ds) qr[ds] = *(const bf16x8*)(PN + qoff + (hkv * 4 + g) * 64 + 16 * ds + 8 * hi);
#pragma unroll
    for (int j = 0; j < 3; ++j) { const int gc = (hkv * 4 + g) * 3 + j; const float gt = __builtin_amdgcn_rcpf(1.0f + __expf(-(bf2f(PN[qoff + 1280 + gc]) + gate_b[gc]))); if (hi == 0) wsf[32 + 32 * j + r32] = gt; }
#define NSA_GATE(j_) (wsf[32 + 32 * (j_) + r32])
    bf16_t* const dst0 = PN + ((size_t)b * T_ + 64 * qblk + 8 * wave) * PN_LD + hkv * 256 + r32;
#define NSA_DMA(kp, vp, pitch, tile, slot) do { nsa_dma((kp) + (size_t)(tile) * 64 * (pitch), (pitch), lds + (slot) * NT_SLOT, wave, lane); nsa_dma((vp) + (size_t)(tile) * 64 * (pitch), (pitch), lds + (slot) * NT_SLOT + 8192, wave, lane); } while (0)
#define NSA_SYNC() do { asm volatile("s_waitcnt vmcnt(0)" ::: "memory"); __syncthreads(); } while (0)
    f32x16 p0, p1, o[2];
    const int nct = (4 * qblk + 3 + 63) / 64;
    float mc = 0.f, lc = 0.f;
    for (int i = 0; i < nct; ++i) nsa_dma(KCg + (size_t)i * 64 * 64, 64, lds + i * 8192, wave, lane);
    NSA_SYNC();
    for (int i = 0; i < nct; ++i) {
        const bool farc = (64 * qblk + 8 * wave) - 1024 * i - 1039 >= 1535;
        nsa_qk_c(p0, p1, lds + i * 8192, qr, r32, hi, nsa_cfrag(farc ? b31 - mc : -mc, hi));
        if (!farc) nsa_bias_cmp(p0, p1, luts + g * NS_N, tq - 31 - 1024 * i - 64 * hi);
        const float ts = nsa_tile_exp_plain(p0, p1); lc += ts;
        const float ps = fmaxf(ts, __shfl_xor(ts, 32));
        if (__any(ps > 16384.0f)) { const float d = ps > 16384.0f ? __builtin_amdgcn_logf(ps) : 0.f; lc *= __builtin_amdgcn_exp2f(-d); mc += d; }
    }
    __syncthreads();
    lc += __shfl_xor(lc, 32);
    const float cnorm = lc > 0.f ? -mc - __builtin_amdgcn_logf(lc) : -INFINITY;
    o[0] = (f32x16){}; o[1] = (f32x16){};
    float carry = 0.f;
    NSA_DMA(KCg, VCg, 64, 0, 0);
    NSA_SYNC();
    for (int i = 0; i < nct; ++i) {
        if (i + 1 < nct) NSA_DMA(KCg, VCg, 64, i + 1, (i + 1) & 1);
        const bool farc = (64 * qblk + 8 * wave) - 1024 * i - 1039 >= 1535;
        nsa_qk_c(p0, p1, lds + (i & 1) * NT_SLOT, qr, r32, hi, nsa_cfrag(farc ? b31 + cnorm : cnorm, hi));
        if (!farc) nsa_bias_cmp(p0, p1, luts + g * NS_N, tq - 31 - 1024 * i - 64 * hi);
#pragma unroll
        for (int r = 0; r < 16; ++r) { p0[r] = __builtin_amdgcn_exp2f(p0[r]); p1[r] = __builtin_amdgcn_exp2f(p1[r]); }
        float gs[8], gl[8], rc[8];
#pragma unroll
        for (int k4 = 0; k4 < 4; ++k4) { gs[k4] = (p0[4 * k4] + p0[4 * k4 + 1]) + (p0[4 * k4 + 2] + p0[4 * k4 + 3]); gl[k4] = p0[4 * k4 + 3];
            gs[4 + k4] = (p1[4 * k4] + p1[4 * k4 + 1]) + (p1[4 * k4 + 2] + p1[4 * k4 + 3]); gl[4 + k4] = p1[4 * k4 + 3]; }
#pragma unroll
        for (int k = 0; k < 8; ++k) rc[k] = __shfl_xor(gl[k], 32);
#pragma unroll
        for (int k = 0; k < 8; ++k) { const float prev = hi ? rc[k] : (k == 0 ? carry : rc[k - 1]); float v = gs[k] + prev;
            v += __shfl_xor(v, 8); v += __shfl_xor(v, 16);
            if (g == 0) impl[(8 * wave + qi) * IMP_PITCH + 16 * i + 2 * k + hi] = v; }
        carry = rc[7];
        nsa_pv(o, p0, p1, lds + (i & 1) * NT_SLOT + 8192, lane);
        NSA_SYNC();
    }
    nsa_emit(dst0, o, NSA_GATE(0), false, dry, wsf, hi, r32);
    {
        const int q8 = lane >> 3, jg = lane & 7, qq = 8 * wave + q8, cur = qblk;
        unsigned bits = 0u;
        if (cur >= 16) {
            unsigned key[16];
#pragma unroll
            for (int jj = 0; jj < 16; ++jj) { const int j = 16 * jg + jj; const unsigned kb_ = __builtin_bit_cast(unsigned, impl[qq * IMP_PITCH + j]); key[jj] = (j >= 1 && j <= cur - 2) ? kb_ + 1u : 0u; }
            unsigned Tsel = 0u; bool done = false;
            int bb0 = 30; asm volatile("" : "+s"(bb0));
#pragma unroll 2
            for (int bb = bb0; bb >= 0; --bb) { const unsigned Tt = Tsel | (1u << bb); int c = 0;
#pragma unroll
                for (int jj = 0; jj < 16; ++jj) c += (key[jj] >= Tt) ? 1 : 0;
                c = sum8_dpp(c);
                Tsel = (!done && c >= 13) ? Tt : Tsel;
                done = done || c == 13;
                if (__all(done)) break; }
            int ngt = 0, neq = 0;
#pragma unroll
            for (int jj = 0; jj < 16; ++jj) { ngt += (key[jj] > Tsel) ? 1 : 0; neq += (key[jj] == Tsel) ? 1 : 0; }
            ngt = sum8_dpp(ngt);
            int pre = neq;
            { int t = __shfl_up(pre, 1, 8); if (jg >= 1) pre += t; t = __shfl_up(pre, 2, 8); if (jg >= 2) pre += t; t = __shfl_up(pre, 4, 8); if (jg >= 4) pre += t; }
            int run = pre - neq; const int need = 13 - ngt;
#pragma unroll
            for (int jj = 0; jj < 16; ++jj) { const int j = 16 * jg + jj; bool sel = key[jj] > Tsel;
                if (key[jj] == Tsel && Tsel != 0u) { sel = run < need; ++run; }
                sel = sel || j == 0 || j == cur || j == cur - 1; bits |= sel ? (1u << jj) : 0u; }
        } else {
#pragma unroll
            for (int jj = 0; jj < 16; ++jj) { const int j = 16 * jg + jj; bits |= (j <= cur) ? (1u << jj) : 0u; }
        }
        const unsigned other = (unsigned)__shfl_xor((int)bits, 1);
        if ((jg & 1) == 0) selm[qq * 4 + (jg >> 1)] = bits | (other << 16);
        asm volatile("s_waitcnt lgkmcnt(0)" ::: "memory");
    }
    const LAS unsigned* sm = selm + (8 * wave + qi) * 4;
#define NSA_SB() __builtin_amdgcn_sched_barrier(0)
#define NSA_PAIR(EXPA, EXPB) do { \
            { bf16x8 ka_[8]; nsa_kfrags(ka_, sl_, r32, hi); NSA_SB(); nsa_qk_frags(p0, p1, ka_, qr); } \
            NSA_SB(); \
            nsa_qk(q0, q1, sl_ + NT_SLOT, qr, r32, hi); \
            EXPA; \
            fa0 = p_frag(p0, 0); fa1 = p_frag(p0, 1); fa2 = p_frag(p1, 0); fa3 = p_frag(p1, 1); \
            NSA_SB(); \
            { bf16x8 va_[8]; nsa_vfrags(va_, sl_ + 8192, lane); NSA_SB(); nsa_pv_frags(o, fa0, fa1, fa2, fa3, va_); } \
            EXPB; \
            fa0 = p_frag(q0, 0); fa1 = p_frag(q0, 1); fa2 = p_frag(q1, 0); fa3 = p_frag(q1, 1); \
            NSA_SB(); \
            { bf16x8 vb_[8]; nsa_vfrags(vb_, sl_ + NT_SLOT + 8192, lane); NSA_SB(); nsa_pv_frags(o, fa0, fa1, fa2, fa3, vb_); } \
        } while (0)
#define NSA_PAIR_C(CFA, CFB, EXPA, EXPB) do { \
            { bf16x8 ka_[8]; nsa_kfrags(ka_, sl_, r32, hi); const s16x4 cfa_ = (CFA); NSA_SB(); nsa_qk_frags_c(p0, p1, ka_, qr, cfa_); } \
            NSA_SB(); \
            nsa_qk_c(q0, q1, sl_ + NT_SLOT, qr, r32, hi, (CFB)); \
            EXPA; \
            fa0 = p_frag(p0, 0); fa1 = p_frag(p0, 1); fa2 = p_frag(p1, 0); fa3 = p_frag(p1, 1); \
            NSA_SB(); \
            { bf16x8 va_[8]; nsa_vfrags(va_, sl_ + 8192, lane); NSA_SB(); nsa_pv_frags(o, fa0, fa1, fa2, fa3, va_); } \
            EXPB; \
            fa0 = p_frag(q0, 0); fa1 = p_frag(q0, 1); fa2 = p_frag(q1, 0); fa3 = p_frag(q1, 1); \
            NSA_SB(); \
            { bf16x8 vb_[8]; nsa_vfrags(vb_, sl_ + NT_SLOT + 8192, lane); NSA_SB(); nsa_pv_frags(o, fa0, fa1, fa2, fa3, vb_); } \
            tsa_ = sum16(p0) + sum16(p1); tsb_ = sum16(q0) + sum16(q1);     \
        } while (0)
#define NSA_ITER_HEAD(kp, vp, t0, nt) \
            const int jn_ = (j + 1 < np_) ? j + 1 : j, tb_ = (2 * jn_ + 1 < (nt)) ? 2 * jn_ + 1 : 2 * jn_; \
            NSA_DMA(kp, vp, PN_LD, (t0) + 2 * jn_, 2 * ((j + 1) & 1)); NSA_DMA(kp, vp, PN_LD, (t0) + tb_, 2 * ((j + 1) & 1) + 1);        \
            const LAS unsigned char* sl_ = lds + (j & 1) * 2 * NT_SLOT; \
            f32x16 q0, q1; float tsa_, tsb_; bf16x8 fa0, fa1, fa2, fa3;
#define NSA_ITER_TAIL(mref, psum, lvar) \
            { float ts_ = tsa_ + tsb_; lvar += ts_; psum = fmaxf(ts_, __shfl_xor(ts_, 32)); } \
            NSA_SYNC(); \
            nsa_resc(mref, psum, lvar, o, wsf, hi, r32);
#define NSA_LOOP2(kp, vp, t0, nt, TABF, NFAR, SELBIT, mref, psum, lvar) do { \
        const int np_ = ((nt) + 1) >> 1, nf_ = (NFAR) < np_ ? (NFAR) : np_; \
        __syncthreads();                                                \
        NSA_DMA(kp, vp, PN_LD, (t0), 0); NSA_DMA(kp, vp, PN_LD, (t0) + ((nt) > 1 ? 1 : 0), 1); \
        NSA_SYNC(); \
        int j = 0; \
        for (; j < nf_; ++j) { \
            NSA_ITER_HEAD(kp, vp, t0, nt) \
            float ca_, cb_; { const int i = 2 * j; ca_ = (SELBIT) ? b31 : -INFINITY; } { const int i = 2 * j + 1; cb_ = (SELBIT) ? b31 : -INFINITY; } \
            NSA_PAIR_C(nsa_cfrag(ca_ - mref, hi), nsa_cfrag(cb_ - mref, hi), nsa_tile_exp_only(p0, p1), nsa_tile_exp_only(q0, q1)); \
            NSA_ITER_TAIL(mref, psum, lvar) \
        } \
        for (; j < np_; ++j) { \
            NSA_ITER_HEAD(kp, vp, t0, nt) \
            const s16x4 cfm_ = nsa_cfrag(-mref, hi); \
            NSA_PAIR_C(cfm_, cfm_, { const int i = 2 * j; nsa_tile_exp_tab_only(p0, p1, TABF); }, { const int i = 2 * j + 1; nsa_tile_exp_tab_only(q0, q1, (i < (nt)) ? (TABF) : (const LAS float*)negt); }); \
            NSA_ITER_TAIL(mref, psum, lvar) \
        } } while (0)
    {
        const bf16_t* kp = PN + (size_t)b * T_ * PN_LD + 768 + hkv * 64; const bf16_t* vp = kp + 128;
        float ms = 0.f, mp = 0.f, ls = 0.f; o[0] = (f32x16){}; o[1] = (f32x16){};
        const int nt = qblk + 1;
        const LAS float* lutsg = luts + g * NS_N + (NS_N - 69 - (tq - 4 * hi)); const LAS float* b31g = b31t + g * 64;
        const int dmin0 = 64 * qblk + 8 * wave - 63;
        NSA_LOOP2(kp, vp, 0, nt, (((sm[(i >> 5) & 3] >> (i & 31)) & 1u) ? ((dmin0 - 64 * i >= 1535) ? b31g : lutsg + 64 * i) : (const LAS float*)negt), (dmin0 >= 1599 ? (dmin0 - 1599) / 128 + 1 : 0), ((sm[(i >> 5) & 3] >> (i & 31)) & 1u), ms, mp, ls);
        ls += __shfl_xor(ls, 32);
        nsa_emit(dst0, o, NSA_GATE(1) * __builtin_amdgcn_rcpf(ls), true, dry, wsf, hi, r32);
    }
    {
        const bf16_t* kp = PN + (size_t)b * T_ * PN_LD + 1024 + hkv * 64; const bf16_t* vp = kp + 128;
        float mw = 0.f, mp = 0.f, lw = 0.f; o[0] = (f32x16){}; o[1] = (f32x16){};
        const int first = qblk >= 8 ? qblk - 8 : 0, nt = qblk - first + 1;
        const LAS float* lutwg = lutw + g * NW_N + (NW_N - 69 - (tq - 64 * first - 4 * hi));
        NSA_LOOP2(kp, vp, first, nt, (lutwg + 64 * i), 0, true, mw, mp, lw);
        lw += __shfl_xor(lw, 32);
        nsa_emit(dst0, o, NSA_GATE(2) * __builtin_amdgcn_rcpf(lw), true, dry, wsf, hi, r32);
    }
#undef NSA_LOOP2
#undef NSA_ITER_HEAD
#undef NSA_ITER_TAIL
#undef NSA_PAIR
#undef NSA_PAIR_C
#undef NSA_SB
#undef NSA_DMA
#undef NSA_SYNC
#undef NSA_GATE
}

#define XB_TMO      128
#define XB_XCNT(j)  (256  + 64 * (j))
#define XB_XSUB(j)  (1280 + 64 * (j))
#define XB_XGEN(j)  (2304 + 64 * (j))
#define XB_TOP      3328
#define XB_TOPGEN   3392
#define XCD_BAR_WORDS 3456
#define XB_SPIN_CAP (1u << 18)
__device__ __forceinline__ unsigned xb_ld(unsigned* p)              { return __hip_atomic_load(p, __ATOMIC_RELAXED, __HIP_MEMORY_SCOPE_AGENT); }
__device__ __forceinline__ unsigned xb_add(unsigned* p, unsigned v) { return __hip_atomic_fetch_add(p, v, __ATOMIC_RELAXED, __HIP_MEMORY_SCOPE_AGENT); }
__device__ __forceinline__ unsigned xb_xcc_id() { return (unsigned)__builtin_amdgcn_s_getreg((3 << 11) | 20) & 0xFu; }
#define XB_SPIN(cond, bar) do { unsigned _sp = 0; while (cond) { __builtin_amdgcn_s_sleep(1); \
    if ((++_sp & 255u) == 0u) { if (xb_ld(&(bar)[XB_TMO])) break; if (_sp > XB_SPIN_CAP) { atomicAdd(&(bar)[XB_TMO], 1u); break; } } } } while (0)
struct XcdBarrier { unsigned* bar; unsigned x; volatile LAS unsigned* st; };
__device__ __forceinline__ void xcd_barrier_complete(unsigned* bar, unsigned x, unsigned& nloc, unsigned& nx) {
    const unsigned G = gridDim.x;
    unsigned sum, cnt, mine, sp = 0u;
    for (;;) {
        sum = 0u; cnt = 0u; mine = 0u;
#pragma unroll
        for (unsigned j = 0; j < 16; ++j) { const unsigned c = xb_ld(&bar[XB_XCNT(j)]); sum += c; cnt += (c > 0u) ? 1u : 0u; mine = (j == x) ? c : mine; }
        if (sum == G) break;
        __builtin_amdgcn_s_sleep(1);
        if ((++sp & 255u) == 0u) { if (xb_ld(&bar[XB_TMO])) break; if (sp > XB_SPIN_CAP) { atomicAdd(&bar[XB_TMO], 1u); break; } }
    }
    nloc = mine > 0u ? mine : 1u; nx = cnt > 0u ? cnt : 1u;
}
__device__ __forceinline__ void xcd_barrier(const XcdBarrier& b, bool leader_thread) {
    asm volatile("s_waitcnt vmcnt(0)" ::: "memory");
    __syncthreads();
    if (leader_thread) {
        unsigned* bar = b.bar;
        __builtin_amdgcn_s_waitcnt(0);
        unsigned nloc = b.st[0], nx = b.st[1];
        if (nloc == 0u) { xcd_barrier_complete(bar, b.x, nloc, nx); b.st[0] = nloc; b.st[1] = nx; }
        const unsigned old = xb_add(&bar[XB_XSUB(b.x)], 1u);
        const unsigned gen = old / nloc;
        if (old + 1u == (gen + 1u) * nloc) {
            __builtin_amdgcn_fence(__ATOMIC_RELEASE, "agent");
            asm volatile("s_waitcnt vmcnt(0)" ::: "memory");
            const unsigned og = xb_add(&bar[XB_TOP], 1u);
            const unsigned tg = og / nx;
            if (og + 1u == (tg + 1u) * nx) xb_add(&bar[XB_TOPGEN], 1u);
            else XB_SPIN(xb_ld(&bar[XB_TOPGEN]) == tg, bar);
            __builtin_amdgcn_fence(__ATOMIC_ACQUIRE, "agent");
            xb_add(&bar[XB_XGEN(b.x)], 1u);
            asm volatile("s_waitcnt vmcnt(0)" ::: "memory");
        } else {
            XB_SPIN(xb_ld(&bar[XB_XGEN(b.x)]) == gen, bar);
            __builtin_amdgcn_fence(__ATOMIC_ACQUIRE, "agent");
            asm volatile("s_waitcnt vmcnt(0)" ::: "memory");
        }
    }
    __syncthreads();
}
constexpr size_t OFF_BAR = 256 * 1024;
constexpr size_t OFF_CNT = 320 * 1024;
constexpr size_t OFF_PCNT = 384 * 1024;

__global__ void __launch_bounds__(NTHREADS, 2) hybrid_fwd(Args args) {
    extern __shared__ __attribute__((aligned(16))) unsigned char lds_raw[];
    Frame F;
    F.lds = (LAS unsigned char*)lds_raw;
    F.wave = __builtin_amdgcn_readfirstlane(threadIdx.x >> 6);
    F.G = gridDim.x; F.blk = blockIdx.x;
    XcdBarrier xbar; xbar.bar = (unsigned*)(args.ws + OFF_BAR); xbar.x = xb_xcc_id(); xbar.st = (volatile LAS unsigned*)(F.lds + LDS_CTRL + 1024);
    if (threadIdx.x < 2) xbar.st[threadIdx.x] = 0u;
    if (threadIdx.x == 0) (void)xb_add(&xbar.bar[XB_XCNT(xbar.x)], 1u);
    __syncthreads();
#define IN(k) (true)
#define SEAM(k) xcd_barrier(xbar, F.wave == 0 && lane_id() == 0)
#define WSP(type, off) ((type*)(args.ws + (off)))
#define PHASE_IDS() unsigned char* ws = args.ws; (void)ws; const int lane = lane_id(), tid = F.wave * 64 + lane, gw = F.blk * NWAVES + F.wave, NGW = F.G * NWAVES, gt = F.blk * NTHREADS + tid, NGT = F.G * NTHREADS; (void)gw; (void)NGW; (void)gt; (void)NGT; (void)tid; (void)lane
#define XIN (args.in[0])
#define SS1 WSP(float, OFF_SS1)
#define SS2 WSP(float, OFF_SS2)
#define SS3 WSP(float, OFF_SS3)
#define XN WSP(bf16_t, OFF_XN)
#define XB WSP(bf16_t, OFF_XN)
#define Win_t WSP(bf16_t, OFF_WIN)
#define Wkv_t ((bf16_t*)args.out + (size_t)10 * 1024 * 1024)
#define Wc1k_t WSP(bf16_t, OFF_WC1K)
#define Wc1v_t WSP(bf16_t, OFF_WC1V)
#define Wlora_t WSP(bf16_t, OFF_WLORA)
#define Wout_t ((bf16_t*)args.out)
#define Wq_t ((bf16_t*)args.out + (size_t)1024 * 1024)
#define Wo_t ((bf16_t*)args.out + (size_t)2 * 1024 * 1024)
#define Wgu_t ((bf16_t*)args.out + (size_t)3 * 1024 * 1024)
#define Wd_t WSP(bf16_t, OFF_WD)
#define Hb WSP(bf16_t, OFF_H)
#define MEMN WSP(bf16_t, OFF_MEMN)
#define KVX WSP(bf16_t, OFF_KVX)
#define PNSA WSP(bf16_t, OFF_PNSA)
#define PRW WSP(bf16_t, OFF_R1)
#define LUT WSP(float, OFF_LUT)
#define CBK WSP(float, OFF_CBK)
#define CBPART WSP(float, OFF_CBPART)
#define H1K WSP(bf16_t, OFF_H1K)
#define H1V WSP(bf16_t, OFF_H1V)
#define KC WSP(bf16_t, OFF_KC)

    if (IN(0)) { PHASE_IDS();
        {
          LAS float* scr = (LAS float*)(F.lds + F.wave * 16384);
          for (int it = gw; it < 3088; it += NGW) {
              if (it < 1552) p0_transpose_item(args.in[5], D_, IN_COLS, Win_t, D_, 1, 0, scr, it, lane);
              else if (it < 2576) p0_transpose_item(args.in[30], D_, 2 * D_, Wkv_t, D_, 0, 0, scr, it - 1552, lane);
              else if (it < 2832) p0_transpose_item(args.in[9], 2048, 256, Wc1k_t, 2048, 0, 0, scr, it - 2576, lane);
              else p0_transpose_item(args.in[12], 2048, 256, Wc1v_t, 2048, 0, 0, scr, it - 2832, lane); } }
        for (int i = gt; i < (NIN - IN_COLS) * (D_ / 8); i += NGT) *(u32x4*)(Win_t + (size_t)IN_COLS * D_ + (size_t)i * 8) = (u32x4){0u, 0u, 0u, 0u};
        for (int i = gt; i < 1536 * 32; i += NGT) { const int n = i >> 5, kc = (i & 31) * 8, reg = n >> 9, nn = n & 511; float f[8];
#pragma unroll
            for (int j = 0; j < 8; ++j) { const int k = kc + j; float v = 0.f;
                if (reg == 0 && k < 64) v = args.in[17][(size_t)k * 512 + nn];
                else if (reg == 1 && k >= 64 && k < 128) v = args.in[19][(size_t)(k - 64) * 512 + nn];
                else if (reg == 2 && k >= 128) v = args.in[20][(size_t)(k - 128) * 512 + nn];
                f[j] = v; }
            *(u32x4*)(Wlora_t + (size_t)n * 256 + kc) = pack8(f); }
        for (int m = gw; m < M_; m += 2 * NGW) {
            const int m2 = m + NGW; const bool two = m2 < M_;
            const f32x4* xa = (const f32x4*)(XIN + (size_t)m * D_) + lane; const f32x4* xb = (const f32x4*)(XIN + (size_t)(two ? m2 : m) * D_) + lane;
            f32x4 va[4], vb[4]; float sa = 0.f, sb = 0.f;
#pragma unroll
            for (int j = 0; j < 4; ++j) { va[j] = xa[64 * j]; vb[j] = xb[64 * j]; }
#pragma unroll
            for (int j = 0; j < 4; ++j) { sa += (va[j][0] * va[j][0] + va[j][1] * va[j][1]) + (va[j][2] * va[j][2] + va[j][3] * va[j][3]); sb += (vb[j][0] * vb[j][0] + vb[j][1] * vb[j][1]) + (vb[j][2] * vb[j][2] + vb[j][3] * vb[j][3]); }
#pragma unroll
            for (int o = 1; o < 64; o <<= 1) { sa += __shfl_xor(sa, o); sb += __shfl_xor(sb, o); }
            const float ra = __builtin_amdgcn_rsqf(sa * (1.0f / D_) + RMS_EPS), rb = __builtin_amdgcn_rsqf(sb * (1.0f / D_) + RMS_EPS);
#pragma unroll
            for (int j = 0; j < 4; ++j) { const f32x4 g4 = *((const f32x4*)args.in[4] + lane + 64 * j); const f32x4 ya = va[j] * ra * g4, yb = vb[j] * rb * g4;
                u32x2 w; w.x = pk2(ya[0], ya[1]); w.y = pk2(ya[2], ya[3]); *((u32x2*)(XN + (size_t)m * D_) + lane + 64 * j) = w;
                if (two) { w.x = pk2(yb[0], yb[1]); w.y = pk2(yb[2], yb[3]); *((u32x2*)(XN + (size_t)m2 * D_) + lane + 64 * j) = w; } }
        }
        for (int m = gw; m < 512; m += NGW) rms_row_to_bf16(args.in[1] + (size_t)m * D_, args.in[28], MEMN + (size_t)m * D_, lane);
        for (int i = gt; i < 8 * 2048; i += NGT) { const int h = i >> 11, d = i & 2047; int bk;
            if (d < 16) bk = d; else { bk = 16; const int thr[15] = {22, 30, 40, 54, 73, 99, 134, 182, 246, 332, 450, 609, 825, 1117, 1513};
#pragma unroll
                for (int j = 0; j < 15; ++j) bk += (d >= thr[j]) ? 1 : 0; }
            LUT[i] = args.in[2][bk * 8 + h] * LOG2E; }
        for (int i = gt; i < 8 * (NS_N + NW_N); i += NGT) { const bool isw = i >= 8 * NS_N; const int ii = isw ? i - 8 * NS_N : i, n = isw ? NW_N : NS_N, h = ii / n, dist = (n - 1 - (ii % n)) - 68;
            const int d = dist < 0 ? 0 : (dist < 1535 ? dist : 1535); int bk;
            if (d < 16) bk = d; else { bk = 16; const int thr[15] = {22, 30, 40, 54, 73, 99, 134, 182, 246, 332, 450, 609, 825, 1117, 1513};
#pragma unroll
                for (int j = 0; j < 15; ++j) bk += (d >= thr[j]) ? 1 : 0; }
            const bool valid = isw ? (dist >= 0 && dist < 512) : (dist >= 0);
            (isw ? WSP(float, OFF_LTW) : WSP(float, OFF_LTS))[ii] = valid ? args.in[2][bk * 8 + h] * LOG2E : -INFINITY; }
        for (int i = gt; i < 32 * 512; i += NGT) { const int lc = i >> 9, j = i & 511; const float* pe = (j < 256 ? args.in[7] : args.in[8]) + lc * 64; const float* w1 = (j < 256 ? args.in[9] : args.in[12]) + (size_t)lc * 64 * 256 + (j & 255);
            float s = 0.f;
#pragma unroll 8
            for (int d = 0; d < 64; ++d) s += pe[d] * w1[(size_t)d * 256];
            CBPART[i] = s; }
    }
    SEAM(0);
    if (IN(1)) { PHASE_IDS();
        if (F.blk == 100) { const int j = tid; float s = (j < 256 ? args.in[10] : args.in[13])[j & 255];
            for (int lc = 0; lc < 32; ++lc) s += CBPART[lc * 512 + j];
            CBK[j < 256 ? j : 512 + (j - 256)] = s; }
        { pg8::Gemm g{XN, Win_t, M_, NIN - 256, D_, D_, 128, 0}; pg8::StaticOrder S; S.init(M_, NIN - 256, F.G, F.blk);
          pg8::EpiStore E{PRW, PR_LD, 7, PNSA, PN_LD, 7, 9, QK_C};
          pg8::gemm_phase(F.lds, g, S, E, F.wave); }
    }
    SEAM(1);
    if (IN(2)) { PHASE_IDS();
        bf16_t* R = (bf16_t*)(ws + OFF_R); bf16_t* V = (bf16_t*)(ws + OFF_V); bf16_t* KK = (bf16_t*)(ws + OFF_KK); bf16_t* KP = (bf16_t*)(ws + OFF_KP);
        bf16_t* LA = (bf16_t*)(ws + OFF_LORA_A);
        const float* mu = args.in[15]; const float* k_k = args.in[21];
        for (int m = (F.blk >= 16 ? (F.blk - 16) * NWAVES + F.wave : M_); m < M_; m += (F.G - 16) * NWAVES) {
            const bf16_t* pr = PRW + (size_t)m * PR_LD; const bool hp = (m % T_) != 0;
#pragma unroll
            for (int q = 0; q < 3; ++q) { const int col = q * 512 + 8 * lane;
                const u32x4 cw = *(const u32x4*)(pr + col); u32x4 pw = (u32x4){0u, 0u, 0u, 0u}; if (hp) pw = *(const u32x4*)(pr - PR_LD + col);
                float cf[8], pf[8], val[8]; unpack8(cw, cf); unpack8(pw, pf);
                const f32x4 m0 = *(const f32x4*)(mu + col), m1 = *(const f32x4*)(mu + col + 4);
#pragma unroll
                for (int i = 0; i < 8; ++i) val[i] = cf[i] + (pf[i] - cf[i]) * (i < 4 ? m0[i & 3] : m1[i & 3]);
                const size_t o = (size_t)m * 512 + 8 * lane;
                if (q == 0) *(u32x4*)(R + o) = pack8(val);
                else if (q == 2) *(u32x4*)(V + o) = pack8(val);
                else { *(u32x4*)(KP + o) = pack8(val);
                    const f32x4 k0 = *(const f32x4*)(k_k + 8 * lane), k1 = *(const f32x4*)(k_k + 8 * lane + 4); float kr[8], ss = 0.f;
#pragma unroll
                    for (int i = 0; i < 8; ++i) { kr[i] = val[i] * (i < 4 ? k0[i & 3] : k1[i & 3]); ss += kr[i] * kr[i]; }
                    ss += __shfl_xor(ss, 1); ss += __shfl_xor(ss, 2); ss += __shfl_xor(ss, 4);
                    const float inv = __builtin_amdgcn_rsqf(fmaxf(ss, 1e-24f));
#pragma unroll
                    for (int i = 0; i < 8; ++i) kr[i] *= inv;
                    *(u32x4*)(KK + o) = pack8(kr); }
            }
            { const int col = 1536 + 4 * lane; const u32x2 cw = *(const u32x2*)(pr + col); u32x2 pw = (u32x2){0u, 0u}; if (hp) pw = *(const u32x2*)(pr - PR_LD + col);
              const f32x4 mm = *(const f32x4*)(mu + col); float o4[4];
#pragma unroll
              for (int i = 0; i < 4; ++i) { const unsigned cu = i < 2 ? cw.x : cw.y, pu = i < 2 ? pw.x : pw.y;
                  const float cf = __builtin_bit_cast(float, (i & 1) ? (cu & 0xffff0000u) : (cu << 16)), pf = __builtin_bit_cast(float, (i & 1) ? (pu & 0xffff0000u) : (pu << 16));
                  const float v = cf + (pf - cf) * mm[i];
                  o4[i] = lane < 16 ? (1.0f - 2.0f * __builtin_amdgcn_rcpf(1.0f + __expf(2.0f * v))) : (lane < 32 ? v : __builtin_amdgcn_rcpf(1.0f + __expf(-v))); }
              u32x2 w; w.x = pk2(o4[0], o4[1]); w.y = pk2(o4[2], o4[3]); *(u32x2*)(LA + (size_t)m * 256 + 4 * lane) = w; }
        }
        { pg8::Gemm g{PNSA + 512, Wc1k_t, 2048, 256, 2048, 16 * PN_LD, PN_LD * 2, 1}; pg8::ListOrder S; S.init(2048, 256, 0, F.blk);
          pg8::EpiGelu E{H1K, CBK};
          pg8::gemm_phase(F.lds, g, S, E, F.wave); }
        { pg8::Gemm g{PNSA + 640, Wc1v_t, 2048, 256, 2048, 16 * PN_LD, PN_LD * 2, 1}; pg8::ListOrder S; S.init(2048, 256, 8, F.blk);
          pg8::EpiGelu E{H1V, CBK + 512};
          pg8::gemm_phase(F.lds, g, S, E, F.wave); }
    }
    SEAM(2);
    if (IN(3)) { PHASE_IDS();
        { pg8::Gemm g{(const bf16_t*)(ws + OFF_LORA_A), Wlora_t, M_, 1536, 256, 256, 128, 0}; pg8::StaticOrder S; S.init(M_, 1536, F.G, F.blk);
          pg8::EpiLora E{(float*)(ws + OFF_W), (bf16_t*)(ws + OFF_KP), (const bf16_t*)(ws + OFF_KK), (bf16_t*)(ws + OFF_B), (bf16_t*)(ws + OFF_G), args.in[16], args.in[18], args.in[22]};
          pg8::gemm_phase(F.lds, g, S, E, F.wave);
          }
        { pg8::Gemm g{XN, Win_t + (size_t)(NIN - 256) * D_, M_, 256, D_, D_, 128, 0}; pg8::ListOrder S; S.init(M_, 256, 128, F.blk);
          pg8::EpiStore E{PNSA + 1280, PN_LD, 1000, nullptr, 0, 0, 0, 1.0f};
          pg8::gemm_phase(F.lds, g, S, E, F.wave); }
        {
          LAS float* scr = (LAS float*)(F.lds + F.wave * 16384);
          const int q3 = F.G >> 2, grp3 = F.blk < 2 * q3 ? 0 : (F.blk < 3 * q3 ? 1 : 2);
          const int it0 = grp3 == 0 ? gw : (grp3 == 2 ? 2880 + (F.blk - 3 * q3) * NWAVES + F.wave : 5760), itn = grp3 == 0 ? 2880 : 5760, its = grp3 == 0 ? 2 * q3 * NWAVES : q3 * NWAVES;
          for (int it = it0; it < itn; it += its) {
              if (it < 512) p0_transpose_item(args.in[26], D_, D_, Wout_t, D_, 0, 0, scr, it, lane);
              else if (it < 1024) p0_transpose_item(args.in[29], D_, D_, Wq_t, D_, 0, 0, scr, it - 512, lane);
              else if (it < 1536) p0_transpose_item(args.in[31], D_, D_, Wo_t, D_, 0, 0, scr, it - 1024, lane);
              else if (it < 2944) p0_transpose_item(args.in[33], D_, DFF, Wgu_t, D_, 2, 0, scr, it - 1536, lane);
              else if (it < 4352) p0_transpose_item(args.in[34], D_, DFF, Wgu_t, D_, 3, 0, scr, it - 2944, lane);
              else p0_transpose_item(args.in[35], DFF, D_, Wd_t, DFF, 0, 0, scr, it - 4352, lane); } }
        for (int r = gw; r < 4096; r += NGW) { const int kv = r >> 11, row = r & 2047; const bf16_t* h1 = (kv ? H1V : H1K) + (size_t)row * 256; const float* w2 = args.in[kv ? 14 : 11] + lane;
            float s0 = 0.f, s1 = 0.f;
#pragma unroll 8
            for (int j = 0; j < 256; j += 2) { const unsigned hw = *(const unsigned*)(h1 + j); s0 += __builtin_bit_cast(float, hw << 16) * w2[(size_t)j * 64]; s1 += __builtin_bit_cast(float, hw & 0xffff0000u) * w2[(size_t)(j + 1) * 64]; }
            float s = s0 + s1; if ((row & 511) == 511) s = 0.f;
            (KC + (size_t)kv * 131072)[(size_t)row * 64 + lane] = (bf16_t)f2bf(s); }
    }
    SEAM(3);
    if (IN(4)) { PHASE_IDS();
        rwkv_chunk(F, ws);
    }
    SEAM(4);
    if (IN(5)) { PHASE_IDS();
        if (F.blk < 16) rwkv_combine(F, ws, F.blk);
        { pg8::Gemm g{MEMN, Wkv_t, 512, 2 * D_, D_, D_, 128, 0}; pg8::ListOrder S; S.init(512, 2 * D_, 16, F.blk);
          pg8::EpiStore E{KVX, 2 * D_, 1000, nullptr, 0, 0, 0, 1.0f};
          pg8::gemm_phase(F.lds, g, S, E, F.wave); }
        volatile LAS unsigned* uw = (volatile LAS unsigned*)(F.lds + LDS_CTRL + 1024 + 64);
        for (;;) {
            __syncthreads();
            if (tid == 0) uw[0] = xb_add(WSP(unsigned, OFF_CNT), 1u);
            __syncthreads();
            const unsigned u = uw[0];
            if (u >= 512u) break;
            nsa_unit(F, ws, args.in[6], (int)(u & 1u), (int)((u >> 1) & 1u), 127 - (int)(u >> 2));
        }
    }
    SEAM(5);
    if (IN(6)) { PHASE_IDS();
        for (int task = gw; task < 16 * NC * 4; task += NGW) rwkv_fixup_task(ws, args.in[24], args.in[25], args.in[23], task >> 2, task & 3, lane);
    }
    SEAM(6);
    if (IN(7)) { PHASE_IDS();
        pg8::Gemm g{PNSA, Wout_t, M_, D_, D_, PN_LD, 128, 0}; pg8::StaticOrder S; S.init(M_, D_, F.G, F.blk);
        pg8::EpiResidual<false> E{XIN, nullptr, nullptr, XB, args.in[27], SS1};
        pg8::gemm_phase(F.lds, g, S, E, F.wave);
    }
    SEAM(7);
    if (IN(8)) { PHASE_IDS();
        pg8::Gemm g{XB, Wq_t, M_, D_, D_, D_, 128, 0}; pg8::StaticOrder S; S.init(M_, D_, F.G, F.blk);
        pg8::EpiRowScale E{WSP(bf16_t, OFF_Q2), SS1, 0.0625f * LOG2E};
        pg8::gemm_phase(F.lds, g, S, E, F.wave);
        asm volatile("s_waitcnt vmcnt(0)" ::: "memory");
        __syncthreads();
        asm volatile("buffer_inv sc0\n\ts_waitcnt vmcnt(0)" ::: "memory");
    }
    if (IN(9)) { PHASE_IDS();
        const int c = F.blk, pm = 8 * (c & 7) + ((c >> 3) & 7), pn = c >> 6;
        xattn_unit(F, WSP(bf16_t, OFF_Q2), KVX, WSP(bf16_t, OFF_XO), pm >> 5, pn, pm & 31);
    }
    SEAM(9);
    if (IN(10)) { PHASE_IDS();
        pg8::Gemm g{WSP(bf16_t, OFF_XO), Wo_t, M_, D_, D_, D_, 128, 0}; pg8::StaticOrder S; S.init(M_, D_, F.G, F.blk);
        pg8::EpiResidual<true> E{nullptr, XB, args.in[27], XB, args.in[32], SS2};
        pg8::gemm_phase(F.lds, g, S, E, F.wave);
    }
    SEAM(10);
    if (IN(11)) { PHASE_IDS();
        pg8::Gemm g{XB, Wgu_t, M_, 2 * DFF, D_, D_, 128, 0}; pg8::StaticOrder S; S.init(M_, 2 * DFF, F.G, F.blk);
        pg8::EpiSwiglu E{Hb, SS2};
        pg8::gemm_phase(F.lds, g, S, E, F.wave);
    }
    SEAM(11);
    if (IN(12)) { PHASE_IDS();
        pg8::Gemm g{Hb, Wd_t, M_, D_, DFF, DFF, 128, 0}; pg8::StaticOrder S; S.init(M_, D_, F.G, F.blk);
        pg8::EpiFinalNorm E{XB, args.in[32], args.out, args.in[3], SS3, WSP(unsigned, OFF_PCNT)};
        pg8::gemm_phase(F.lds, g, S, E, F.wave);
    }
#undef IN
#undef SEAM
}

extern "C" void kernel_launch(void* const* d_in, const int* in_sizes, int n_in, void* d_out, int out_size, void* d_ws, size_t ws_size, hipStream_t stream) {
    static int grid = 0;
    if (grid == 0) {
        int dev = 0, cus = 0, per_cu = 0;
        (void)hipGetDevice(&dev);
        (void)hipDeviceGetAttribute(&cus, hipDeviceAttributeMultiprocessorCount, dev);
        (void)hipFuncSetAttribute((const void*)hybrid_fwd, hipFuncAttributeMaxDynamicSharedMemorySize, LDS_BYTES);
        (void)hipOccupancyMaxActiveBlocksPerMultiprocessor(&per_cu, (const void*)hybrid_fwd, NTHREADS, LDS_BYTES);
        if (per_cu < 1) { fprintf(stderr, "kernel_launch: occupancy query reports %d blocks per CU\n", per_cu); per_cu = 1; }
        (void)hipGetLastError();
        grid = cus;
        if (n_in != 36 || ws_size < 256 * MiB) fprintf(stderr, "kernel_launch: unexpected n_in %d / ws %zu\n", n_in, ws_size);
    }
    Args a{};
    for (int i = 0; i < 36; ++i) a.in[i] = (const float*)d_in[i];
    a.out = (float*)d_out; a.ws = (unsigned char*)d_ws; a.ph_lo = 0; a.ph_hi = N_PHASES;
    (void)hipMemsetAsync((char*)d_ws + OFF_BAR, 0, 256 * 1024, stream);
    void* kargs[] = {&a};
    hipError_t e = hipLaunchCooperativeKernel((const void*)hybrid_fwd, dim3(grid), dim3(NTHREADS), kargs, LDS_BYTES, stream);
    if (e != hipSuccess) fprintf(stderr, "cooperative launch failed: %s (grid %d)\n", hipGetErrorString(e), grid);
}
```
